# Optimizing an MI355X kernel written in HIP

```python
import jax, jax.numpy as jnp
from jax import lax
import numpy as np

D_MODEL = 1024
BATCH = 4
SEQ = 4096
DEPTH = 2

GLA_HEADS = 4
GLA_DK = 64
GLA_DV = 128
GLA_GATE_RANK = 16
GLA_GATE_TAU = 16.0
GLA_CHUNK = 64
DSA_HEADS = 8
DSA_HD = 64
IDX_HEADS = 4
IDX_HD = 64
TOPK_MAX = 256
Q_BLOCK = 128
ROPE_THETA = 500000.0
ROPE_FRAC_DIV = 4
SGU_CHUNK = 128
SGU_GROUPS = 8
SGU_WIDTH = D_MODEL
D_FF = 2816
CONV_W = 3
EPS = 1e-6
LN_EPS = 1e-5

A_WIDTH = GLA_HEADS * GLA_DV
B_WIDTH = DSA_HEADS * DSA_HD
IN_WIDTHS = (
    GLA_HEADS * GLA_DK,
    GLA_HEADS * GLA_DK,
    GLA_HEADS * GLA_DV,
    A_WIDTH,
    GLA_GATE_RANK,
    DSA_HEADS * DSA_HD,
    DSA_HD,
    DSA_HD,
    IDX_HEADS * IDX_HD,
    IDX_HD,
    IDX_HEADS,
)
IN_WIDTH = sum(IN_WIDTHS)
N_EVEN = (DEPTH + 1) // 2
N_ODD = DEPTH // 2

kernel_name = "hybrid_gla_dsa_sgu_convffn"


def rmsnorm(x, g):
    xf = x.astype(jnp.float32)
    y = xf * lax.rsqrt(jnp.mean(xf * xf, axis=-1, keepdims=True) + EPS)
    return (y * g.astype(jnp.float32)).astype(x.dtype)


def layernorm(x, g, b):
    xf = x.astype(jnp.float32)
    mu = jnp.mean(xf, axis=-1, keepdims=True)
    xc = xf - mu
    y = xc * lax.rsqrt(jnp.mean(xc * xc, axis=-1, keepdims=True) + LN_EPS)
    return (y * g.astype(jnp.float32) + b.astype(jnp.float32)).astype(x.dtype)


def split_cols(a, widths):
    out, start = [], 0
    for w in widths:
        out.append(a[..., start:start + w])
        start += w
    return out


def rope_partial(x, pos):
    d = x.shape[-1]
    rd = d // ROPE_FRAC_DIV
    half = rd // 2
    inv = jnp.power(ROPE_THETA, -(jnp.arange(half, dtype=jnp.float32) * 2.0 / rd))
    ang = pos[:, None] * inv[None, :]
    cos = jnp.cos(ang)[:, None, :].astype(x.dtype)
    sin = jnp.sin(ang)[:, None, :].astype(x.dtype)
    x1, x2, rest = x[..., :half], x[..., half:rd], x[..., rd:]
    return jnp.concatenate([x1 * cos - x2 * sin, x2 * cos + x1 * sin, rest], axis=-1)


def gla_chunked(q, k, v, log_a):
    Bn, T, H, dk = q.shape
    dv = v.shape[-1]
    C = GLA_CHUNK
    N = T // C

    def chunks(a):
        return a.astype(jnp.float32).reshape(Bn, N, C, H, a.shape[-1]).transpose(0, 3, 1, 2, 4)

    qf = chunks(q) * (dk ** -0.5)
    kf, vf, la = chunks(k), chunks(v), chunks(log_a)
    b = jnp.cumsum(la, axis=3)
    b_last = b[:, :, :, -1:]
    b_mid = b[:, :, :, C // 2:C // 2 + 1]
    att = jnp.einsum('bhnid,bhnjd->bhnij', qf * jnp.exp(b - b_mid), kf * jnp.exp(b_mid - b))
    att = att * jnp.tril(jnp.ones((C, C), jnp.float32))
    o_intra = jnp.einsum('bhnij,bhnjd->bhnid', att, vf)
    dS = jnp.einsum('bhncd,bhnce->bhnde', kf * jnp.exp(b_last - b), vf)
    decay = jnp.exp(b_last[:, :, :, 0])

    def step(S, inp):
        dec, ds = inp
        return dec[..., None] * S + ds, S

    S0 = jnp.zeros((Bn, H, dk, dv), jnp.float32)
    _, S_prev = lax.scan(step, S0, (jnp.moveaxis(decay, 2, 0), jnp.moveaxis(dS, 2, 0)))
    S_prev = jnp.moveaxis(S_prev, 0, 2)
    o_inter = jnp.einsum('bhncd,bhnde->bhnce', qf * jnp.exp(b), S_prev)
    o = o_intra + o_inter
    return o.transpose(0, 2, 3, 1, 4).reshape(Bn, T, H, dv)


def dsa_attention(q, k, v, iq, ik, iw, topk):
    Bn, T, Hq, d = q.shape
    di = ik.shape[-1]
    NB = T // Q_BLOCK
    key_pos = jnp.arange(T, dtype=jnp.int32)
    ikf = ik.astype(jnp.float32)

    def to_blocks(a):
        return jnp.moveaxis(a.reshape((Bn, NB, Q_BLOCK) + a.shape[2:]), 1, 0)

    q_pos = key_pos.reshape(NB, Q_BLOCK)

    def one_block(args):
        qb, iqb, iwb, qp = args
        s_idx = jnp.einsum('bqhd,bsd->bqhs', iqb.astype(jnp.float32), ikf) * (di ** -0.5)
        score = jnp.einsum('bqh,bqhs->bqs', iwb.astype(jnp.float32), jax.nn.relu(s_idx))
        causal = key_pos[None, :] <= qp[:, None]
        score = jnp.where(causal[None], score, -jnp.inf)
        _, idx = lax.top_k(score, topk)
        kg = jax.vmap(lambda kb, ib: kb[ib])(k, idx)
        vg = jax.vmap(lambda vb, ib: vb[ib])(v, idx)
        valid = idx <= qp[None, :, None]
        s = jnp.einsum('bqhd,bqkd->bqhk', qb.astype(jnp.float32), kg.astype(jnp.float32)) * (d ** -0.5)
        s = jnp.where(valid[:, :, None, :], s, -jnp.inf)
        p = jax.nn.softmax(s, axis=-1)
        o = jnp.einsum('bqhk,bqkd->bqhd', p, vg.astype(jnp.float32))
        return o.astype(q.dtype)

    ob = lax.map(one_block, (to_blocks(q), to_blocks(iq), to_blocks(iw), q_pos))
    return jnp.moveaxis(ob, 0, 1).reshape(Bn, T, Hq * d)


def hybrid_attn_layer(x, g, w_in, w_a2, b_a, head_g, w_o, topk):
    Bn, T, _ = x.shape
    pos = jnp.arange(T, dtype=jnp.float32)
    h = rmsnorm(x, g)
    proj = h @ w_in
    aq, ak, av, ar, alr, bq, bk, bv, iq, ik, iw = split_cols(proj, IN_WIDTHS)
    log_a = jax.nn.log_sigmoid((alr @ w_a2 + b_a).astype(jnp.float32)) / GLA_GATE_TAU
    oa = gla_chunked(aq.reshape(Bn, T, GLA_HEADS, GLA_DK),
                     ak.reshape(Bn, T, GLA_HEADS, GLA_DK),
                     av.reshape(Bn, T, GLA_HEADS, GLA_DV),
                     log_a.reshape(Bn, T, GLA_HEADS, GLA_DK))
    oa = rmsnorm(oa, head_g).reshape(Bn, T, A_WIDTH).astype(x.dtype) * jax.nn.silu(ar)
    bq = rope_partial(bq.reshape(Bn, T, DSA_HEADS, DSA_HD), pos)
    bk = rope_partial(bk[:, :, None, :], pos)[:, :, 0, :]
    iq = rope_partial(iq.reshape(Bn, T, IDX_HEADS, IDX_HD), pos)
    ik = rope_partial(ik[:, :, None, :], pos)[:, :, 0, :]
    iw = iw * (IDX_HEADS ** -0.5)
    ob = dsa_attention(bq, bk, bv, iq, ik, iw, topk)
    return x + jnp.concatenate([oa, ob], axis=-1) @ w_o


def sgu_layer(x, g, w_uv, ln_g, ln_b, w_s, b_s, w_out):
    Bn, T, _ = x.shape
    NC = T // SGU_CHUNK
    gw = SGU_WIDTH // SGU_GROUPS
    h = rmsnorm(x, g)
    z = jax.nn.gelu(h @ w_uv)
    u, v = z[..., :SGU_WIDTH], z[..., SGU_WIDTH:]
    v = layernorm(v, ln_g, ln_b)
    vc = v.reshape(Bn, NC, SGU_CHUNK, SGU_GROUPS, gw)
    ws = w_s * jnp.tril(jnp.ones((SGU_CHUNK, SGU_CHUNK), w_s.dtype))
    mixed = jnp.einsum('gts,bnsgc->bntgc', ws, vc) + b_s.T[None, None, :, :, None]
    return x + (u * mixed.reshape(Bn, T, SGU_WIDTH)) @ w_out


def conv_ffn(x, g, w_up, conv_w, conv_b, w_down):
    T = x.shape[1]
    h = rmsnorm(x, g)
    a = h @ w_up
    ap = jnp.pad(a, ((0, 0), (CONV_W - 1, 0), (0, 0)))
    c = conv_b + sum(conv_w[j] * ap[:, j:j + T] for j in range(CONV_W))
    gate, up = c[..., :D_FF], c[..., D_FF:]
    return x + (jax.nn.silu(gate) * up) @ w_down


def setup_inputs(seed: int = 0) -> dict:
    key = jax.random.key(seed)
    ks = jax.random.split(key, 24)

    def nrm(k, shape, scale):
        return jax.random.normal(k, shape, jnp.float32) * scale

    D = D_MODEL
    return {
        "x": nrm(ks[0], (BATCH, SEQ, D), 1.0),
        "attn_norm": 1.0 + nrm(ks[1], (N_EVEN, D), 0.02),
        "attn_w_in": nrm(ks[2], (N_EVEN, D, IN_WIDTH), D ** -0.5),
        "gla_w_a2": nrm(ks[3], (N_EVEN, GLA_GATE_RANK, GLA_HEADS * GLA_DK), GLA_GATE_RANK ** -0.5),
        "gla_b_a": nrm(ks[4], (N_EVEN, GLA_HEADS * GLA_DK), 0.1),
        "gla_head_g": 1.0 + nrm(ks[5], (N_EVEN, GLA_DV), 0.02),
        "attn_w_o": nrm(ks[6], (N_EVEN, A_WIDTH + B_WIDTH, D), (A_WIDTH + B_WIDTH) ** -0.5),
        "sgu_norm": 1.0 + nrm(ks[7], (N_ODD, D), 0.02),
        "sgu_w_uv": nrm(ks[8], (N_ODD, D, 2 * SGU_WIDTH), D ** -0.5),
        "sgu_ln_g": 1.0 + nrm(ks[9], (N_ODD, SGU_WIDTH), 0.02),
        "sgu_ln_b": nrm(ks[10], (N_ODD, SGU_WIDTH), 0.02),
        "sgu_w_s": nrm(ks[11], (N_ODD, SGU_GROUPS, SGU_CHUNK, SGU_CHUNK), 0.5 * SGU_CHUNK ** -0.5),
        "sgu_b_s": 1.0 + nrm(ks[12], (N_ODD, SGU_GROUPS, SGU_CHUNK), 0.02),
        "sgu_w_out": nrm(ks[13], (N_ODD, SGU_WIDTH, D), SGU_WIDTH ** -0.5),
        "ffn_norm": 1.0 + nrm(ks[14], (DEPTH, D), 0.02),
        "ffn_w_up": nrm(ks[15], (DEPTH, D, 2 * D_FF), D ** -0.5),
        "ffn_conv_w": nrm(ks[16], (DEPTH, CONV_W, 2 * D_FF), CONV_W ** -0.5),
        "ffn_conv_b": nrm(ks[17], (DEPTH, 2 * D_FF), 0.02),
        "ffn_w_down": nrm(ks[18], (DEPTH, D_FF, D), D_FF ** -0.5),
        "final_norm": 1.0 + nrm(ks[19], (D,), 0.02),
    }


def reference(x, attn_norm, attn_w_in, gla_w_a2, gla_b_a, gla_head_g, attn_w_o,
              sgu_norm, sgu_w_uv, sgu_ln_g, sgu_ln_b, sgu_w_s, sgu_b_s, sgu_w_out,
              ffn_norm, ffn_w_up, ffn_conv_w, ffn_conv_b, ffn_w_down, final_norm):
    T = x.shape[1]
    topk = min(TOPK_MAX, T // 4)
    for i in range(DEPTH):
        j = i // 2
        if i % 2 == 0:
            x = hybrid_attn_layer(x, attn_norm[j], attn_w_in[j], gla_w_a2[j], gla_b_a[j],
                                  gla_head_g[j], attn_w_o[j], topk)
        else:
            x = sgu_layer(x, sgu_norm[j], sgu_w_uv[j], sgu_ln_g[j], sgu_ln_b[j],
                          sgu_w_s[j], sgu_b_s[j], sgu_w_out[j])
        x = conv_ffn(x, ffn_norm[i], ffn_w_up[i], ffn_conv_w[i], ffn_conv_b[i], ffn_w_down[i])
    return rmsnorm(x, final_norm)
```

```cpp
#include <hip/hip_runtime.h>
#include <cstdio>
#include <cstdint>

#ifndef MK_MULTI
#define MK_MULTI 0
#endif

namespace pg8 {
#define PG8_LAS __attribute__((address_space(3)))
typedef unsigned short bf16_t;
typedef short bf16x8 __attribute__((ext_vector_type(8)));
typedef float f32x4 __attribute__((ext_vector_type(4)));
typedef unsigned u32x4 __attribute__((ext_vector_type(4)));
constexpr int BM = 256, BK = 64, HALF = 128, HTB = HALF * BK * 2  , STAGE_BYTES = 8 * HTB, NXCD = 8, WGM = 8;

__host__ __device__ __forceinline__ int lds_byte(int r, int c) { const int st = (r >> 4) * 2 + (c >> 5), rr = r & 15, cc = c & 31, ob = rr * 64 + cc * 2; return st * 1024 + (ob ^ (((ob >> 9) & 1) << 5)); }
__host__ __device__ __forceinline__ void stage_rc(int b, int& R, int& C) { const int st = b / 1024, sb = b % 1024, swz = sb ^ (((sb >> 9) & 1) << 5); R = (st >> 1) * 16 + swz / 64; C = (st & 1) * 32 + (swz % 64) / 2; }
__host__ __device__ __forceinline__ int perm32(int rho) { const int n = rho >> 4, i = rho & 15; return 8 * (i >> 2) + 4 * n + (i & 3); }

struct Unit { int pm, pn; };
struct Gemm { const bf16_t* A; const bf16_t* Bt; int M, N, K; };

struct StaticOrder {
    int nM, nN, nwg, G, c;
    __host__ __device__ void init(int M, int N, int G_, int c_) { nM = M / BM; nN = N / BM; nwg = nM * nN; G = G_; c = c_; }
    __host__ __device__ bool next(int i, Unit& u) const {
        const long L = (long)i * G + c; if (L >= nwg) return false;
        int wgid = (int)L; { const int q = nwg / NXCD, r = nwg % NXCD, xcd = wgid % NXCD, off = wgid / NXCD; wgid = (xcd < r ? xcd * (q + 1) : r * (q + 1) + (xcd - r) * q) + off; }
        const int nig = WGM * nN, gid = wgid / nig, fm = gid * WGM, gsz = (nM - fm) < WGM ? (nM - fm) : WGM;
        u.pm = fm + ((wgid % nig) % gsz); u.pn = (wgid % nig) / gsz; return true;
    }
    __device__ __forceinline__ void a_ready(const Unit&) const {}
    __device__ __forceinline__ void done(const Unit&) const {}
};

__device__ __forceinline__ unsigned cvt_pk_bf16(float lo, float hi) { unsigned r; asm volatile("v_cvt_pk_bf16_f32 %0, %1, %2" : "=v"(r) : "v"(lo), "v"(hi)); return r; }
typedef float f32x2 __attribute__((ext_vector_type(2)));
typedef unsigned u32x2 __attribute__((ext_vector_type(2)));
__device__ __forceinline__ void st_bf16x4(bf16_t* p, f32x4 v) { u32x2 w; w.x = cvt_pk_bf16(v[0], v[1]); w.y = cvt_pk_bf16(v[2], v[3]); *(u32x2*)p = w; }
__device__ __forceinline__ float sigm(float x) { return 1.0f / (1.0f + __expf(-x)); }
__device__ __forceinline__ float silu_f(float x) { return x * sigm(x); }
__device__ __forceinline__ float gelu_tanh_f(float x) { const float u = 0.7978845608028654f * (x + 0.044715f * x * x * x); return x * sigm(2.0f * u); }
__device__ __forceinline__ f32x4 shfl4(f32x4 v, int src) { f32x4 r; r[0] = __shfl(v[0], src); r[1] = __shfl(v[1], src); r[2] = __shfl(v[2], src); r[3] = __shfl(v[3], src); return r; }
__device__ __forceinline__ f32x4 rope4(f32x4 v, const float* tab_t, int fq) {
    const f32x4 cs = *(const f32x4*)(tab_t + 4 * fq);
    f32x4 o; o[0] = v[0] * cs[0] - v[1] * cs[1]; o[1] = v[1] * cs[0] + v[0] * cs[1]; o[2] = v[2] * cs[2] - v[3] * cs[3]; o[3] = v[3] * cs[2] + v[2] * cs[3]; return o;
}

struct EpiIn {
    static constexpr bool PERM = false, AFTER_DRAIN = false;
    const float* ssq; const float* rope;
    bf16_t *gq, *gk, *gv, *gr, *bq, *bk, *bv; float *iq, *ik, *alr, *iw;
    __device__ __forceinline__ void operator()(const f32x4 (&acc)[2][2][4][2], const Unit& u, int wr, int wc, int fr_in, int fq_in) const {
        int fr = fr_in, fq = fq_in; asm volatile("" : "+v"(fr), "+v"(fq));
        const int pn = u.pn;
#pragma unroll
        for (int ai = 0; ai < 2; ++ai)
#pragma unroll
            for (int m = 0; m < 4; ++m) {
                asm volatile("" ::: "memory");
                const int r = u.pm * BM + ai * HALF + wr * 64 + m * 16 + fr;
                const float rs = 1.0f / sqrtf(ssq[r] * (1.0f / 1024.0f) + 1e-6f);
                const float* tab_t = rope + (size_t)(r & 4095) * 16;
#pragma unroll
                for (int bj = 0; bj < 2; ++bj)
#pragma unroll
                    for (int n = 0; n < 2; ++n) {
                        f32x4 v = acc[ai][bj][m][n] * rs;
                        const int cl = bj * HALF + wc * 32 + n * 16 + 4 * fq;
                        const bool ropecol = ((wc & 1) == 0) && (n == 0);
                        if (pn == 0) { st_bf16x4(gq + (size_t)r * 256 + cl, v * 0.125f); }
                        else if (pn == 1) { st_bf16x4(gk + (size_t)r * 256 + cl, v); }
                        else if (pn < 4) { st_bf16x4(gv + (size_t)r * 512 + (pn - 2) * 256 + cl, v); }
                        else if (pn < 6) { st_bf16x4(gr + (size_t)r * 512 + (pn - 4) * 256 + cl, v); }
                        else if (pn < 8) { if (ropecol) v = rope4(v, tab_t, fq); st_bf16x4(bq + (size_t)r * 512 + (pn - 6) * 256 + cl, v * 0.125f); }
                        else if (pn == 8) { if (ropecol) v = rope4(v, tab_t, fq); *(f32x4*)(iq + (size_t)r * 256 + cl) = v; }
                        else {
                            const int reg = bj * 2 + (wc >> 1);
                            const int c64 = cl & 63;
                            if (reg == 0) { if (ropecol) v = rope4(v, tab_t, fq); st_bf16x4(bk + (size_t)r * 64 + c64, v); }
                            else if (reg == 1) { st_bf16x4(bv + (size_t)r * 64 + c64, v); }
                            else if (reg == 2) { if (ropecol) v = rope4(v, tab_t, fq); *(f32x4*)(ik + (size_t)r * 64 + c64) = v; }
                            else if ((wc & 1) == 0) {
                                if (n == 0) *(f32x4*)(alr + (size_t)r * 16 + 4 * fq) = v;
                                else if (fq == 0) *(f32x4*)(iw + (size_t)r * 4) = v * 0.5f;
                            }
                        }
                    }
            }
    }
};

struct EpiRes {
    static constexpr bool PERM = false, AFTER_DRAIN = false;
    const float* base; float* out; bf16_t* xb; float* ssq;
    __device__ __forceinline__ void operator()(const f32x4 (&acc)[2][2][4][2], const Unit& u, int wr, int wc, int fr_in, int fq_in) const {
        int fr = fr_in, fq = fq_in; asm volatile("" : "+v"(fr), "+v"(fq));
#pragma unroll
        for (int ai = 0; ai < 2; ++ai)
#pragma unroll
            for (int m = 0; m < 4; ++m) {
                const int r = u.pm * BM + ai * HALF + wr * 64 + m * 16 + fr;
                float s = 0.f;
#pragma unroll
                for (int bj = 0; bj < 2; ++bj)
#pragma unroll
                    for (int n = 0; n < 2; ++n) {
                        const size_t off = (size_t)r * 1024 + u.pn * BM + bj * HALF + wc * 32 + n * 16 + 4 * fq;
                        const f32x4 x = *(const f32x4*)(base + off) + acc[ai][bj][m][n];
                        *(f32x4*)(out + off) = x; st_bf16x4(xb + off, x);
                        s += (x[0] * x[0] + x[1] * x[1]) + (x[2] * x[2] + x[3] * x[3]);
                    }
                s += __shfl_xor(s, 16); s += __shfl_xor(s, 32);
                if (fq == 0) atomicAdd(ssq + r, s);
            }
    }
};

struct EpiSgu {
    static constexpr bool PERM = false, AFTER_DRAIN = false;
    const float* ssq; bf16_t* z; float* lns; float* lnq;
    __device__ __forceinline__ void operator()(const f32x4 (&acc)[2][2][4][2], const Unit& u, int wr, int wc, int fr_in, int fq_in) const {
        int fr = fr_in, fq = fq_in; asm volatile("" : "+v"(fr), "+v"(fq));
        const bool vhalf = u.pn >= 4;
#pragma unroll
        for (int ai = 0; ai < 2; ++ai)
#pragma unroll
            for (int m = 0; m < 4; ++m) {
                const int r = u.pm * BM + ai * HALF + wr * 64 + m * 16 + fr;
                const float rs = 1.0f / sqrtf(ssq[r] * (1.0f / 1024.0f) + 1e-6f);
                float s = 0.f, q = 0.f;
#pragma unroll
                for (int bj = 0; bj < 2; ++bj)
#pragma unroll
                    for (int n = 0; n < 2; ++n) {
                        f32x4 v = acc[ai][bj][m][n] * rs;
                        v[0] = gelu_tanh_f(v[0]); v[1] = gelu_tanh_f(v[1]); v[2] = gelu_tanh_f(v[2]); v[3] = gelu_tanh_f(v[3]);
                        st_bf16x4(z + (size_t)r * 2048 + u.pn * BM + bj * HALF + wc * 32 + n * 16 + 4 * fq, v);
                        s += (v[0] + v[1]) + (v[2] + v[3]); q += (v[0] * v[0] + v[1] * v[1]) + (v[2] * v[2] + v[3] * v[3]);
                    }
                if (vhalf) {
                    s += __shfl_xor(s, 16); s += __shfl_xor(s, 32); q += __shfl_xor(q, 16); q += __shfl_xor(q, 32);
                    if (fq == 0) { atomicAdd(lns + r, s); atomicAdd(lnq + r, q); }
                }
            }
    }
};

struct EpiConv {
    static constexpr bool PERM = false, AFTER_DRAIN = false;
    const float* ssq; const float* cw; const float* cb; bf16_t* gt; float* hl; float* hf;
    __device__ __forceinline__ void operator()(const f32x4 (&acc)[2][2][4][2], const Unit& u, int wr, int wc, int fr_in, int fq_in) const {
        int fr = fr_in, fq = fq_in; asm volatile("" : "+v"(fr), "+v"(fq));
        const int lane = fq * 16 + fr;
        const int s1 = (lane & 48) | ((fr + 15) & 15), s2 = (lane & 48) | ((fr + 14) & 15);
#pragma unroll
        for (int ai = 0; ai < 2; ++ai) {
            const int blk = u.pm * 4 + ai * 2 + wr;
            float rs[4];
#pragma unroll
            for (int m = 0; m < 4; ++m) rs[m] = 1.0f / sqrtf(ssq[u.pm * BM + ai * HALF + wr * 64 + m * 16 + fr] * (1.0f / 1024.0f) + 1e-6f);
#pragma unroll
            for (int n = 0; n < 2; ++n) {
                asm volatile("" ::: "memory");
                const int g0 = u.pn * 128 + wc * 32 + n * 16 + 4 * fq;
                f32x4 pg1 = {0.f, 0.f, 0.f, 0.f}, pg2 = pg1, pu1 = pg1, pu2 = pg1;
#pragma unroll
                for (int m = 0; m < 4; ++m) {
                    asm volatile("" ::: "memory");
                    const int r = u.pm * BM + ai * HALF + wr * 64 + m * 16 + fr;
                    const f32x4 ag = acc[ai][0][m][n] * rs[m], au = acc[ai][1][m][n] * rs[m];
                    if (m == 3 && fr >= 14) { float* h = hl + (size_t)(blk * 2 + (fr - 14)) * 5632 + g0; *(f32x4*)h = ag; *(f32x4*)(h + 2816) = au; }
                    if (m == 0 && fr < 2) { float* h = hf + (size_t)(blk * 2 + fr) * 5632 + g0; *(f32x4*)h = ag; *(f32x4*)(h + 2816) = au; }
                    f32x4 o;
                    { const f32x4 g1 = shfl4(ag, s1), g2 = shfl4(ag, s2);
                      const f32x4 p1g = fr >= 1 ? g1 : pg1, p2g = fr >= 2 ? g2 : pg2;
                      const f32x4 cg = *(const f32x4*)(cb + g0) + *(const f32x4*)(cw + g0) * p2g + *(const f32x4*)(cw + 5632 + g0) * p1g + *(const f32x4*)(cw + 2 * 5632 + g0) * ag;
                      o[0] = silu_f(cg[0]); o[1] = silu_f(cg[1]); o[2] = silu_f(cg[2]); o[3] = silu_f(cg[3]);
                      pg1 = g1; pg2 = g2; }
                    { const f32x4 u1 = shfl4(au, s1), u2 = shfl4(au, s2);
                      const f32x4 p1u = fr >= 1 ? u1 : pu1, p2u = fr >= 2 ? u2 : pu2;
                      const f32x4 cu = *(const f32x4*)(cb + 2816 + g0) + *(const f32x4*)(cw + 2816 + g0) * p2u + *(const f32x4*)(cw + 5632 + 2816 + g0) * p1u + *(const f32x4*)(cw + 2 * 5632 + 2816 + g0) * au;
                      o = o * cu;
                      pu1 = u1; pu2 = u2; }
                    st_bf16x4(gt + (size_t)r * 2816 + g0, o);
                }
            }
        }
    }
};

template <class Epi, class Sched, bool ALIGN_EPI = false, bool SP2 = false>
__device__ __forceinline__ void gemm_phase(PG8_LAS unsigned char* lds, const Gemm g, const Sched& S, const Epi& E) {
    int tid_ = threadIdx.x; asm volatile("" : "+v"(tid_));
    const int tid = tid_, wid = __builtin_amdgcn_readfirstlane(tid >> 6), lane = tid & 63, wr = wid >> 2, wc = wid & 3, fr = lane & 15, fq = lane >> 4;
    const int K = g.K, nt = K / BK;
    unsigned voffA[2], voffB[2];
#pragma unroll
    for (int i = 0; i < 2; ++i) { int R, C; stage_rc(tid * 16 + i * 8192, R, C); const int Rb = Epi::PERM ? ((R & ~31) + perm32(R & 31)) : R;
        voffA[i] = (unsigned)(R * K + C) * 2u; voffB[i] = (unsigned)(Rb * K + C) * 2u; }
    const size_t kstep = (size_t)(BK * 2);
    const size_t hstep = (size_t)HALF * K * 2;
    const size_t tstep = 2 * hstep;
    const unsigned ldsw = (unsigned)wid * 1024u;
    const int aoff = lds_byte(wr * 64 + fr, fq * 8), boff = lds_byte(wc * 32 + fr, fq * 8);
#define PG8_SA(b, h) (((b) * 2 + (h)) * HTB)
#define PG8_SB(b, h) ((4 + (b) * 2 + (h)) * HTB)
#define PG8_STAGE(bufoff, gbase, voff) do { _Pragma("unroll") for (int _i = 0; _i < 2; ++_i) \
        __builtin_amdgcn_global_load_lds((const unsigned*)((const char*)(gbase) + (voff)[_i]), (PG8_LAS unsigned*)(lds + (bufoff) + ldsw + _i * 8192), 16, 0, 0); } while (0)
#define PG8_LDA(dst, b, h) do { _Pragma("unroll") for (int m = 0; m < 4; ++m) _Pragma("unroll") for (int k = 0; k < 2; ++k) dst[m][k] = *(const PG8_LAS bf16x8*)(lds + PG8_SA(b, h) + aoff + m * 2048 + k * 1024); } while (0)
#define PG8_LDB(dst, b, h) do { _Pragma("unroll") for (int n = 0; n < 2; ++n) _Pragma("unroll") for (int k = 0; k < 2; ++k) dst[n][k] = *(const PG8_LAS bf16x8*)(lds + PG8_SB(b, h) + boff + n * 2048 + k * 1024); } while (0)
#define PG8_MMA(ai, bj, At, Bt) do { __builtin_amdgcn_s_setprio(1); _Pragma("unroll") for (int m = 0; m < 4; ++m) _Pragma("unroll") for (int n = 0; n < 2; ++n) _Pragma("unroll") for (int k = 0; k < 2; ++k) \
        acc[ai][bj][m][n] = __builtin_amdgcn_mfma_f32_16x16x32_bf16(Bt[n][k], At[m][k], acc[ai][bj][m][n], 0, 0, 0); __builtin_amdgcn_s_setprio(0); } while (0)
#define PG8_WAIT_V(n) asm volatile("s_waitcnt vmcnt(" #n ")" ::: "memory")
#define PG8_WAIT_L(n) asm volatile("s_waitcnt lgkmcnt(" #n ")" ::: "memory")
#define PG8_BAR __builtin_amdgcn_s_barrier()
#define PG8_SCHED __builtin_amdgcn_sched_barrier(0)
    Unit cur, nxt; int ui = 0;
    if (!S.next(0, cur)) return;
    f32x4 acc[2][2][4][2];
#pragma unroll
    for (int a = 0; a < 2; ++a)
#pragma unroll
        for (int b = 0; b < 2; ++b)
#pragma unroll
            for (int m = 0; m < 4; ++m)
#pragma unroll
                for (int n = 0; n < 2; ++n) acc[a][b][m][n] = (f32x4){0.f, 0.f, 0.f, 0.f};
    bf16x8 At[4][2], B0[2][2], B1[2][2];
    const char* cA = (const char*)g.A + (size_t)cur.pm * tstep; const char* cB = (const char*)g.Bt + (size_t)cur.pn * tstep;
    S.a_ready(cur);
    if constexpr (SP2) {
        PG8_STAGE(PG8_SB(0, 0), cB, voffB); PG8_STAGE(PG8_SB(0, 1), cB + hstep, voffB); PG8_STAGE(PG8_SA(0, 0), cA, voffA); PG8_STAGE(PG8_SA(0, 1), cA + hstep, voffA);
        if (wr == 1) PG8_BAR;
        PG8_WAIT_V(2); PG8_BAR;
        PG8_STAGE(PG8_SB(1, 0), cB + kstep, voffB); PG8_STAGE(PG8_SA(1, 0), cA + kstep, voffA); PG8_STAGE(PG8_SB(1, 1), cB + hstep + kstep, voffB);
        PG8_WAIT_V(6); PG8_BAR;
    } else {
        PG8_STAGE(PG8_SB(0, 0), cB, voffB); PG8_STAGE(PG8_SA(0, 0), cA, voffA); PG8_STAGE(PG8_SB(0, 1), cB + hstep, voffB); PG8_STAGE(PG8_SA(0, 1), cA + hstep, voffA);
        if (wr == 1) PG8_BAR;
        PG8_WAIT_V(4); PG8_BAR;
        PG8_STAGE(PG8_SB(1, 0), cB + kstep, voffB); PG8_STAGE(PG8_SA(1, 0), cA + kstep, voffA); PG8_STAGE(PG8_SB(1, 1), cB + hstep + kstep, voffB);
        PG8_WAIT_V(6); PG8_BAR;
    }
    for (;;) {
        const bool has_next = S.next(ui + 1, nxt);
        const char* nA = has_next ? (const char*)g.A + (size_t)nxt.pm * tstep : cA; const char* nB = has_next ? (const char*)g.Bt + (size_t)nxt.pn * tstep : cB;
        for (int t = 0; t < nt; t += 2) {
            const bool last = (t == nt - 2);
            const char* a1 = cA + (size_t)(t + 1) * kstep;
            const char* a2 = last ? nA : cA + (size_t)(t + 2) * kstep; const char* b2 = last ? nB : cB + (size_t)(t + 2) * kstep;
            const char* a3 = a2 + kstep; const char* b3 = b2 + kstep;
            if (last && has_next) S.a_ready(nxt);
            if constexpr (SP2) {
            PG8_LDB(B0, 0, 0); PG8_LDB(B1, 0, 1); PG8_SCHED; PG8_LDA(At, 0, 0); PG8_STAGE(PG8_SA(1, 1), a1 + hstep, voffA);
            PG8_WAIT_V(8); PG8_WAIT_L(0); PG8_BAR; PG8_MMA(0, 0, At, B0); PG8_MMA(0, 1, At, B1); PG8_BAR; PG8_SCHED;
            PG8_LDA(At, 0, 1); PG8_STAGE(PG8_SB(0, 0), b2, voffB); PG8_STAGE(PG8_SB(0, 1), b2 + hstep, voffB); PG8_STAGE(PG8_SA(0, 0), a2, voffA);
            PG8_WAIT_V(8); PG8_WAIT_L(0); PG8_BAR; PG8_MMA(1, 0, At, B0); PG8_MMA(1, 1, At, B1); PG8_BAR; PG8_SCHED;
            PG8_LDB(B0, 1, 0); PG8_LDB(B1, 1, 1); PG8_SCHED; PG8_LDA(At, 1, 0); PG8_STAGE(PG8_SA(0, 1), a2 + hstep, voffA);
            PG8_WAIT_V(8); PG8_WAIT_L(0); PG8_BAR; PG8_MMA(0, 0, At, B0); PG8_MMA(0, 1, At, B1); PG8_BAR; PG8_SCHED;
            PG8_LDA(At, 1, 1); PG8_STAGE(PG8_SB(1, 0), b3, voffB); PG8_STAGE(PG8_SB(1, 1), b3 + hstep, voffB); PG8_STAGE(PG8_SA(1, 0), a3, voffA);
            PG8_WAIT_V(8); PG8_WAIT_L(0); PG8_BAR; PG8_MMA(1, 0, At, B0); PG8_MMA(1, 1, At, B1); PG8_BAR; PG8_SCHED;
            } else {
            PG8_LDB(B0, 0, 0); PG8_SCHED; PG8_LDA(At, 0, 0); PG8_STAGE(PG8_SA(1, 1), a1 + hstep, voffA);
            PG8_WAIT_L(8); PG8_BAR; PG8_WAIT_L(0); PG8_MMA(0, 0, At, B0); PG8_BAR; PG8_SCHED;
            PG8_LDB(B1, 0, 1); PG8_STAGE(PG8_SB(0, 0), b2, voffB);
            PG8_BAR; PG8_WAIT_L(0); PG8_MMA(0, 1, At, B1); PG8_BAR;
            PG8_LDA(At, 0, 1); PG8_STAGE(PG8_SA(0, 0), a2, voffA);
            PG8_BAR; PG8_WAIT_L(0); PG8_MMA(1, 0, At, B0); PG8_BAR; PG8_SCHED;
            PG8_STAGE(PG8_SB(0, 1), b2 + hstep, voffB);
            PG8_WAIT_V(6); PG8_BAR; PG8_MMA(1, 1, At, B1); PG8_BAR;
            PG8_LDB(B0, 1, 0); PG8_SCHED; PG8_LDA(At, 1, 0); PG8_STAGE(PG8_SA(0, 1), a2 + hstep, voffA);
            PG8_WAIT_L(8); PG8_BAR; PG8_WAIT_L(0); PG8_MMA(0, 0, At, B0); PG8_BAR; PG8_SCHED;
            PG8_LDB(B1, 1, 1); PG8_STAGE(PG8_SB(1, 0), b3, voffB);
            PG8_BAR; PG8_WAIT_L(0); PG8_MMA(0, 1, At, B1); PG8_BAR;
            PG8_LDA(At, 1, 1); PG8_STAGE(PG8_SA(1, 0), a3, voffA);
            PG8_BAR; PG8_WAIT_L(0); PG8_MMA(1, 0, At, B0); PG8_BAR; PG8_SCHED;
            PG8_STAGE(PG8_SB(1, 1), b3 + hstep, voffB);
            PG8_WAIT_V(6); PG8_BAR; PG8_MMA(1, 1, At, B1); PG8_BAR;
            }
        }
        if constexpr (ALIGN_EPI) { if (wr == 0) PG8_BAR; }
        if constexpr (!Epi::AFTER_DRAIN) { E(acc, cur, wr, wc, fr, fq); S.done(cur); }
        if (!has_next) break;
#pragma unroll
        for (int a = 0; a < 2; ++a)
#pragma unroll
            for (int b = 0; b < 2; ++b)
#pragma unroll
                for (int m = 0; m < 4; ++m)
#pragma unroll
                    for (int n = 0; n < 2; ++n) acc[a][b][m][n] = (f32x4){0.f, 0.f, 0.f, 0.f};
        cur = nxt; cA = nA; cB = nB; ++ui;
        if constexpr (ALIGN_EPI) { if (wr == 1) PG8_BAR; }
    }
    PG8_WAIT_V(0);
    if constexpr (!ALIGN_EPI) { if (wr == 0) PG8_BAR; }
    PG8_BAR;
    if constexpr (Epi::AFTER_DRAIN) { E.fused(acc, cur, wr, wc, fr, fq, lds, wid, lane); S.done(cur); }
#undef PG8_SA
#undef PG8_SB
#undef PG8_STAGE
#undef PG8_LDA
#undef PG8_LDB
#undef PG8_MMA
#undef PG8_WAIT_V
#undef PG8_WAIT_L
#undef PG8_BAR
#undef PG8_SCHED
}
}
#define GAS __attribute__((address_space(1)))
#define LAS __attribute__((address_space(3)))
typedef unsigned short bf16;
typedef unsigned v4u __attribute__((ext_vector_type(4)));
typedef float f32x4 __attribute__((ext_vector_type(4)));
typedef short bf16x8 __attribute__((ext_vector_type(8)));
typedef GAS unsigned gu32;
typedef GAS unsigned long long gu64;
#define RLX_AGENT __ATOMIC_RELAXED, __HIP_MEMORY_SCOPE_AGENT
#define LDS_WAIT() asm volatile("s_waitcnt lgkmcnt(0)" ::: "memory")
#define VM_WAIT() asm volatile("s_waitcnt vmcnt(0)" ::: "memory")
__device__ __forceinline__ unsigned long long rt() { return __builtin_amdgcn_s_memrealtime(); }
__device__ __forceinline__ unsigned f2bf(float f) { unsigned u = __builtin_bit_cast(unsigned, f); return (u + 0x7fffu + ((u >> 16) & 1u)) >> 16; }
__device__ __forceinline__ unsigned pk2(float lo, float hi) { return f2bf(lo) | (f2bf(hi) << 16); }

#define XB_TMO      128
#define XB_XCNT(j)  (256  + 64 * (j))
#define XB_XSUB(j)  (1280 + 64 * (j))
#define XB_XGEN(j)  (2304 + 64 * (j))
#define XB_TOP      3328
#define XB_TOPGEN   3392
#define XCD_BAR_WORDS 3456
#define XB_SPIN_CAP (1u << 18)

__device__ __forceinline__ unsigned xb_ld(unsigned* p)              { return __hip_atomic_load(p, __ATOMIC_RELAXED, __HIP_MEMORY_SCOPE_AGENT); }
__device__ __forceinline__ unsigned xb_add(unsigned* p, unsigned v) { return __hip_atomic_fetch_add(p, v, __ATOMIC_RELAXED, __HIP_MEMORY_SCOPE_AGENT); }
__device__ __forceinline__ unsigned xb_xcc_id() { return (unsigned)__builtin_amdgcn_s_getreg((3 << 11) | 20) & 0xFu; }
#define XB_SPIN(cond, bar) do { unsigned _sp = 0; while (cond) { __builtin_amdgcn_s_sleep(1); \
    if ((++_sp & 255u) == 0u) { if (xb_ld(&(bar)[XB_TMO])) break; if (_sp > XB_SPIN_CAP) { atomicAdd(&(bar)[XB_TMO], 1u); break; } } } } while (0)

struct XcdBarrier {
    unsigned* bar; unsigned x;
    volatile LAS unsigned* st;
};

__device__ __forceinline__ XcdBarrier xcd_barrier_post(unsigned* bar, volatile LAS unsigned* st) {
    XcdBarrier b; b.bar = bar; b.x = xb_xcc_id(); b.st = st;
    if (threadIdx.x == 0) (void)xb_add(&bar[XB_XCNT(b.x)], 1u);
    return b;
}
__device__ __forceinline__ void xcd_barrier_complete(unsigned* bar, unsigned x, unsigned& nloc, unsigned& nx) {
    const unsigned G = gridDim.x * gridDim.y * gridDim.z;
    unsigned sum, cnt, mine, sp = 0u;
    for (;;) {
        sum = 0u; cnt = 0u; mine = 0u;
#pragma unroll
        for (unsigned j = 0; j < 16; ++j) { const unsigned c = xb_ld(&bar[XB_XCNT(j)]); sum += c; cnt += (c > 0u) ? 1u : 0u; mine = (j == x) ? c : mine; }
        if (sum == G) break;
        __builtin_amdgcn_s_sleep(1);
        if ((++sp & 255u) == 0u) { if (xb_ld(&bar[XB_TMO])) break; if (sp > XB_SPIN_CAP) { atomicAdd(&bar[XB_TMO], 1u); break; } }
    }
    nloc = mine > 0u ? mine : 1u; nx = cnt > 0u ? cnt : 1u;
}

__device__ __forceinline__ void xcd_barrier(const XcdBarrier& b) {
    asm volatile("s_waitcnt vmcnt(0)" ::: "memory");
    __syncthreads();
    if (threadIdx.x == 0) {
        unsigned* bar = b.bar;
        __builtin_amdgcn_s_waitcnt(0);
        unsigned nloc = b.st[0], nx = b.st[1];
        if (nloc == 0u) { xcd_barrier_complete(bar, b.x, nloc, nx); b.st[0] = nloc; b.st[1] = nx; }
        const unsigned old = xb_add(&bar[XB_XSUB(b.x)], 1u);
        const unsigned gen = old / nloc;
        if (old + 1u == (gen + 1u) * nloc) {
            __builtin_amdgcn_fence(__ATOMIC_RELEASE, "agent");
            asm volatile("s_waitcnt vmcnt(0)" ::: "memory");
            const unsigned og = xb_add(&bar[XB_TOP], 1u);
            const unsigned tg = og / nx;
            if (og + 1u == (tg + 1u) * nx) xb_add(&bar[XB_TOPGEN], 1u);
            else XB_SPIN(xb_ld(&bar[XB_TOPGEN]) == tg, bar);
            __builtin_amdgcn_fence(__ATOMIC_ACQUIRE, "agent");
            xb_add(&bar[XB_XGEN(b.x)], 1u);
            asm volatile("s_waitcnt vmcnt(0)" ::: "memory");
        } else {
            XB_SPIN(xb_ld(&bar[XB_XGEN(b.x)]) == gen, bar);
            __builtin_amdgcn_fence(__ATOMIC_ACQUIRE, "agent");
            asm volatile("s_waitcnt vmcnt(0)" ::: "memory");
        }
    }
    __syncthreads();
}

constexpr int NWAVES = 8, NTHR = 512;
constexpr int NB = 4, SEQ = 4096, M = NB * SEQ, DM = 1024;
constexpr int IN_W = 2516, NIN = 2560;
constexpr int DFF = 2816, DFF2 = 5632;
constexpr int NUNIT_GLA = NB * 4 * 64;

constexpr size_t MiB = 1u << 20;
constexpr size_t WS_CTL = 0, CTL_ZERO_BYTES = 1 * MiB;
constexpr size_t WS_ROPE = 1 * MiB;
constexpr size_t WS_SSQ = 2 * MiB;
constexpr size_t WS_WIN = 4 * MiB, WS_WO = 9 * MiB, WS_WUP0 = 11 * MiB, WS_WUP1 = 22 * MiB, WS_WDN0 = 33 * MiB, WS_WDN1 = 39 * MiB, WS_WUV = 45 * MiB, WS_WOUT = 49 * MiB;
constexpr size_t WS_XB = 51 * MiB;
constexpr size_t WS_R = 83 * MiB;
constexpr size_t R_GQ = WS_R, R_GK = R_GQ + 8 * MiB, R_GV = R_GK + 8 * MiB, R_GR = R_GV + 16 * MiB, R_BQ = R_GR + 16 * MiB, R_IQ = R_BQ + 16 * MiB, R_BK = R_IQ + 16 * MiB,
                 R_BV = R_BK + 2 * MiB, R_IK = R_BV + 2 * MiB, R_ALR = R_IK + 4 * MiB, R_IW = R_ALR + 1 * MiB, R_DS = R_IW + 1 * MiB, R_DEC = R_DS + 32 * MiB, R_IDX = R_DEC + 1 * MiB,
                 R_AO = R_IDX + 8 * MiB, R_END0 = R_AO + 32 * MiB;
constexpr size_t R_GT = WS_R, R_HL = R_GT + 88 * MiB, R_HF = R_HL + 11 * MiB, R_END1 = R_HF + 11 * MiB;
constexpr size_t R_Z = WS_R, R_SG = R_Z + 64 * MiB, R_END2 = R_SG + 32 * MiB;
constexpr size_t WS_END = 256 * MiB;
static_assert(R_END0 <= WS_END && R_END1 <= WS_END && R_END2 <= WS_END, "d_ws map");
constexpr int CW_BAR = 4096;

constexpr int RING_BYTES = 131072, LDS_BYTES = 147456, LDSCTL_OFF = LDS_BYTES - 512, MISC_OFF = LDSCTL_OFF;

typedef unsigned short bf16;
__device__ __forceinline__ float bf2f(unsigned short h) { return __builtin_bit_cast(float, (unsigned)h << 16); }
__device__ __forceinline__ float wave_sum(float v) {
#pragma unroll
    for (int o = 1; o < 64; o <<= 1) v += __shfl_xor(v, o);
    return v;
}
__device__ __forceinline__ float wave_max(float v) {
#pragma unroll
    for (int o = 1; o < 64; o <<= 1) v = fmaxf(v, __shfl_xor(v, o));
    return v;
}

struct Args { const float* in[20]; float* out; unsigned char* ws; int ph_lo, ph_hi; };

__device__ __forceinline__ int ropeperm(int p) { return p < 16 ? ((p >> 1) + 8 * (p & 1)) : p; }
__device__ __forceinline__ int win_src(int n) {
    if (n < 1536) return n;
    if (n < 2048) { const int c = n - 1536; return 1552 + (c & ~63) + ropeperm(c & 63); }
    if (n < 2304) { const int c = n - 2048; return 2192 + (c & ~63) + ropeperm(c & 63); }
    const int c = n - 2304;
    if (c < 64) return 2064 + ropeperm(c);
    if (c < 128) return 2128 + (c - 64);
    if (c < 192) return 2448 + ropeperm(c - 128);
    if (c < 208) return 1536 + (c - 192);
    if (c < 212) return 2512 + (c - 208);
    return -1;
}
__device__ __forceinline__ int up_src(int r) { const int pn = r >> 8, w = r & 255; return (w >> 7) * DFF + pn * 128 + (w & 127); }

template <int MAP  >
__device__ __forceinline__ void transpose_item(const float* W, int K, int Nsrc, int Ndst, const float* g, bf16* WT, float* scr, int item, int lane) {
    const int nblk = Ndst / 32, kb = item / nblk, nb = item % nblk, k0 = 64 * kb, n0 = 32 * nb;
    const int nd = n0 + (lane & 31);
    const int src = MAP == 0 ? nd : (MAP == 1 ? win_src(nd) : up_src(nd));
#pragma unroll 8
    for (int i = 0; i < 32; ++i) { const int kk = 2 * i + (lane >> 5);
        float v = 0.f; if (src >= 0) { v = W[(size_t)(k0 + kk) * Nsrc + src]; if (g) v *= g[k0 + kk]; }
        scr[kk * 33 + (lane & 31)] = v; }
    LDS_WAIT(); asm volatile("" ::: "memory");
    const int c = lane & 7;
#pragma unroll
    for (int j = 0; j < 4; ++j) { const int n = (lane >> 3) + 8 * j; const float* s = scr + (8 * c) * 33 + n;
        v4u o; o.x = pk2(s[0 * 33], s[1 * 33]); o.y = pk2(s[2 * 33], s[3 * 33]); o.z = pk2(s[4 * 33], s[5 * 33]); o.w = pk2(s[6 * 33], s[7 * 33]);
        *(v4u*)(WT + (size_t)(n0 + n) * K + k0 + 8 * c) = o; }
    LDS_WAIT(); asm volatile("" ::: "memory");
}

__device__ __forceinline__ void sincos_d(double a, float& c, float& s) {
    const double k = __builtin_rint(a * 0.15915494309189535);
    double r = a - k * 6.283185307179586; r -= k * 2.4492935982947064e-16;
    const double r2 = r * r;
    double sp = -1.0 / 51090942171709440000.0, cp = 1.0 / 1124000727777607680000.0;
    sp = sp * r2 + 1.0 / 121645100408832000.0;  cp = cp * r2 - 1.0 / 2432902008176640000.0;
    sp = sp * r2 - 1.0 / 355687428096000.0;     cp = cp * r2 + 1.0 / 6402373705728000.0;
    sp = sp * r2 + 1.0 / 1307674368000.0;       cp = cp * r2 - 1.0 / 20922789888000.0;
    sp = sp * r2 - 1.0 / 6227020800.0;          cp = cp * r2 + 1.0 / 87178291200.0;
    sp = sp * r2 + 1.0 / 39916800.0;            cp = cp * r2 - 1.0 / 479001600.0;
    sp = sp * r2 - 1.0 / 362880.0;              cp = cp * r2 + 1.0 / 3628800.0;
    sp = sp * r2 + 1.0 / 5040.0;                cp = cp * r2 - 1.0 / 40320.0;
    sp = sp * r2 - 1.0 / 120.0;                 cp = cp * r2 + 1.0 / 720.0;
    sp = sp * r2 + 1.0 / 6.0;                   cp = cp * r2 - 1.0 / 24.0;
    cp = cp * r2 + 0.5;
    s = (float)(r - r * r2 * sp); c = (float)(1.0 - r2 * cp);
}

__device__ __forceinline__ void p0_prologue(const Args& a, unsigned char* lds, int vcu, int G, int tid) {
    unsigned char* ws = a.ws;
    const int lane = tid & 63, wave = tid >> 6;
    float* scr = (float*)(lds + wave * 16384);
    const int gw = vcu * NWAVES + wave, NGW = G * NWAVES;
    constexpr int I_WIN = 16 * (NIN / 32), I_WO = 16 * 32, I_WUP = 16 * (DFF2 / 32), I_WDN = (DFF / 64) * 32, I_WUV = 16 * 64, I_WOUT = 16 * 32;
    constexpr int NITEMS = I_WIN + I_WO + 2 * I_WUP + 2 * I_WDN + I_WUV + I_WOUT;
    for (int it = gw; it < NITEMS; it += NGW) {
        int r = it;
        if (r < I_WIN) { transpose_item<1>(a.in[2], 1024, IN_W, NIN, a.in[1], (bf16*)(ws + WS_WIN), scr, r, lane); continue; } r -= I_WIN;
        if (r < I_WO) { transpose_item<0>(a.in[6], 1024, 1024, 1024, nullptr, (bf16*)(ws + WS_WO), scr, r, lane); continue; } r -= I_WO;
        if (r < I_WUP) { transpose_item<2>(a.in[15], 1024, DFF2, DFF2, a.in[14], (bf16*)(ws + WS_WUP0), scr, r, lane); continue; } r -= I_WUP;
        if (r < I_WUP) { transpose_item<2>(a.in[15] + (size_t)1024 * DFF2, 1024, DFF2, DFF2, a.in[14] + 1024, (bf16*)(ws + WS_WUP1), scr, r, lane); continue; } r -= I_WUP;
        if (r < I_WDN) { transpose_item<0>(a.in[18], DFF, 1024, 1024, nullptr, (bf16*)(ws + WS_WDN0), scr, r, lane); continue; } r -= I_WDN;
        if (r < I_WDN) { transpose_item<0>(a.in[18] + (size_t)DFF * 1024, DFF, 1024, 1024, nullptr, (bf16*)(ws + WS_WDN1), scr, r, lane); continue; } r -= I_WDN;
        if (r < I_WUV) { transpose_item<0>(a.in[8], 1024, 2048, 2048, a.in[7], (bf16*)(ws + WS_WUV), scr, r, lane); continue; } r -= I_WUV;
        transpose_item<0>(a.in[13], 1024, 1024, 1024, nullptr, (bf16*)(ws + WS_WOUT), scr, r, lane);
    }
    float* ssq = (float*)(ws + WS_SSQ);
    bf16* xb = (bf16*)(ws + WS_XB);
    for (int m = gw; m < M; m += NGW) {
        const f32x4* xr = (const f32x4*)(a.in[0] + (size_t)m * DM) + lane;
        unsigned long long* o8 = (unsigned long long*)(xb + (size_t)m * DM) + lane;
        float s = 0.f;
#pragma unroll
        for (int j = 0; j < 4; ++j) { const f32x4 v = xr[64 * j]; s += (v.x * v.x + v.y * v.y) + (v.z * v.z + v.w * v.w);
            o8[64 * j] = (unsigned long long)pk2(v.x, v.y) | ((unsigned long long)pk2(v.z, v.w) << 32); }
        s = wave_sum(s);
        if (lane == 0) ssq[m] = s;
    }
    const int gt = vcu * NTHR + tid, NGT = G * NTHR;
    for (int i = gt; i < 6 * M; i += NGT) ssq[M + i] = 0.f;
    float* rope = (float*)(ws + WS_ROPE);
    for (int i = gt; i < SEQ * 8; i += NGT) {
        const int t = i >> 3, j = i & 7;
        const double inv = j == 0 ? 1.0 : j == 1 ? 0.19392274474868576 : j == 2 ? 0.03760603093086393 : j == 3 ? 0.007292664737217109 : j == 4 ? 0.001414213562373095
                         : j == 5 ? 0.0002742481756762073 : j == 6 ? 5.318295896944988e-05 : 1.031338537721246e-05;
        float c, s; sincos_d((double)t * inv, c, s);
        rope[2 * i] = c; rope[2 * i + 1] = s;
    }
}

__device__ __forceinline__ float logsigmoid_f(float z) { return fminf(z, 0.f) - log1pf(__expf(-fabsf(z))); }

__device__ __forceinline__ void gla_cumdecay(float* bl, const float* alr, const float* wa2, const float* ba, int row0, int h, int tid) {
    { const int c = tid >> 3, d0 = (tid & 7) * 8;
      float z[8];
#pragma unroll
      for (int j = 0; j < 8; ++j) z[j] = ba[h * 64 + d0 + j];
      const float* ar = alr + (size_t)(row0 + c) * 16;
#pragma unroll
      for (int r = 0; r < 16; ++r) { const float x = ar[r];
#pragma unroll
          for (int j = 0; j < 8; ++j) z[j] += x * wa2[r * 256 + h * 64 + d0 + j]; }
#pragma unroll
      for (int j = 0; j < 8; ++j) bl[c * 64 + d0 + j] = logsigmoid_f(z[j]) * (1.0f / 16.0f); }
    __syncthreads();
    if (tid < 64) { float s = 0.f; for (int c = 0; c < 64; ++c) { s += bl[c * 64 + tid]; bl[c * 64 + tid] = s; } }
    __syncthreads();
}

__device__ __forceinline__ void gla_phase_a(const Args& a, unsigned char* lds, int vcu, int G, int tid) {
    unsigned char* ws = a.ws;
    float* bl = (float*)lds; float* kl = bl + 4096; float* vl = kl + 4096;
    const bf16* gk = (const bf16*)(ws + R_GK); const bf16* gv = (const bf16*)(ws + R_GV);
    const float* alr = (const float*)(ws + R_ALR);
    float* ds = (float*)(ws + R_DS); float* dec = (float*)(ws + R_DEC);
    for (int unit = vcu; unit < NUNIT_GLA; unit += G) {
        const int bb = unit >> 8, h = (unit >> 6) & 3, n = unit & 63, row0 = bb * SEQ + n * 64;
        gla_cumdecay(bl, alr, a.in[3], a.in[4], row0, h, tid);
        { const int c = tid >> 3, d0 = (tid & 7) * 8, e0 = (tid & 7) * 16;
#pragma unroll
          for (int j = 0; j < 8; ++j) kl[c * 64 + d0 + j] = bf2f(gk[(size_t)(row0 + c) * 256 + h * 64 + d0 + j]) * __expf(bl[63 * 64 + d0 + j] - bl[c * 64 + d0 + j]);
#pragma unroll
          for (int j = 0; j < 16; ++j) vl[c * 128 + e0 + j] = bf2f(gv[(size_t)(row0 + c) * 512 + h * 128 + e0 + j]); }
        __syncthreads();
        { const int d = tid >> 3, e0 = (tid & 7) * 16;
          float acc[16];
#pragma unroll
          for (int j = 0; j < 16; ++j) acc[j] = 0.f;
          for (int c = 0; c < 64; ++c) { const float kv = kl[c * 64 + d];
#pragma unroll
              for (int j = 0; j < 16; ++j) acc[j] += kv * vl[c * 128 + e0 + j]; }
          float* o = ds + (size_t)unit * 8192 + d * 128 + e0;
#pragma unroll
          for (int j = 0; j < 16; j += 4) *(f32x4*)(o + j) = (f32x4){acc[j], acc[j + 1], acc[j + 2], acc[j + 3]}; }
        if (tid < 64) dec[unit * 64 + tid] = __expf(bl[63 * 64 + tid]);
        __syncthreads();
    }
}

__device__ __forceinline__ void gla_scan(const Args& a, int vcu, int G, int tid) {
    float* ds = (float*)(a.ws + R_DS); const float* dec = (const float*)(a.ws + R_DEC);
    for (int e = vcu * NTHR + tid; e < 16 * 8192; e += G * NTHR) {
        const int bh = e >> 13, de = e & 8191, d = de >> 7;
        float S = 0.f;
#pragma unroll 8
        for (int n = 0; n < 64; ++n) { const int unit = bh * 64 + n; float* p = ds + (size_t)unit * 8192 + de;
            const float t = *p; const float dc = dec[unit * 64 + d]; *p = S; S = dc * S + t; }
    }
}

__device__ __forceinline__ void gla_phase_b(const Args& a, unsigned char* lds, int vcu, int G, int tid) {
    unsigned char* ws = a.ws;
    float* bl = (float*)lds; float* qd = bl + 4096; float* kd = qd + 64 * 65; float* qb = kd + 64 * 65; float* vl = qb + 4096; float* att = vl + 8192;
    const bf16* gq = (const bf16*)(ws + R_GQ); const bf16* gk = (const bf16*)(ws + R_GK); const bf16* gv = (const bf16*)(ws + R_GV); const bf16* gr = (const bf16*)(ws + R_GR);
    const float* alr = (const float*)(ws + R_ALR); const float* sp = (const float*)(ws + R_DS);
    bf16* ao = (bf16*)(ws + R_AO); const float* hg = a.in[5];
    for (int unit = vcu; unit < NUNIT_GLA; unit += G) {
        const int bb = unit >> 8, h = (unit >> 6) & 3, n = unit & 63, row0 = bb * SEQ + n * 64;
        gla_cumdecay(bl, alr, a.in[3], a.in[4], row0, h, tid);
        { const int c = tid >> 3, d0 = (tid & 7) * 8, e0 = (tid & 7) * 16;
#pragma unroll
          for (int j = 0; j < 8; ++j) { const int d = d0 + j; const float bv = bl[c * 64 + d], bm = bl[32 * 64 + d];
              const float q = bf2f(gq[(size_t)(row0 + c) * 256 + h * 64 + d]), k = bf2f(gk[(size_t)(row0 + c) * 256 + h * 64 + d]);
              qd[c * 65 + d] = q * __expf(bv - bm); kd[c * 65 + d] = k * __expf(bm - bv); qb[c * 64 + d] = q * __expf(bv); }
#pragma unroll
          for (int j = 0; j < 16; ++j) vl[c * 128 + e0 + j] = bf2f(gv[(size_t)(row0 + c) * 512 + h * 128 + e0 + j]); }
        __syncthreads();
        { const int i = tid >> 3, jg = tid & 7;
          float acc[8];
#pragma unroll
          for (int jj = 0; jj < 8; ++jj) acc[jj] = 0.f;
          for (int d = 0; d < 64; ++d) { const float qv = qd[i * 65 + d];
#pragma unroll
              for (int jj = 0; jj < 8; ++jj) acc[jj] += qv * kd[(jj * 8 + jg) * 65 + d]; }
#pragma unroll
          for (int jj = 0; jj < 8; ++jj) { const int j = jj * 8 + jg; att[i * 65 + j] = (j <= i) ? acc[jj] : 0.f; } }
        __syncthreads();
        { const int i = tid >> 3, eg = tid & 7, e0 = eg * 16;
          float acc[16];
#pragma unroll
          for (int j = 0; j < 16; ++j) acc[j] = 0.f;
          for (int j = 0; j <= i; ++j) { const float av = att[i * 65 + j];
#pragma unroll
              for (int e = 0; e < 16; ++e) acc[e] += av * vl[j * 128 + e0 + e]; }
          const float* S = sp + (size_t)unit * 8192 + e0;
          for (int d = 0; d < 64; ++d) { const float qv = qb[i * 64 + d];
              const f32x4 s0 = *(const f32x4*)(S + d * 128), s1 = *(const f32x4*)(S + d * 128 + 4), s2 = *(const f32x4*)(S + d * 128 + 8), s3 = *(const f32x4*)(S + d * 128 + 12);
              acc[0] += qv * s0[0]; acc[1] += qv * s0[1]; acc[2] += qv * s0[2]; acc[3] += qv * s0[3];
              acc[4] += qv * s1[0]; acc[5] += qv * s1[1]; acc[6] += qv * s1[2]; acc[7] += qv * s1[3];
              acc[8] += qv * s2[0]; acc[9] += qv * s2[1]; acc[10] += qv * s2[2]; acc[11] += qv * s2[3];
              acc[12] += qv * s3[0]; acc[13] += qv * s3[1]; acc[14] += qv * s3[2]; acc[15] += qv * s3[3]; }
          float ss = 0.f;
#pragma unroll
          for (int e = 0; e < 16; ++e) ss += acc[e] * acc[e];
          ss += __shfl_xor(ss, 1); ss += __shfl_xor(ss, 2); ss += __shfl_xor(ss, 4);
          const float rs = 1.0f / sqrtf(ss * (1.0f / 128.0f) + 1e-6f);
          const size_t row = (size_t)(row0 + i);
          unsigned w[8];
#pragma unroll
          for (int e = 0; e < 16; e += 2) {
              const float g0 = bf2f(gr[row * 512 + h * 128 + e0 + e]), g1 = bf2f(gr[row * 512 + h * 128 + e0 + e + 1]);
              const float y0 = acc[e] * rs * hg[e0 + e] * pg8::silu_f(g0), y1 = acc[e + 1] * rs * hg[e0 + e + 1] * pg8::silu_f(g1);
              w[e >> 1] = pk2(y0, y1); }
          v4u* o = (v4u*)(ao + row * 1024 + h * 128 + e0);
          o[0] = (v4u){w[0], w[1], w[2], w[3]}; o[1] = (v4u){w[4], w[5], w[6], w[7]}; }
        __syncthreads();
    }
}

__device__ __forceinline__ unsigned f2key(float f) { const unsigned u = __builtin_bit_cast(unsigned, f); return (u & 0x80000000u) ? ~u : (u | 0x80000000u); }

__device__ __forceinline__ void dsa_select(const Args& a, unsigned char* lds, int vcu, int G, int tid) {
    unsigned char* ws = a.ws;
    const int lane = tid & 63, wave = tid >> 6;
    float* qs = (float*)(lds + wave * 1024);
    unsigned* sc = (unsigned*)(lds + 8192 + wave * 16384);
    const float* iq = (const float*)(ws + R_IQ); const float* ik = (const float*)(ws + R_IK); const float* iw = (const float*)(ws + R_IW);
    unsigned short* idx = (unsigned short*)(ws + R_IDX);
    const int gw = vcu * NWAVES + wave, NGW = G * NWAVES;
    for (int p = gw; p < M / 2; p += NGW) {
#pragma unroll 1
        for (int half = 0; half < 2; ++half) {
            const int bb = p >> 11, x = p & 2047, t = half ? (SEQ - 1 - x) : x;
            const size_t q = (size_t)bb * SEQ + t;
            unsigned short* out = idx + q * 256;
            if (t < 256) {
#pragma unroll
                for (int j = 0; j < 4; ++j) { const int kk = j * 64 + lane; out[kk] = (unsigned short)(kk <= t ? kk : 0xFFFF); }
                continue;
            }
#pragma unroll
            for (int j = 0; j < 4; ++j) qs[j * 64 + lane] = iq[q * 256 + j * 64 + lane];
            const float w0 = iw[q * 4 + 0], w1 = iw[q * 4 + 1], w2 = iw[q * 4 + 2], w3 = iw[q * 4 + 3];
            LDS_WAIT(); asm volatile("" ::: "memory");
            const int ntile = (t >> 6) + 1;
            for (int jt = 0; jt < ntile; ++jt) {
                const int key = jt * 64 + lane;
                const f32x4* kr = (const f32x4*)(ik + ((size_t)bb * SEQ + (key <= t ? key : t)) * 64);
                float d0 = 0.f, d1 = 0.f, d2 = 0.f, d3 = 0.f;
#pragma unroll
                for (int c = 0; c < 16; ++c) { const f32x4 kv = kr[c];
                    const f32x4 q0 = *(const f32x4*)(qs + 4 * c), q1 = *(const f32x4*)(qs + 64 + 4 * c), q2 = *(const f32x4*)(qs + 128 + 4 * c), q3 = *(const f32x4*)(qs + 192 + 4 * c);
                    d0 += kv[0] * q0[0] + kv[1] * q0[1] + kv[2] * q0[2] + kv[3] * q0[3];
                    d1 += kv[0] * q1[0] + kv[1] * q1[1] + kv[2] * q1[2] + kv[3] * q1[3];
                    d2 += kv[0] * q2[0] + kv[1] * q2[1] + kv[2] * q2[2] + kv[3] * q2[3];
                    d3 += kv[0] * q3[0] + kv[1] * q3[1] + kv[2] * q3[2] + kv[3] * q3[3]; }
                const float s = (w0 * fmaxf(d0, 0.f) + w1 * fmaxf(d1, 0.f)) + (w2 * fmaxf(d2, 0.f) + w3 * fmaxf(d3, 0.f)) + 0.0f;
                sc[key] = key <= t ? f2key(s) : 0u;
            }
            LDS_WAIT(); asm volatile("" ::: "memory");
            unsigned u[64];
#pragma unroll
            for (int j = 0; j < 64; ++j) u[j] = (j < ntile) ? sc[j * 64 + lane] : 0u;
            unsigned T = 0u;
#pragma unroll 1
            for (int bit = 31; bit >= 0; --bit) {
                const unsigned cand = T | (1u << bit);
                int cnt = 0;
#pragma unroll
                for (int j = 0; j < 64; ++j) cnt += __popcll(__ballot(u[j] >= cand));
                if (cnt >= 256) T = cand;
                if (cnt == 256) break;
            }
            int ngt = 0;
#pragma unroll
            for (int j = 0; j < 64; ++j) ngt += __popcll(__ballot(u[j] > T));
            const int need = 256 - ngt;
            const unsigned long long lt = (1ull << lane) - 1ull;
            int base = 0, eqt = 0;
#pragma unroll
            for (int j = 0; j < 64; ++j) {
                const bool eq = (u[j] == T);
                const unsigned long long me = __ballot(eq);
                const bool take = (u[j] > T) || (eq && (eqt + __popcll(me & lt) < need));
                const unsigned long long mf = __ballot(take);
                if (take) out[base + __popcll(mf & lt)] = (unsigned short)(j * 64 + lane);
                base += __popcll(mf); eqt += __popcll(me);
            }
        }
    }
}

__device__ __forceinline__ void dsa_attend(const Args& a, unsigned char* lds, int vcu, int G, int tid) {
    unsigned char* ws = a.ws;
    const int lane = tid & 63, wave = tid >> 6;
    float* qs = (float*)(lds + wave * 12288);
    float* ps = qs + 512;
    int* ks = (int*)(ps + 2048);
    const bf16* bq = (const bf16*)(ws + R_BQ); const bf16* bk = (const bf16*)(ws + R_BK); const bf16* bv = (const bf16*)(ws + R_BV);
    const unsigned short* idx = (const unsigned short*)(ws + R_IDX);
    bf16* ao = (bf16*)(ws + R_AO);
    const int gw = vcu * NWAVES + wave, NGW = G * NWAVES;
    for (int p = gw; p < M / 2; p += NGW) {
#pragma unroll 1
        for (int half = 0; half < 2; ++half) {
            const int bb = p >> 11, x = p & 2047, t = half ? (SEQ - 1 - x) : x;
            const size_t q = (size_t)bb * SEQ + t;
            const int cnt = t < 255 ? t + 1 : 256;
#pragma unroll
            for (int j = 0; j < 8; ++j) qs[j * 64 + lane] = bf2f(bq[q * 512 + j * 64 + lane]);
            LDS_WAIT(); asm volatile("" ::: "memory");
#pragma unroll 1
            for (int r = 0; r < 4; ++r) {
                asm volatile("" ::: "memory");
                const int kk = r * 64 + lane; const bool valid = kk < cnt;
                const int key = valid ? (int)idx[q * 256 + kk] : 0;
                ks[kk] = key;
                const v4u* kr = (const v4u*)(bk + ((size_t)bb * SEQ + key) * 64);
                float kf[64];
#pragma unroll
                for (int c = 0; c < 8; ++c) { const v4u kw = kr[c];
                    kf[8 * c + 0] = __builtin_bit_cast(float, kw.x << 16); kf[8 * c + 1] = __builtin_bit_cast(float, kw.x & 0xffff0000u);
                    kf[8 * c + 2] = __builtin_bit_cast(float, kw.y << 16); kf[8 * c + 3] = __builtin_bit_cast(float, kw.y & 0xffff0000u);
                    kf[8 * c + 4] = __builtin_bit_cast(float, kw.z << 16); kf[8 * c + 5] = __builtin_bit_cast(float, kw.z & 0xffff0000u);
                    kf[8 * c + 6] = __builtin_bit_cast(float, kw.w << 16); kf[8 * c + 7] = __builtin_bit_cast(float, kw.w & 0xffff0000u); }
                float sh[8];
#pragma unroll
                for (int h = 0; h < 8; ++h) { float acc = 0.f;
#pragma unroll
                    for (int c = 0; c < 16; ++c) { const f32x4 qa = *(const f32x4*)(qs + h * 64 + 4 * c);
                        acc += (kf[4 * c] * qa[0] + kf[4 * c + 1] * qa[1]) + (kf[4 * c + 2] * qa[2] + kf[4 * c + 3] * qa[3]); }
                    sh[h] = valid ? acc : -INFINITY;
                    asm volatile("" ::: "memory"); }
                float* pp = ps + kk * 8;
                *(f32x4*)pp = (f32x4){sh[0], sh[1], sh[2], sh[3]}; *(f32x4*)(pp + 4) = (f32x4){sh[4], sh[5], sh[6], sh[7]};
            }
            LDS_WAIT(); asm volatile("" ::: "memory");
            float s[4][8];
#pragma unroll
            for (int r = 0; r < 4; ++r) { const float* pp = ps + (r * 64 + lane) * 8; const f32x4 pa = *(const f32x4*)pp, pb = *(const f32x4*)(pp + 4);
                s[r][0] = pa[0]; s[r][1] = pa[1]; s[r][2] = pa[2]; s[r][3] = pa[3]; s[r][4] = pb[0]; s[r][5] = pb[1]; s[r][6] = pb[2]; s[r][7] = pb[3]; }
            float inv[8];
#pragma unroll
            for (int h = 0; h < 8; ++h) {
                float mx = fmaxf(fmaxf(s[0][h], s[1][h]), fmaxf(s[2][h], s[3][h])); mx = wave_max(mx);
                float sum = 0.f;
#pragma unroll
                for (int r = 0; r < 4; ++r) { const float pv = __expf(s[r][h] - mx); s[r][h] = pv; sum += pv; }
                inv[h] = 1.0f / wave_sum(sum);
            }
#pragma unroll
            for (int r = 0; r < 4; ++r) { float* pp = ps + (r * 64 + lane) * 8;
                *(f32x4*)pp = (f32x4){s[r][0], s[r][1], s[r][2], s[r][3]}; *(f32x4*)(pp + 4) = (f32x4){s[r][4], s[r][5], s[r][6], s[r][7]}; }
            LDS_WAIT(); asm volatile("" ::: "memory");
            float o[8];
#pragma unroll
            for (int h = 0; h < 8; ++h) o[h] = 0.f;
            const bf16* vb = bv + (size_t)bb * SEQ * 64 + lane;
#pragma unroll 4
            for (int kk = 0; kk < cnt; ++kk) {
                const float v = bf2f(vb[(size_t)ks[kk] * 64]);
                const f32x4 pa = *(const f32x4*)(ps + kk * 8), pb = *(const f32x4*)(ps + kk * 8 + 4);
                o[0] += pa[0] * v; o[1] += pa[1] * v; o[2] += pa[2] * v; o[3] += pa[3] * v; o[4] += pb[0] * v; o[5] += pb[1] * v; o[6] += pb[2] * v; o[7] += pb[3] * v;
            }
#pragma unroll
            for (int h = 0; h < 8; ++h) ao[q * 1024 + 512 + h * 64 + lane] = (bf16)f2bf(o[h] * inv[h]);
            LDS_WAIT(); asm volatile("" ::: "memory");
        }
    }
}

__device__ __forceinline__ void ffn_fixup(const Args& a, int layer, int vcu, int G, int tid) {
    unsigned char* ws = a.ws;
    const float* hl = (const float*)(ws + R_HL); const float* hf = (const float*)(ws + R_HF);
    const float* cw = a.in[16] + (size_t)layer * 3 * DFF2; const float* cb = a.in[17] + (size_t)layer * DFF2;
    bf16* gt = (bf16*)(ws + R_GT);
    for (int it = vcu * NTHR + tid; it < 256 * 2 * (DFF / 4); it += G * NTHR) {
        const int cg = it % (DFF / 4), rr = (it / (DFF / 4)) & 1, blk = it / (2 * (DFF / 4));
        const int g0 = cg * 4; const bool bstart = (blk & 63) == 0;
        const f32x4 z4 = {0.f, 0.f, 0.f, 0.f};
        f32x4 a0g, a0u, a1g, a1u, a2g, a2u;
        { const float* h0 = hf + (size_t)(blk * 2 + rr) * DFF2 + g0; a0g = *(const f32x4*)h0; a0u = *(const f32x4*)(h0 + DFF); }
        if (rr == 1) {
            const float* h1 = hf + (size_t)(blk * 2) * DFF2 + g0; a1g = *(const f32x4*)h1; a1u = *(const f32x4*)(h1 + DFF);
            if (bstart) { a2g = z4; a2u = z4; } else { const float* h2 = hl + (size_t)((blk - 1) * 2 + 1) * DFF2 + g0; a2g = *(const f32x4*)h2; a2u = *(const f32x4*)(h2 + DFF); }
        } else {
            if (bstart) { a1g = z4; a1u = z4; a2g = z4; a2u = z4; }
            else { const float* h1 = hl + (size_t)((blk - 1) * 2 + 1) * DFF2 + g0; a1g = *(const f32x4*)h1; a1u = *(const f32x4*)(h1 + DFF);
                   const float* h2 = hl + (size_t)((blk - 1) * 2) * DFF2 + g0; a2g = *(const f32x4*)h2; a2u = *(const f32x4*)(h2 + DFF); }
        }
        const f32x4 cgv = *(const f32x4*)(cb + g0) + *(const f32x4*)(cw + g0) * a2g + *(const f32x4*)(cw + DFF2 + g0) * a1g + *(const f32x4*)(cw + 2 * DFF2 + g0) * a0g;
        const f32x4 cuv = *(const f32x4*)(cb + DFF + g0) + *(const f32x4*)(cw + DFF + g0) * a2u + *(const f32x4*)(cw + DFF2 + DFF + g0) * a1u + *(const f32x4*)(cw + 2 * DFF2 + DFF + g0) * a0u;
        f32x4 o; o[0] = pg8::silu_f(cgv[0]) * cuv[0]; o[1] = pg8::silu_f(cgv[1]) * cuv[1]; o[2] = pg8::silu_f(cgv[2]) * cuv[2]; o[3] = pg8::silu_f(cgv[3]) * cuv[3];
        pg8::st_bf16x4(gt + (size_t)(blk * 64 + rr) * DFF + g0, o);
    }
}

__device__ __forceinline__ void sgu_mix(const Args& a, unsigned char* lds, int vcu, int G, int tid) {
    unsigned char* ws = a.ws;
    float* vn = (float*)lds;
    const bf16* z = (const bf16*)(ws + R_Z); bf16* sg = (bf16*)(ws + R_SG);
    const float* lns = (const float*)(ws + WS_SSQ) + 5 * M; const float* lnq = lns + M;
    const float* lg = a.in[9]; const float* lb = a.in[10]; const float* wsp = a.in[11]; const float* bs = a.in[12];
    for (int unit = vcu; unit < 1024; unit += G) {
        const int g = unit & 7, ci = unit >> 3, row0 = ci * 128;
        { const int s = tid >> 2, c0 = (tid & 3) * 32; const size_t row = (size_t)(row0 + s);
          const float mean = lns[row] * (1.0f / 1024.0f); const float var = lnq[row] * (1.0f / 1024.0f) - mean * mean; const float rstd = 1.0f / sqrtf(var + 1e-5f);
#pragma unroll 8
          for (int j = 0; j < 32; ++j) { const int c = g * 128 + c0 + j;
              vn[s * 128 + c0 + j] = (bf2f(z[row * 2048 + 1024 + c]) - mean) * rstd * lg[c] + lb[c]; } }
        __syncthreads();
        { const int t = tid >> 2, c0 = (tid & 3) * 32;
          float acc[32];
#pragma unroll
          for (int j = 0; j < 32; ++j) acc[j] = 0.f;
          const float* wr = wsp + ((size_t)g * 128 + t) * 128;
          for (int s = 0; s <= t; ++s) { const float w = wr[s];
#pragma unroll
              for (int j = 0; j < 32; ++j) acc[j] += w * vn[s * 128 + c0 + j]; }
          const float bias = bs[g * 128 + t];
          const size_t row = (size_t)(row0 + t);
#pragma unroll
          for (int j = 0; j < 32; j += 4) { f32x4 o;
#pragma unroll
              for (int e = 0; e < 4; ++e) o[e] = bf2f(z[row * 2048 + g * 128 + c0 + j + e]) * (acc[j + e] + bias);
              pg8::st_bf16x4(sg + row * 1024 + g * 128 + c0 + j, o); } }
        __syncthreads();
    }
}

__device__ __forceinline__ void final_norm(const Args& a, int vcu, int G, int tid) {
    const int lane = tid & 63, wave = tid >> 6;
    const float* g = a.in[19];
    for (int m = vcu * NWAVES + wave; m < M; m += G * NWAVES) {
        f32x4* xr = (f32x4*)(a.out + (size_t)m * DM) + lane;
        f32x4 v[4]; float s = 0.f;
#pragma unroll
        for (int j = 0; j < 4; ++j) { v[j] = xr[64 * j]; s += (v[j].x * v[j].x + v[j].y * v[j].y) + (v[j].z * v[j].z + v[j].w * v[j].w); }
        const float rs = 1.0f / sqrtf(wave_sum(s) * (1.0f / 1024.0f) + 1e-6f);
#pragma unroll
        for (int j = 0; j < 4; ++j) xr[64 * j] = v[j] * rs * *((const f32x4*)g + lane + 64 * j);
    }
}

__device__ __forceinline__ int opq(int x) { asm volatile("" : "+s"(x)); return x; }
__device__ __forceinline__ int opqv(int x) { asm volatile("" : "+v"(x)); return x; }
constexpr int NPHASE = 16;
__global__ void __launch_bounds__(NTHR, 2) fwd_megakernel(Args args) {
    extern __shared__ __attribute__((aligned(16))) unsigned char lds[];
    const int tid = threadIdx.x;
    const int G = gridDim.x; const int bx = blockIdx.x;
    const int vcu = (G % 8 == 0) ? (bx % 8) * (G / 8) + bx / 8 : bx;
    unsigned char* ws = args.ws;
    for (int u = tid; u < (LDS_BYTES - LDSCTL_OFF) / 4; u += NTHR) ((LAS unsigned*)((LAS unsigned char*)lds + LDSCTL_OFF))[u] = 0u;
    __syncthreads();
    XcdBarrier bar; bar.bar = (unsigned*)(ws + WS_CTL) + CW_BAR; bar.x = 0; bar.st = nullptr;
    const int lo = args.ph_lo, hi = args.ph_hi;
    if (hi - lo > 1) bar = xcd_barrier_post((unsigned*)(ws + WS_CTL) + CW_BAR, (volatile LAS unsigned*)((LAS unsigned char*)lds + MISC_OFF) + 8);
#ifdef PHASE_MASK
#define IN(k) (((PHASE_MASK >> (k)) & 1) && lo <= (k) && (k) < hi)
#else
#define IN(k) (lo <= (k) && (k) < hi)
#endif
#define SEAM(k) do { if (IN(k) && IN((k) + 1)) xcd_barrier(bar); } while (0)
    LAS unsigned char* ring = (LAS unsigned char*)lds;
    float* ssq = (float*)(ws + WS_SSQ);
    bf16* xb = (bf16*)(ws + WS_XB);

    if (IN(0)) { p0_prologue(args, lds, opq(vcu), G, opqv(tid)); __syncthreads(); } SEAM(0);

    if (IN(1)) {
        pg8::Gemm g{xb, (const bf16*)(ws + WS_WIN), M, NIN, DM}; pg8::StaticOrder S; S.init(M, NIN, G, opq(bx));
        pg8::EpiIn E{ssq, (const float*)(ws + WS_ROPE), (bf16*)(ws + R_GQ), (bf16*)(ws + R_GK), (bf16*)(ws + R_GV), (bf16*)(ws + R_GR), (bf16*)(ws + R_BQ), (bf16*)(ws + R_BK), (bf16*)(ws + R_BV),
                      (float*)(ws + R_IQ), (float*)(ws + R_IK), (float*)(ws + R_ALR), (float*)(ws + R_IW)};
        pg8::gemm_phase<pg8::EpiIn, pg8::StaticOrder, true, true>(ring, g, S, E);
    } SEAM(1);

    if (IN(2)) { gla_phase_a(args, lds, opq(vcu), G, opqv(tid)); dsa_select(args, lds, opq(vcu), G, opqv(tid)); __syncthreads(); } SEAM(2);
    if (IN(3)) { gla_scan(args, opq(vcu), G, opqv(tid)); dsa_attend(args, lds, opq(vcu), G, opqv(tid)); __syncthreads(); } SEAM(3);
    if (IN(4)) { gla_phase_b(args, lds, opq(vcu), G, opqv(tid)); } SEAM(4);

    if (IN(5)) {
        pg8::Gemm g{(const bf16*)(ws + R_AO), (const bf16*)(ws + WS_WO), M, DM, DM}; pg8::StaticOrder S; S.init(M, DM, G, opq(bx));
        pg8::EpiRes E{args.in[0], args.out, xb, ssq + M};
        pg8::gemm_phase<pg8::EpiRes, pg8::StaticOrder, true, true>(ring, g, S, E);
    } SEAM(5);

#pragma unroll 1
    for (int layer = 0; layer < 2; ++layer) {
        const int pb = layer == 0 ? 6 : 12;
        if (IN(pb)) {
            pg8::Gemm g{xb, (const bf16*)(ws + (layer == 0 ? WS_WUP0 : WS_WUP1)), M, DFF2, DM}; pg8::StaticOrder S; S.init(M, DFF2, G, opq(bx));
            pg8::EpiConv E{ssq + (layer == 0 ? 1 : 3) * M, args.in[16] + (size_t)layer * 3 * DFF2, args.in[17] + (size_t)layer * DFF2, (bf16*)(ws + R_GT), (float*)(ws + R_HL), (float*)(ws + R_HF)};
            pg8::gemm_phase<pg8::EpiConv, pg8::StaticOrder, true, true>(ring, g, S, E);
        } SEAM(pb);
        if (IN(pb + 1)) { ffn_fixup(args, layer, opq(vcu), G, opqv(tid)); } SEAM(pb + 1);
        if (IN(pb + 2)) {
            pg8::Gemm g{(const bf16*)(ws + R_GT), (const bf16*)(ws + (layer == 0 ? WS_WDN0 : WS_WDN1)), M, DM, DFF}; pg8::StaticOrder S; S.init(M, DM, G, opq(bx));
            pg8::EpiRes E{args.out, args.out, xb, ssq + (layer == 0 ? 2 : 4) * M};
            pg8::gemm_phase<pg8::EpiRes, pg8::StaticOrder, true, true>(ring, g, S, E);
        } SEAM(pb + 2);
        if (layer == 0) {
            if (IN(9)) {
                pg8::Gemm g{xb, (const bf16*)(ws + WS_WUV), M, 2048, DM}; pg8::StaticOrder S; S.init(M, 2048, G, opq(bx));
                pg8::EpiSgu E{ssq + 2 * M, (bf16*)(ws + R_Z), ssq + 5 * M, ssq + 6 * M};
                pg8::gemm_phase<pg8::EpiSgu, pg8::StaticOrder, true, true>(ring, g, S, E);
            } SEAM(9);
            if (IN(10)) { sgu_mix(args, lds, opq(vcu), G, opqv(tid)); } SEAM(10);
            if (IN(11)) {
                pg8::Gemm g{(const bf16*)(ws + R_SG), (const bf16*)(ws + WS_WOUT), M, DM, DM}; pg8::StaticOrder S; S.init(M, DM, G, opq(bx));
                pg8::EpiRes E{args.out, args.out, xb, ssq + 3 * M};
                pg8::gemm_phase<pg8::EpiRes, pg8::StaticOrder, true, true>(ring, g, S, E);
            } SEAM(11);
        }
    }
    if (IN(15)) { final_norm(args, opq(vcu), G, opqv(tid)); }
#undef IN
#undef SEAM
}

extern "C" void kernel_launch(void* const* d_in, const int* in_sizes, int n_in, void* d_out, int out_size, void* d_ws, size_t ws_size, hipStream_t stream) {
    static int grid = 0;
    if (grid == 0) {
        if (n_in != 20 || out_size != M * DM || ws_size < WS_END) { fprintf(stderr, "kernel_launch: unexpected problem (n_in %d, out %d, ws %zu)\n", n_in, out_size, ws_size); grid = -1; return; }
        int dev = 0, cus = 0, per_cu = 0;
        if (hipGetDevice(&dev) != hipSuccess || hipDeviceGetAttribute(&cus, hipDeviceAttributeMultiprocessorCount, dev) != hipSuccess) { grid = -1; return; }
        if (hipFuncSetAttribute((const void*)fwd_megakernel, hipFuncAttributeMaxDynamicSharedMemorySize, LDS_BYTES) != hipSuccess) { fprintf(stderr, "kernel_launch: hipFuncSetAttribute failed\n"); grid = -1; return; }
        if (hipOccupancyMaxActiveBlocksPerMultiprocessor(&per_cu, (const void*)fwd_megakernel, NTHR, LDS_BYTES) != hipSuccess || per_cu < 1)
            fprintf(stderr, "kernel_launch: note: occupancy query reports %d workgroups per CU\n", per_cu);
        (void)hipGetLastError();
        grid = cus;
    }
    if (grid < 0) return;
    if (hipMemsetAsync((char*)d_ws + WS_CTL, 0, CTL_ZERO_BYTES, stream) != hipSuccess) { fprintf(stderr, "kernel_launch: hipMemsetAsync failed\n"); return; }
    Args a{};
    for (int i = 0; i < 20; ++i) a.in[i] = (const float*)d_in[i];
    a.out = (float*)d_out; a.ws = (unsigned char*)d_ws;
#if MK_MULTI
    for (int p = 0; p < NPHASE; ++p) { a.ph_lo = p; a.ph_hi = p + 1; hipLaunchKernelGGL(fwd_megakernel, dim3(grid), dim3(NTHR), LDS_BYTES, stream, a); }
#else
    a.ph_lo = 0; a.ph_hi = NPHASE;
    hipLaunchKernelGGL(fwd_megakernel, dim3(grid), dim3(NTHR), LDS_BYTES, stream, a);
#endif
    const hipError_t le = hipPeekAtLastError();
    if (le != hipSuccess) fprintf(stderr, "kernel_launch: launch failed: %s\n", hipGetErrorName(le));
}
```

```cpp
#include <hip/hip_runtime.h>
#include <cstdio>
#include <cstdint>

#ifndef MK_MULTI
#define MK_MULTI 0
#endif

namespace pg8 {
#define PG8_LAS __attribute__((address_space(3)))
typedef unsigned short bf16_t;
typedef short bf16x8 __attribute__((ext_vector_type(8)));
typedef float f32x4 __attribute__((ext_vector_type(4)));
typedef unsigned u32x4 __attribute__((ext_vector_type(4)));
constexpr int BM = 256, BK = 64, HALF = 128, HTB = HALF * BK * 2  , STAGE_BYTES = 8 * HTB, NXCD = 8, WGM = 8;

__host__ __device__ __forceinline__ int lds_byte(int r, int c) { const int st = (r >> 4) * 2 + (c >> 5), rr = r & 15, cc = c & 31, ob = rr * 64 + cc * 2; return st * 1024 + (ob ^ (((ob >> 9) & 1) << 5)); }
__host__ __device__ __forceinline__ void stage_rc(int b, int& R, int& C) { const int st = b / 1024, sb = b % 1024, swz = sb ^ (((sb >> 9) & 1) << 5); R = (st >> 1) * 16 + swz / 64; C = (st & 1) * 32 + (swz % 64) / 2; }
__host__ __device__ __forceinline__ int perm32(int rho) { const int n = rho >> 4, i = rho & 15; return 8 * (i >> 2) + 4 * n + (i & 3); }

struct Unit { int pm, pn; };
struct Gemm { const bf16_t* A; const bf16_t* Bt; int M, N, K; };

struct StaticOrder {
    int nM, nN, nwg, G, c;
    __host__ __device__ void init(int M, int N, int G_, int c_) { nM = M / BM; nN = N / BM; nwg = nM * nN; G = G_; c = c_; }
    __host__ __device__ bool next(int i, Unit& u) const {
        const long L = (long)i * G + c; if (L >= nwg) return false;
        int wgid = (int)L; { const int q = nwg / NXCD, r = nwg % NXCD, xcd = wgid % NXCD, off = wgid / NXCD; wgid = (xcd < r ? xcd * (q + 1) : r * (q + 1) + (xcd - r) * q) + off; }
        const int nig = WGM * nN, gid = wgid / nig, fm = gid * WGM, gsz = (nM - fm) < WGM ? (nM - fm) : WGM;
        u.pm = fm + ((wgid % nig) % gsz); u.pn = (wgid % nig) / gsz; return true;
    }
    __device__ __forceinline__ void a_ready(const Unit&) const {}
    __device__ __forceinline__ void done(const Unit&) const {}
};

__device__ __forceinline__ unsigned cvt_pk_bf16(float lo, float hi) { unsigned r; asm volatile("v_cvt_pk_bf16_f32 %0, %1, %2" : "=v"(r) : "v"(lo), "v"(hi)); return r; }
typedef float f32x2 __attribute__((ext_vector_type(2)));
typedef unsigned u32x2 __attribute__((ext_vector_type(2)));
__device__ __forceinline__ void st_bf16x4(bf16_t* p, f32x4 v) { u32x2 w; w.x = cvt_pk_bf16(v[0], v[1]); w.y = cvt_pk_bf16(v[2], v[3]); *(u32x2*)p = w; }
__device__ __forceinline__ float sigm(float x) { return 1.0f / (1.0f + __expf(-x)); }
__device__ __forceinline__ float silu_f(float x) { return x * sigm(x); }
__device__ __forceinline__ float gelu_tanh_f(float x) { const float u = 0.7978845608028654f * (x + 0.044715f * x * x * x); return x * sigm(2.0f * u); }
__device__ __forceinline__ f32x4 shfl4(f32x4 v, int src) { f32x4 r; r[0] = __shfl(v[0], src); r[1] = __shfl(v[1], src); r[2] = __shfl(v[2], src); r[3] = __shfl(v[3], src); return r; }
__device__ __forceinline__ f32x4 rope4(f32x4 v, const float* tab_t, int fq) {
    const f32x4 cs = *(const f32x4*)(tab_t + 4 * fq);
    f32x4 o; o[0] = v[0] * cs[0] - v[1] * cs[1]; o[1] = v[1] * cs[0] + v[0] * cs[1]; o[2] = v[2] * cs[2] - v[3] * cs[3]; o[3] = v[3] * cs[2] + v[2] * cs[3]; return o;
}

struct EpiIn {
    static constexpr bool PERM = false, AFTER_DRAIN = false;
    const float* ssq; const float* rope;
    bf16_t *gq, *gk, *gv, *gr, *bq, *bk, *bv, *iq, *ik; float *alr, *iw;
    __device__ __forceinline__ void operator()(const f32x4 (&acc)[2][2][4][2], const Unit& u, int wr, int wc, int fr_in, int fq_in) const {
        int fr = fr_in, fq = fq_in; asm volatile("" : "+v"(fr), "+v"(fq));
        const int pn = u.pn;
#pragma unroll
        for (int ai = 0; ai < 2; ++ai)
#pragma unroll
            for (int m = 0; m < 4; ++m) {
                asm volatile("" ::: "memory");
                const int r = u.pm * BM + ai * HALF + wr * 64 + m * 16 + fr;
                const float rs = 1.0f / sqrtf(ssq[r] * (1.0f / 1024.0f) + 1e-6f);
                const float* tab_t = rope + (size_t)(r & 4095) * 16;
#pragma unroll
                for (int bj = 0; bj < 2; ++bj)
#pragma unroll
                    for (int n = 0; n < 2; ++n) {
                        f32x4 v = acc[ai][bj][m][n] * rs;
                        const int cl = bj * HALF + wc * 32 + n * 16 + 4 * fq;
                        const bool ropecol = ((wc & 1) == 0) && (n == 0);
                        if (pn == 0) { st_bf16x4(gq + (size_t)r * 256 + cl, v * 0.125f); }
                        else if (pn == 1) { st_bf16x4(gk + (size_t)r * 256 + cl, v); }
                        else if (pn < 4) { st_bf16x4(gv + (size_t)r * 512 + (pn - 2) * 256 + cl, v); }
                        else if (pn < 6) { st_bf16x4(gr + (size_t)r * 512 + (pn - 4) * 256 + cl, v); }
                        else if (pn < 8) { if (ropecol) v = rope4(v, tab_t, fq); st_bf16x4(bq + (size_t)r * 512 + (pn - 6) * 256 + cl, v * 0.125f); }
                        else if (pn == 8) { if (ropecol) v = rope4(v, tab_t, fq); st_bf16x4(iq + (size_t)r * 256 + cl, v); }
                        else {
                            const int reg = bj * 2 + (wc >> 1);
                            const int c64 = cl & 63;
                            if (reg == 0) { if (ropecol) v = rope4(v, tab_t, fq); st_bf16x4(bk + (size_t)r * 64 + c64, v); }
                            else if (reg == 1) { st_bf16x4(bv + (size_t)r * 64 + c64, v); }
                            else if (reg == 2) { if (ropecol) v = rope4(v, tab_t, fq); st_bf16x4(ik + (size_t)r * 64 + c64, v); }
                            else if ((wc & 1) == 0) {
                                if (n == 0) *(f32x4*)(alr + (size_t)r * 16 + 4 * fq) = v;
                                else if (fq == 0) *(f32x4*)(iw + (size_t)r * 4) = v * 0.5f;
                            }
                        }
                    }
            }
    }
};

struct EpiRes {
    static constexpr bool PERM = false, AFTER_DRAIN = false;
    const float* base; float* out; bf16_t* xb; float* ssq;
    __device__ __forceinline__ void operator()(const f32x4 (&acc)[2][2][4][2], const Unit& u, int wr, int wc, int fr_in, int fq_in) const {
        int fr = fr_in, fq = fq_in; asm volatile("" : "+v"(fr), "+v"(fq));
#pragma unroll
        for (int ai = 0; ai < 2; ++ai)
#pragma unroll
            for (int m = 0; m < 4; ++m) {
                const int r = u.pm * BM + ai * HALF + wr * 64 + m * 16 + fr;
                float s = 0.f;
#pragma unroll
                for (int bj = 0; bj < 2; ++bj)
#pragma unroll
                    for (int n = 0; n < 2; ++n) {
                        const size_t off = (size_t)r * 1024 + u.pn * BM + bj * HALF + wc * 32 + n * 16 + 4 * fq;
                        const f32x4 x = *(const f32x4*)(base + off) + acc[ai][bj][m][n];
                        *(f32x4*)(out + off) = x; st_bf16x4(xb + off, x);
                        s += (x[0] * x[0] + x[1] * x[1]) + (x[2] * x[2] + x[3] * x[3]);
                    }
                s += __shfl_xor(s, 16); s += __shfl_xor(s, 32);
                if (fq == 0) atomicAdd(ssq + r, s);
            }
    }
};

struct EpiSgu {
    static constexpr bool PERM = false, AFTER_DRAIN = false;
    const float* ssq; bf16_t* z; float* lns; float* lnq;
    __device__ __forceinline__ void operator()(const f32x4 (&acc)[2][2][4][2], const Unit& u, int wr, int wc, int fr_in, int fq_in) const {
        int fr = fr_in, fq = fq_in; asm volatile("" : "+v"(fr), "+v"(fq));
        const bool vhalf = u.pn >= 4;
#pragma unroll
        for (int ai = 0; ai < 2; ++ai)
#pragma unroll
            for (int m = 0; m < 4; ++m) {
                const int r = u.pm * BM + ai * HALF + wr * 64 + m * 16 + fr;
                const float rs = 1.0f / sqrtf(ssq[r] * (1.0f / 1024.0f) + 1e-6f);
                float s = 0.f, q = 0.f;
#pragma unroll
                for (int bj = 0; bj < 2; ++bj)
#pragma unroll
                    for (int n = 0; n < 2; ++n) {
                        f32x4 v = acc[ai][bj][m][n] * rs;
                        v[0] = gelu_tanh_f(v[0]); v[1] = gelu_tanh_f(v[1]); v[2] = gelu_tanh_f(v[2]); v[3] = gelu_tanh_f(v[3]);
                        st_bf16x4(z + (size_t)r * 2048 + u.pn * BM + bj * HALF + wc * 32 + n * 16 + 4 * fq, v);
                        s += (v[0] + v[1]) + (v[2] + v[3]); q += (v[0] * v[0] + v[1] * v[1]) + (v[2] * v[2] + v[3] * v[3]);
                    }
                if (vhalf) {
                    s += __shfl_xor(s, 16); s += __shfl_xor(s, 32); q += __shfl_xor(q, 16); q += __shfl_xor(q, 32);
                    if (fq == 0) { atomicAdd(lns + r, s); atomicAdd(lnq + r, q); }
                }
            }
    }
};

struct EpiConv {
    static constexpr bool PERM = false, AFTER_DRAIN = false;
    const float* ssq; const float* cw; const float* cb; bf16_t* gt; float* hl; float* hf;
    __device__ __forceinline__ void operator()(const f32x4 (&acc)[2][2][4][2], const Unit& u, int wr, int wc, int fr_in, int fq_in) const {
        int fr = fr_in, fq = fq_in; asm volatile("" : "+v"(fr), "+v"(fq));
        const int lane = fq * 16 + fr;
        const int s1 = (lane & 48) | ((fr + 15) & 15), s2 = (lane & 48) | ((fr + 14) & 15);
#pragma unroll
        for (int ai = 0; ai < 2; ++ai) {
            const int blk = u.pm * 4 + ai * 2 + wr;
            float rs[4];
#pragma unroll
            for (int m = 0; m < 4; ++m) rs[m] = 1.0f / sqrtf(ssq[u.pm * BM + ai * HALF + wr * 64 + m * 16 + fr] * (1.0f / 1024.0f) + 1e-6f);
#pragma unroll
            for (int n = 0; n < 2; ++n) {
                asm volatile("" ::: "memory");
                const int g0 = u.pn * 128 + wc * 32 + n * 16 + 4 * fq;
                f32x4 pg1 = {0.f, 0.f, 0.f, 0.f}, pg2 = pg1, pu1 = pg1, pu2 = pg1;
#pragma unroll
                for (int m = 0; m < 4; ++m) {
                    asm volatile("" ::: "memory");
                    const int r = u.pm * BM + ai * HALF + wr * 64 + m * 16 + fr;
                    const f32x4 ag = acc[ai][0][m][n] * rs[m], au = acc[ai][1][m][n] * rs[m];
                    if (m == 3 && fr >= 14) { float* h = hl + (size_t)(blk * 2 + (fr - 14)) * 5632 + g0; *(f32x4*)h = ag; *(f32x4*)(h + 2816) = au; }
                    if (m == 0 && fr < 2) { float* h = hf + (size_t)(blk * 2 + fr) * 5632 + g0; *(f32x4*)h = ag; *(f32x4*)(h + 2816) = au; }
                    f32x4 o;
                    { const f32x4 g1 = shfl4(ag, s1), g2 = shfl4(ag, s2);
                      const f32x4 p1g = fr >= 1 ? g1 : pg1, p2g = fr >= 2 ? g2 : pg2;
                      const f32x4 cg = *(const f32x4*)(cb + g0) + *(const f32x4*)(cw + g0) * p2g + *(const f32x4*)(cw + 5632 + g0) * p1g + *(const f32x4*)(cw + 2 * 5632 + g0) * ag;
                      o[0] = silu_f(cg[0]); o[1] = silu_f(cg[1]); o[2] = silu_f(cg[2]); o[3] = silu_f(cg[3]);
                      pg1 = g1; pg2 = g2; }
                    { const f32x4 u1 = shfl4(au, s1), u2 = shfl4(au, s2);
                      const f32x4 p1u = fr >= 1 ? u1 : pu1, p2u = fr >= 2 ? u2 : pu2;
                      const f32x4 cu = *(const f32x4*)(cb + 2816 + g0) + *(const f32x4*)(cw + 2816 + g0) * p2u + *(const f32x4*)(cw + 5632 + 2816 + g0) * p1u + *(const f32x4*)(cw + 2 * 5632 + 2816 + g0) * au;
                      o = o * cu;
                      pu1 = u1; pu2 = u2; }
                    st_bf16x4(gt + (size_t)r * 2816 + g0, o);
                }
            }
        }
    }
};

template <class Epi, class Sched, bool ALIGN_EPI = false, bool SP2 = false>
__device__ __forceinline__ void gemm_phase(PG8_LAS unsigned char* lds, const Gemm g, const Sched& S, const Epi& E) {
    int tid_ = threadIdx.x; asm volatile("" : "+v"(tid_));
    const int tid = tid_, wid = __builtin_amdgcn_readfirstlane(tid >> 6), lane = tid & 63, wr = wid >> 2, wc = wid & 3, fr = lane & 15, fq = lane >> 4;
    const int K = g.K, nt = K / BK;
    unsigned voffA[2], voffB[2];
#pragma unroll
    for (int i = 0; i < 2; ++i) { int R, C; stage_rc(tid * 16 + i * 8192, R, C); const int Rb = Epi::PERM ? ((R & ~31) + perm32(R & 31)) : R;
        voffA[i] = (unsigned)(R * K + C) * 2u; voffB[i] = (unsigned)(Rb * K + C) * 2u; }
    const size_t kstep = (size_t)(BK * 2);
    const size_t hstep = (size_t)HALF * K * 2;
    const size_t tstep = 2 * hstep;
    const unsigned ldsw = (unsigned)wid * 1024u;
    const int aoff = lds_byte(wr * 64 + fr, fq * 8), boff = lds_byte(wc * 32 + fr, fq * 8);
#define PG8_SA(b, h) (((b) * 2 + (h)) * HTB)
#define PG8_SB(b, h) ((4 + (b) * 2 + (h)) * HTB)
#define PG8_STAGE(bufoff, gbase, voff) do { _Pragma("unroll") for (int _i = 0; _i < 2; ++_i) \
        __builtin_amdgcn_global_load_lds((const unsigned*)((const char*)(gbase) + (voff)[_i]), (PG8_LAS unsigned*)(lds + (bufoff) + ldsw + _i * 8192), 16, 0, 0); } while (0)
#define PG8_LDA(dst, b, h) do { _Pragma("unroll") for (int m = 0; m < 4; ++m) _Pragma("unroll") for (int k = 0; k < 2; ++k) dst[m][k] = *(const PG8_LAS bf16x8*)(lds + PG8_SA(b, h) + aoff + m * 2048 + k * 1024); } while (0)
#define PG8_LDB(dst, b, h) do { _Pragma("unroll") for (int n = 0; n < 2; ++n) _Pragma("unroll") for (int k = 0; k < 2; ++k) dst[n][k] = *(const PG8_LAS bf16x8*)(lds + PG8_SB(b, h) + boff + n * 2048 + k * 1024); } while (0)
#define PG8_MMA(ai, bj, At, Bt) do { __builtin_amdgcn_s_setprio(1); _Pragma("unroll") for (int m = 0; m < 4; ++m) _Pragma("unroll") for (int n = 0; n < 2; ++n) _Pragma("unroll") for (int k = 0; k < 2; ++k) \
        acc[ai][bj][m][n] = __builtin_amdgcn_mfma_f32_16x16x32_bf16(Bt[n][k], At[m][k], acc[ai][bj][m][n], 0, 0, 0); __builtin_amdgcn_s_setprio(0); } while (0)
#define PG8_WAIT_V(n) asm volatile("s_waitcnt vmcnt(" #n ")" ::: "memory")
#define PG8_WAIT_L(n) asm volatile("s_waitcnt lgkmcnt(" #n ")" ::: "memory")
#define PG8_BAR __builtin_amdgcn_s_barrier()
#define PG8_SCHED __builtin_amdgcn_sched_barrier(0)
    Unit cur, nxt; int ui = 0;
    if (!S.next(0, cur)) return;
    f32x4 acc[2][2][4][2];
#pragma unroll
    for (int a = 0; a < 2; ++a)
#pragma unroll
        for (int b = 0; b < 2; ++b)
#pragma unroll
            for (int m = 0; m < 4; ++m)
#pragma unroll
                for (int n = 0; n < 2; ++n) acc[a][b][m][n] = (f32x4){0.f, 0.f, 0.f, 0.f};
    bf16x8 At[4][2], B0[2][2], B1[2][2];
    const char* cA = (const char*)g.A + (size_t)cur.pm * tstep; const char* cB = (const char*)g.Bt + (size_t)cur.pn * tstep;
    S.a_ready(cur);
    if constexpr (SP2) {
        PG8_STAGE(PG8_SB(0, 0), cB, voffB); PG8_STAGE(PG8_SB(0, 1), cB + hstep, voffB); PG8_STAGE(PG8_SA(0, 0), cA, voffA); PG8_STAGE(PG8_SA(0, 1), cA + hstep, voffA);
        if (wr == 1) PG8_BAR;
        PG8_WAIT_V(2); PG8_BAR;
        PG8_STAGE(PG8_SB(1, 0), cB + kstep, voffB); PG8_STAGE(PG8_SA(1, 0), cA + kstep, voffA); PG8_STAGE(PG8_SB(1, 1), cB + hstep + kstep, voffB);
        PG8_WAIT_V(6); PG8_BAR;
    } else {
        PG8_STAGE(PG8_SB(0, 0), cB, voffB); PG8_STAGE(PG8_SA(0, 0), cA, voffA); PG8_STAGE(PG8_SB(0, 1), cB + hstep, voffB); PG8_STAGE(PG8_SA(0, 1), cA + hstep, voffA);
        if (wr == 1) PG8_BAR;
        PG8_WAIT_V(4); PG8_BAR;
        PG8_STAGE(PG8_SB(1, 0), cB + kstep, voffB); PG8_STAGE(PG8_SA(1, 0), cA + kstep, voffA); PG8_STAGE(PG8_SB(1, 1), cB + hstep + kstep, voffB);
        PG8_WAIT_V(6); PG8_BAR;
    }
    for (;;) {
        const bool has_next = S.next(ui + 1, nxt);
        const char* nA = has_next ? (const char*)g.A + (size_t)nxt.pm * tstep : cA; const char* nB = has_next ? (const char*)g.Bt + (size_t)nxt.pn * tstep : cB;
        for (int t = 0; t < nt; t += 2) {
            const bool last = (t == nt - 2);
            const char* a1 = cA + (size_t)(t + 1) * kstep;
            const char* a2 = last ? nA : cA + (size_t)(t + 2) * kstep; const char* b2 = last ? nB : cB + (size_t)(t + 2) * kstep;
            const char* a3 = a2 + kstep; const char* b3 = b2 + kstep;
            if (last && has_next) S.a_ready(nxt);
            if constexpr (SP2) {
            PG8_LDB(B0, 0, 0); PG8_LDB(B1, 0, 1); PG8_SCHED; PG8_LDA(At, 0, 0); PG8_STAGE(PG8_SA(1, 1), a1 + hstep, voffA);
            PG8_WAIT_V(8); PG8_WAIT_L(0); PG8_BAR; PG8_MMA(0, 0, At, B0); PG8_MMA(0, 1, At, B1); PG8_BAR; PG8_SCHED;
            PG8_LDA(At, 0, 1); PG8_STAGE(PG8_SB(0, 0), b2, voffB); PG8_STAGE(PG8_SB(0, 1), b2 + hstep, voffB); PG8_STAGE(PG8_SA(0, 0), a2, voffA);
            PG8_WAIT_V(8); PG8_WAIT_L(0); PG8_BAR; PG8_MMA(1, 0, At, B0); PG8_MMA(1, 1, At, B1); PG8_BAR; PG8_SCHED;
            PG8_LDB(B0, 1, 0); PG8_LDB(B1, 1, 1); PG8_SCHED; PG8_LDA(At, 1, 0); PG8_STAGE(PG8_SA(0, 1), a2 + hstep, voffA);
            PG8_WAIT_V(8); PG8_WAIT_L(0); PG8_BAR; PG8_MMA(0, 0, At, B0); PG8_MMA(0, 1, At, B1); PG8_BAR; PG8_SCHED;
            PG8_LDA(At, 1, 1); PG8_STAGE(PG8_SB(1, 0), b3, voffB); PG8_STAGE(PG8_SB(1, 1), b3 + hstep, voffB); PG8_STAGE(PG8_SA(1, 0), a3, voffA);
            PG8_WAIT_V(8); PG8_WAIT_L(0); PG8_BAR; PG8_MMA(1, 0, At, B0); PG8_MMA(1, 1, At, B1); PG8_BAR; PG8_SCHED;
            } else {
            PG8_LDB(B0, 0, 0); PG8_SCHED; PG8_LDA(At, 0, 0); PG8_STAGE(PG8_SA(1, 1), a1 + hstep, voffA);
            PG8_WAIT_L(8); PG8_BAR; PG8_WAIT_L(0); PG8_MMA(0, 0, At, B0); PG8_BAR; PG8_SCHED;
            PG8_LDB(B1, 0, 1); PG8_STAGE(PG8_SB(0, 0), b2, voffB);
            PG8_BAR; PG8_WAIT_L(0); PG8_MMA(0, 1, At, B1); PG8_BAR;
            PG8_LDA(At, 0, 1); PG8_STAGE(PG8_SA(0, 0), a2, voffA);
            PG8_BAR; PG8_WAIT_L(0); PG8_MMA(1, 0, At, B0); PG8_BAR; PG8_SCHED;
            PG8_STAGE(PG8_SB(0, 1), b2 + hstep, voffB);
            PG8_WAIT_V(6); PG8_BAR; PG8_MMA(1, 1, At, B1); PG8_BAR;
            PG8_LDB(B0, 1, 0); PG8_SCHED; PG8_LDA(At, 1, 0); PG8_STAGE(PG8_SA(0, 1), a2 + hstep, voffA);
            PG8_WAIT_L(8); PG8_BAR; PG8_WAIT_L(0); PG8_MMA(0, 0, At, B0); PG8_BAR; PG8_SCHED;
            PG8_LDB(B1, 1, 1); PG8_STAGE(PG8_SB(1, 0), b3, voffB);
            PG8_BAR; PG8_WAIT_L(0); PG8_MMA(0, 1, At, B1); PG8_BAR;
            PG8_LDA(At, 1, 1); PG8_STAGE(PG8_SA(1, 0), a3, voffA);
            PG8_BAR; PG8_WAIT_L(0); PG8_MMA(1, 0, At, B0); PG8_BAR; PG8_SCHED;
            PG8_STAGE(PG8_SB(1, 1), b3 + hstep, voffB);
            PG8_WAIT_V(6); PG8_BAR; PG8_MMA(1, 1, At, B1); PG8_BAR;
            }
        }
        if constexpr (ALIGN_EPI) { if (wr == 0) PG8_BAR; }
        if constexpr (!Epi::AFTER_DRAIN) { E(acc, cur, wr, wc, fr, fq); S.done(cur); }
        if (!has_next) break;
#pragma unroll
        for (int a = 0; a < 2; ++a)
#pragma unroll
            for (int b = 0; b < 2; ++b)
#pragma unroll
                for (int m = 0; m < 4; ++m)
#pragma unroll
                    for (int n = 0; n < 2; ++n) acc[a][b][m][n] = (f32x4){0.f, 0.f, 0.f, 0.f};
        cur = nxt; cA = nA; cB = nB; ++ui;
        if constexpr (ALIGN_EPI) { if (wr == 1) PG8_BAR; }
    }
    PG8_WAIT_V(0);
    if constexpr (!ALIGN_EPI) { if (wr == 0) PG8_BAR; }
    PG8_BAR;
    if constexpr (Epi::AFTER_DRAIN) { E.fused(acc, cur, wr, wc, fr, fq, lds, wid, lane); S.done(cur); }
#undef PG8_SA
#undef PG8_SB
#undef PG8_STAGE
#undef PG8_LDA
#undef PG8_LDB
#undef PG8_MMA
#undef PG8_WAIT_V
#undef PG8_WAIT_L
#undef PG8_BAR
#undef PG8_SCHED
}
}
#define GAS __attribute__((address_space(1)))
#define LAS __attribute__((address_space(3)))
typedef unsigned short bf16;
typedef unsigned v4u __attribute__((ext_vector_type(4)));
typedef float f32x4 __attribute__((ext_vector_type(4)));
typedef short bf16x8 __attribute__((ext_vector_type(8)));
typedef GAS unsigned gu32;
typedef GAS unsigned long long gu64;
#define RLX_AGENT __ATOMIC_RELAXED, __HIP_MEMORY_SCOPE_AGENT
#define LDS_WAIT() asm volatile("s_waitcnt lgkmcnt(0)" ::: "memory")
#define VM_WAIT() asm volatile("s_waitcnt vmcnt(0)" ::: "memory")
__device__ __forceinline__ unsigned long long rt() { return __builtin_amdgcn_s_memrealtime(); }
__device__ __forceinline__ unsigned f2bf(float f) { unsigned u = __builtin_bit_cast(unsigned, f); return (u + 0x7fffu + ((u >> 16) & 1u)) >> 16; }
__device__ __forceinline__ unsigned pk2(float lo, float hi) { return f2bf(lo) | (f2bf(hi) << 16); }

#define XB_TMO      128
#define XB_XCNT(j)  (256  + 64 * (j))
#define XB_XSUB(j)  (1280 + 64 * (j))
#define XB_XGEN(j)  (2304 + 64 * (j))
#define XB_TOP      3328
#define XB_TOPGEN   3392
#define XCD_BAR_WORDS 3456
#define XB_SPIN_CAP (1u << 18)

__device__ __forceinline__ unsigned xb_ld(unsigned* p)              { return __hip_atomic_load(p, __ATOMIC_RELAXED, __HIP_MEMORY_SCOPE_AGENT); }
__device__ __forceinline__ unsigned xb_add(unsigned* p, unsigned v) { return __hip_atomic_fetch_add(p, v, __ATOMIC_RELAXED, __HIP_MEMORY_SCOPE_AGENT); }
__device__ __forceinline__ unsigned xb_xcc_id() { return (unsigned)__builtin_amdgcn_s_getreg((3 << 11) | 20) & 0xFu; }
#define XB_SPIN(cond, bar) do { unsigned _sp = 0; while (cond) { __builtin_amdgcn_s_sleep(1); \
    if ((++_sp & 255u) == 0u) { if (xb_ld(&(bar)[XB_TMO])) break; if (_sp > XB_SPIN_CAP) { atomicAdd(&(bar)[XB_TMO], 1u); break; } } } } while (0)

struct XcdBarrier {
    unsigned* bar; unsigned x;
    volatile LAS unsigned* st;
};

__device__ __forceinline__ XcdBarrier xcd_barrier_post(unsigned* bar, volatile LAS unsigned* st) {
    XcdBarrier b; b.bar = bar; b.x = xb_xcc_id(); b.st = st;
    if (threadIdx.x == 0) (void)xb_add(&bar[XB_XCNT(b.x)], 1u);
    return b;
}
__device__ __forceinline__ void xcd_barrier_complete(unsigned* bar, unsigned x, unsigned& nloc, unsigned& nx) {
    const unsigned G = gridDim.x * gridDim.y * gridDim.z;
    unsigned sum, cnt, mine, sp = 0u;
    for (;;) {
        sum = 0u; cnt = 0u; mine = 0u;
#pragma unroll
        for (unsigned j = 0; j < 16; ++j) { const unsigned c = xb_ld(&bar[XB_XCNT(j)]); sum += c; cnt += (c > 0u) ? 1u : 0u; mine = (j == x) ? c : mine; }
        if (sum == G) break;
        __builtin_amdgcn_s_sleep(1);
        if ((++sp & 255u) == 0u) { if (xb_ld(&bar[XB_TMO])) break; if (sp > XB_SPIN_CAP) { atomicAdd(&bar[XB_TMO], 1u); break; } }
    }
    nloc = mine > 0u ? mine : 1u; nx = cnt > 0u ? cnt : 1u;
}

__device__ __forceinline__ void xcd_barrier(const XcdBarrier& b) {
    asm volatile("s_waitcnt vmcnt(0)" ::: "memory");
    __syncthreads();
    if (threadIdx.x == 0) {
        unsigned* bar = b.bar;
        __builtin_amdgcn_s_waitcnt(0);
        unsigned nloc = b.st[0], nx = b.st[1];
        if (nloc == 0u) { xcd_barrier_complete(bar, b.x, nloc, nx); b.st[0] = nloc; b.st[1] = nx; }
        const unsigned old = xb_add(&bar[XB_XSUB(b.x)], 1u);
        const unsigned gen = old / nloc;
        if (old + 1u == (gen + 1u) * nloc) {
            __builtin_amdgcn_fence(__ATOMIC_RELEASE, "agent");
            asm volatile("s_waitcnt vmcnt(0)" ::: "memory");
            const unsigned og = xb_add(&bar[XB_TOP], 1u);
            const unsigned tg = og / nx;
            if (og + 1u == (tg + 1u) * nx) xb_add(&bar[XB_TOPGEN], 1u);
            else XB_SPIN(xb_ld(&bar[XB_TOPGEN]) == tg, bar);
            __builtin_amdgcn_fence(__ATOMIC_ACQUIRE, "agent");
            xb_add(&bar[XB_XGEN(b.x)], 1u);
            asm volatile("s_waitcnt vmcnt(0)" ::: "memory");
        } else {
            XB_SPIN(xb_ld(&bar[XB_XGEN(b.x)]) == gen, bar);
            __builtin_amdgcn_fence(__ATOMIC_ACQUIRE, "agent");
            asm volatile("s_waitcnt vmcnt(0)" ::: "memory");
        }
    }
    __syncthreads();
}

constexpr int NWAVES = 8, NTHR = 512;
constexpr int NB = 4, SEQ = 4096, M = NB * SEQ, DM = 1024;
constexpr int IN_W = 2516, NIN = 2560;
constexpr int DFF = 2816, DFF2 = 5632;
constexpr int NUNIT_GLA = NB * 4 * 64;

constexpr size_t MiB = 1u << 20;
constexpr size_t WS_CTL = 0, CTL_ZERO_BYTES = 1 * MiB;
constexpr size_t WS_ROPE = 1 * MiB;
constexpr size_t WS_SSQ = 2 * MiB;
constexpr size_t WS_WIN = 4 * MiB, WS_WO = 9 * MiB, WS_WUP0 = 11 * MiB, WS_WUP1 = 22 * MiB, WS_WDN0 = 33 * MiB, WS_WDN1 = 39 * MiB, WS_WUV = 45 * MiB, WS_WOUT = 49 * MiB;
constexpr size_t WS_XB = 51 * MiB;
constexpr size_t WS_R = 83 * MiB;
constexpr size_t R_GQ = WS_R, R_GK = R_GQ + 8 * MiB, R_GV = R_GK + 8 * MiB, R_GR = R_GV + 16 * MiB, R_BQ = R_GR + 16 * MiB, R_IQ = R_BQ + 16 * MiB, R_BK = R_IQ + 16 * MiB,
                 R_BV = R_BK + 2 * MiB, R_IK = R_BV + 2 * MiB, R_ALR = R_IK + 4 * MiB, R_IW = R_ALR + 1 * MiB, R_DS = R_IW + 1 * MiB, R_DEC = R_DS + 32 * MiB, R_IDX = R_DEC + 1 * MiB,
                 R_AO = R_IDX + 8 * MiB, R_END0 = R_AO + 32 * MiB;
constexpr size_t R_GT = WS_R, R_HL = R_GT + 88 * MiB, R_HF = R_HL + 11 * MiB, R_END1 = R_HF + 11 * MiB;
constexpr size_t R_Z = WS_R, R_SG = R_Z + 64 * MiB, R_END2 = R_SG + 32 * MiB;
constexpr size_t WS_END = 256 * MiB;
static_assert(R_END0 <= WS_END && R_END1 <= WS_END && R_END2 <= WS_END, "d_ws map");
constexpr int CW_BAR = 4096;

constexpr int RING_BYTES = 131072, LDS_BYTES = 147456, LDSCTL_OFF = LDS_BYTES - 512, MISC_OFF = LDSCTL_OFF;

typedef unsigned short bf16;
__device__ __forceinline__ float bf2f(unsigned short h) { return __builtin_bit_cast(float, (unsigned)h << 16); }
__device__ __forceinline__ float wave_sum(float v) {
#pragma unroll
    for (int o = 1; o < 64; o <<= 1) v += __shfl_xor(v, o);
    return v;
}
__device__ __forceinline__ float wave_max(float v) {
#pragma unroll
    for (int o = 1; o < 64; o <<= 1) v = fmaxf(v, __shfl_xor(v, o));
    return v;
}

struct Args { const float* in[20]; float* out; unsigned char* ws; int ph_lo, ph_hi; };

__device__ __forceinline__ int ropeperm(int p) { return p < 16 ? ((p >> 1) + 8 * (p & 1)) : p; }
__device__ __forceinline__ int win_src(int n) {
    if (n < 1536) return n;
    if (n < 2048) { const int c = n - 1536; return 1552 + (c & ~63) + ropeperm(c & 63); }
    if (n < 2304) { const int c = n - 2048; return 2192 + (c & ~63) + ropeperm(c & 63); }
    const int c = n - 2304;
    if (c < 64) return 2064 + ropeperm(c);
    if (c < 128) return 2128 + (c - 64);
    if (c < 192) return 2448 + ropeperm(c - 128);
    if (c < 208) return 1536 + (c - 192);
    if (c < 212) return 2512 + (c - 208);
    return -1;
}
__device__ __forceinline__ int up_src(int r) { const int pn = r >> 8, w = r & 255; return (w >> 7) * DFF + pn * 128 + (w & 127); }

template <int MAP  >
__device__ __forceinline__ void transpose_item(const float* W, int K, int Nsrc, int Ndst, const float* g, bf16* WT, float* scr, int item, int lane) {
    const int nblk = Ndst / 32, kb = item / nblk, nb = item % nblk, k0 = 64 * kb, n0 = 32 * nb;
    const int nd = n0 + (lane & 31);
    const int src = MAP == 0 ? nd : (MAP == 1 ? win_src(nd) : up_src(nd));
#pragma unroll 8
    for (int i = 0; i < 32; ++i) { const int kk = 2 * i + (lane >> 5);
        float v = 0.f; if (src >= 0) { v = W[(size_t)(k0 + kk) * Nsrc + src]; if (g) v *= g[k0 + kk]; }
        scr[kk * 33 + (lane & 31)] = v; }
    LDS_WAIT(); asm volatile("" ::: "memory");
    const int c = lane & 7;
#pragma unroll
    for (int j = 0; j < 4; ++j) { const int n = (lane >> 3) + 8 * j; const float* s = scr + (8 * c) * 33 + n;
        v4u o; o.x = pk2(s[0 * 33], s[1 * 33]); o.y = pk2(s[2 * 33], s[3 * 33]); o.z = pk2(s[4 * 33], s[5 * 33]); o.w = pk2(s[6 * 33], s[7 * 33]);
        *(v4u*)(WT + (size_t)(n0 + n) * K + k0 + 8 * c) = o; }
    LDS_WAIT(); asm volatile("" ::: "memory");
}

__device__ __forceinline__ void sincos_d(double a, float& c, float& s) {
    const double k = __builtin_rint(a * 0.15915494309189535);
    double r = a - k * 6.283185307179586; r -= k * 2.4492935982947064e-16;
    const double r2 = r * r;
    double sp = -1.0 / 51090942171709440000.0, cp = 1.0 / 1124000727777607680000.0;
    sp = sp * r2 + 1.0 / 121645100408832000.0;  cp = cp * r2 - 1.0 / 2432902008176640000.0;
    sp = sp * r2 - 1.0 / 355687428096000.0;     cp = cp * r2 + 1.0 / 6402373705728000.0;
    sp = sp * r2 + 1.0 / 1307674368000.0;       cp = cp * r2 - 1.0 / 20922789888000.0;
    sp = sp * r2 - 1.0 / 6227020800.0;          cp = cp * r2 + 1.0 / 87178291200.0;
    sp = sp * r2 + 1.0 / 39916800.0;            cp = cp * r2 - 1.0 / 479001600.0;
    sp = sp * r2 - 1.0 / 362880.0;              cp = cp * r2 + 1.0 / 3628800.0;
    sp = sp * r2 + 1.0 / 5040.0;                cp = cp * r2 - 1.0 / 40320.0;
    sp = sp * r2 - 1.0 / 120.0;                 cp = cp * r2 + 1.0 / 720.0;
    sp = sp * r2 + 1.0 / 6.0;                   cp = cp * r2 - 1.0 / 24.0;
    cp = cp * r2 + 0.5;
    s = (float)(r - r * r2 * sp); c = (float)(1.0 - r2 * cp);
}

__device__ __forceinline__ void p0_prologue(const Args& a, unsigned char* lds, int vcu, int G, int tid) {
    unsigned char* ws = a.ws;
    const int lane = tid & 63, wave = tid >> 6;
    float* scr = (float*)(lds + wave * 16384);
    const int gw = vcu * NWAVES + wave, NGW = G * NWAVES;
    constexpr int I_WIN = 16 * (NIN / 32), I_WO = 16 * 32, I_WUP = 16 * (DFF2 / 32), I_WDN = (DFF / 64) * 32, I_WUV = 16 * 64, I_WOUT = 16 * 32;
    constexpr int NITEMS = I_WIN + I_WO + 2 * I_WUP + 2 * I_WDN + I_WUV + I_WOUT;
    for (int it = gw; it < NITEMS; it += NGW) {
        int r = it;
        if (r < I_WIN) { transpose_item<1>(a.in[2], 1024, IN_W, NIN, a.in[1], (bf16*)(ws + WS_WIN), scr, r, lane); continue; } r -= I_WIN;
        if (r < I_WO) { transpose_item<0>(a.in[6], 1024, 1024, 1024, nullptr, (bf16*)(ws + WS_WO), scr, r, lane); continue; } r -= I_WO;
        if (r < I_WUP) { transpose_item<2>(a.in[15], 1024, DFF2, DFF2, a.in[14], (bf16*)(ws + WS_WUP0), scr, r, lane); continue; } r -= I_WUP;
        if (r < I_WUP) { transpose_item<2>(a.in[15] + (size_t)1024 * DFF2, 1024, DFF2, DFF2, a.in[14] + 1024, (bf16*)(ws + WS_WUP1), scr, r, lane); continue; } r -= I_WUP;
        if (r < I_WDN) { transpose_item<0>(a.in[18], DFF, 1024, 1024, nullptr, (bf16*)(ws + WS_WDN0), scr, r, lane); continue; } r -= I_WDN;
        if (r < I_WDN) { transpose_item<0>(a.in[18] + (size_t)DFF * 1024, DFF, 1024, 1024, nullptr, (bf16*)(ws + WS_WDN1), scr, r, lane); continue; } r -= I_WDN;
        if (r < I_WUV) { transpose_item<0>(a.in[8], 1024, 2048, 2048, a.in[7], (bf16*)(ws + WS_WUV), scr, r, lane); continue; } r -= I_WUV;
        transpose_item<0>(a.in[13], 1024, 1024, 1024, nullptr, (bf16*)(ws + WS_WOUT), scr, r, lane);
    }
    float* ssq = (float*)(ws + WS_SSQ);
    bf16* xb = (bf16*)(ws + WS_XB);
    for (int m = gw; m < M; m += NGW) {
        const f32x4* xr = (const f32x4*)(a.in[0] + (size_t)m * DM) + lane;
        unsigned long long* o8 = (unsigned long long*)(xb + (size_t)m * DM) + lane;
        float s = 0.f;
#pragma unroll
        for (int j = 0; j < 4; ++j) { const f32x4 v = xr[64 * j]; s += (v.x * v.x + v.y * v.y) + (v.z * v.z + v.w * v.w);
            o8[64 * j] = (unsigned long long)pk2(v.x, v.y) | ((unsigned long long)pk2(v.z, v.w) << 32); }
        s = wave_sum(s);
        if (lane == 0) ssq[m] = s;
    }
    const int gt = vcu * NTHR + tid, NGT = G * NTHR;
    for (int i = gt; i < 6 * M; i += NGT) ssq[M + i] = 0.f;
    float* rope = (float*)(ws + WS_ROPE);
    for (int i = gt; i < SEQ * 8; i += NGT) {
        const int t = i >> 3, j = i & 7;
        const double inv = j == 0 ? 1.0 : j == 1 ? 0.19392274474868576 : j == 2 ? 0.03760603093086393 : j == 3 ? 0.007292664737217109 : j == 4 ? 0.001414213562373095
                         : j == 5 ? 0.0002742481756762073 : j == 6 ? 5.318295896944988e-05 : 1.031338537721246e-05;
        float c, s; sincos_d((double)t * inv, c, s);
        rope[2 * i] = c; rope[2 * i + 1] = s;
    }
}

__device__ __forceinline__ float logsigmoid_f(float z) { return fminf(z, 0.f) - log1pf(__expf(-fabsf(z))); }
typedef short v4i16_t __attribute__((ext_vector_type(4)));
__device__ __forceinline__ v4i16_t tr16(const unsigned char* p) { return __builtin_amdgcn_ds_read_tr16_b64_v4i16((LAS v4i16_t*)(LAS unsigned char*)p); }
__device__ __forceinline__ bf16x8 frag_tr(const unsigned char* X, int RS, int rowA, int rowB, int col0, int fr, int fq) {
    const unsigned char* b = X + (4 * fq + (fr >> 2)) * RS + (col0 + 4 * (fr & 3)) * 2;
    const v4i16_t a0 = tr16(b + rowA * RS), a1 = tr16(b + rowB * RS);
    return (bf16x8){a0[0], a0[1], a0[2], a0[3], a1[0], a1[1], a1[2], a1[3]};
}
__device__ __forceinline__ bf16x8 frag_row_perm(const unsigned char* X, int RS, int row0, int colA, int colB, int fr, int fq) {
    const unsigned char* b = X + (row0 + fr) * RS + 8 * fq;
    const v4i16_t a0 = *(const v4i16_t*)(b + colA * 2), a1 = *(const v4i16_t*)(b + colB * 2);
    return (bf16x8){a0[0], a0[1], a0[2], a0[3], a1[0], a1[1], a1[2], a1[3]};
}
__device__ __forceinline__ bf16x8 frag_row(const unsigned char* X, int RS, int row0, int col0, int fr, int fq) { return *(const bf16x8*)(X + (row0 + fr) * RS + (col0 + 8 * fq) * 2); }

__device__ __forceinline__ void gla_cumdecay(float* bl, float* gt, const float* alr, const float* wa2, const float* ba, int row0, int h, int tid) {
    { const int c = tid >> 3, d0 = (tid & 7) * 8;
      float z[8];
#pragma unroll
      for (int j = 0; j < 8; ++j) z[j] = ba[h * 64 + d0 + j];
      const float* ar = alr + (size_t)(row0 + c) * 16;
#pragma unroll
      for (int r = 0; r < 16; ++r) { const float x = ar[r];
#pragma unroll
          for (int j = 0; j < 8; ++j) z[j] += x * wa2[r * 256 + h * 64 + d0 + j]; }
#pragma unroll
      for (int j = 0; j < 8; ++j) bl[c * 64 + d0 + j] = logsigmoid_f(z[j]) * (1.0f / 16.0f); }
    __syncthreads();
    const int d = tid & 63, g = tid >> 6;
    float v[8]; float s = 0.f;
#pragma unroll
    for (int j = 0; j < 8; ++j) { s += bl[(8 * g + j) * 64 + d]; v[j] = s; }
    gt[g * 64 + d] = s;
    __syncthreads();
    float off = 0.f;
#pragma unroll
    for (int g2 = 0; g2 < 7; ++g2) off += (g2 < g) ? gt[g2 * 64 + d] : 0.f;
#pragma unroll
    for (int j = 0; j < 8; ++j) bl[(8 * g + j) * 64 + d] = v[j] + off;
    __syncthreads();
}

constexpr int GL_BL = 0, GL_GT = 16384, GL_QD = 18432, GL_KD = 27648, GL_QB = 36864, GL_VV = 46080, GL_SS = 64512, GL_PART = 82944;
constexpr int GL_RS64 = 144, GL_RS128 = 288, GL_RSKL = 160;

__device__ __forceinline__ void gla_phase_a(const Args& a, unsigned char* lds, int vcu, int G, int tid) {
    unsigned char* ws = a.ws;
    float* bl = (float*)(lds + GL_BL); float* gt = (float*)(lds + GL_GT);
    unsigned char* kl = lds + GL_QD; unsigned char* vv = lds + GL_VV;
    const bf16* gk = (const bf16*)(ws + R_GK); const bf16* gv = (const bf16*)(ws + R_GV);
    const float* alr = (const float*)(ws + R_ALR);
    float* ds = (float*)(ws + R_DS); float* dec = (float*)(ws + R_DEC);
    const int lane = tid & 63, wave = tid >> 6, fr = lane & 15, fq = lane >> 4;
    for (int unit = vcu; unit < NUNIT_GLA; unit += G) {
        const int bb = unit >> 8, h = (unit >> 6) & 3, n = unit & 63, row0 = bb * SEQ + n * 64;
        gla_cumdecay(bl, gt, alr, a.in[3], a.in[4], row0, h, tid);
        { const int c = tid >> 3, sub = tid & 7, d0 = sub * 8, e0 = sub * 16;
          const v4u kw = *(const v4u*)(gk + (size_t)(row0 + c) * 256 + h * 64 + d0);
          float kf[8] = {__builtin_bit_cast(float, kw.x << 16), __builtin_bit_cast(float, kw.x & 0xffff0000u), __builtin_bit_cast(float, kw.y << 16), __builtin_bit_cast(float, kw.y & 0xffff0000u),
                         __builtin_bit_cast(float, kw.z << 16), __builtin_bit_cast(float, kw.z & 0xffff0000u), __builtin_bit_cast(float, kw.w << 16), __builtin_bit_cast(float, kw.w & 0xffff0000u)};
#pragma unroll
          for (int j = 0; j < 8; ++j) kf[j] *= __expf(bl[63 * 64 + d0 + j] - bl[c * 64 + d0 + j]);
          *(v4u*)(kl + c * GL_RSKL + d0 * 2) = (v4u){pk2(kf[0], kf[1]), pk2(kf[2], kf[3]), pk2(kf[4], kf[5]), pk2(kf[6], kf[7])};
          const v4u* vs = (const v4u*)(gv + (size_t)(row0 + c) * 512 + h * 128 + e0);
          *(v4u*)(vv + c * GL_RS128 + e0 * 2) = vs[0]; *(v4u*)(vv + c * GL_RS128 + e0 * 2 + 16) = vs[1]; }
        if (tid < 64) dec[unit * 64 + tid] = __expf(bl[63 * 64 + tid]);
        __syncthreads();
        { const bf16x8 va0 = frag_tr(vv, GL_RS128, 0, 16, wave * 16, fr, fq), va1 = frag_tr(vv, GL_RS128, 32, 48, wave * 16, fr, fq);
#pragma unroll
          for (int dtile = 0; dtile < 4; ++dtile) {
              const bf16x8 kb0 = frag_tr(kl, GL_RSKL, 0, 16, dtile * 16, fr, fq), kb1 = frag_tr(kl, GL_RSKL, 32, 48, dtile * 16, fr, fq);
              f32x4 acc = {0.f, 0.f, 0.f, 0.f};
              acc = __builtin_amdgcn_mfma_f32_16x16x32_bf16(va0, kb0, acc, 0, 0, 0);
              acc = __builtin_amdgcn_mfma_f32_16x16x32_bf16(va1, kb1, acc, 0, 0, 0);
              *(f32x4*)(ds + (size_t)unit * 8192 + (dtile * 16 + fr) * 128 + wave * 16 + 4 * fq) = acc;
          } }
        __syncthreads();
    }
}

__device__ __forceinline__ void gla_scan(const Args& a, int vcu, int G, int tid) {
    float* ds = (float*)(a.ws + R_DS); const float* dec = (const float*)(a.ws + R_DEC);
    for (int e = vcu * NTHR + tid; e < 16 * 8192; e += G * NTHR) {
        const int bh = e >> 13, de = e & 8191, d = de >> 7;
        float S = 0.f;
#pragma unroll 8
        for (int n = 0; n < 64; ++n) { const int unit = bh * 64 + n; float* p = ds + (size_t)unit * 8192 + de;
            const float t = *p; const float dc = dec[unit * 64 + d]; *p = S; S = dc * S + t; }
    }
}

__device__ __forceinline__ void gla_phase_b(const Args& a, unsigned char* lds, int vcu, int G, int tid) {
    unsigned char* ws = a.ws;
    float* bl = (float*)(lds + GL_BL); float* gt = (float*)(lds + GL_GT); float* part = (float*)(lds + GL_PART);
    unsigned char* qd = lds + GL_QD; unsigned char* kd = lds + GL_KD; unsigned char* qb = lds + GL_QB; unsigned char* vv = lds + GL_VV; unsigned char* ss = lds + GL_SS;
    const bf16* gq = (const bf16*)(ws + R_GQ); const bf16* gk = (const bf16*)(ws + R_GK); const bf16* gv = (const bf16*)(ws + R_GV); const bf16* gr = (const bf16*)(ws + R_GR);
    const float* alr = (const float*)(ws + R_ALR); const float* sp = (const float*)(ws + R_DS);
    bf16* ao = (bf16*)(ws + R_AO); const float* hg = a.in[5];
    const int lane = tid & 63, wave = tid >> 6, fr = lane & 15, fq = lane >> 4;
    const int Ti = wave & 3, eh = wave >> 2;
    for (int unit = vcu; unit < NUNIT_GLA; unit += G) {
        const int bb = unit >> 8, h = (unit >> 6) & 3, n = unit & 63, row0 = bb * SEQ + n * 64;
        gla_cumdecay(bl, gt, alr, a.in[3], a.in[4], row0, h, tid);
        { const int c = tid >> 3, sub = tid & 7, d0 = sub * 8, e0 = sub * 16;
          const v4u qw = *(const v4u*)(gq + (size_t)(row0 + c) * 256 + h * 64 + d0), kw = *(const v4u*)(gk + (size_t)(row0 + c) * 256 + h * 64 + d0);
          const unsigned qa[4] = {qw.x, qw.y, qw.z, qw.w}, ka[4] = {kw.x, kw.y, kw.z, kw.w};
          unsigned oqd[4], okd[4], oqb[4];
#pragma unroll
          for (int j = 0; j < 4; ++j) {
              const int d = d0 + 2 * j;
              const float b0 = bl[c * 64 + d], b1 = bl[c * 64 + d + 1], m0 = bl[32 * 64 + d], m1 = bl[32 * 64 + d + 1];
              const float q0 = __builtin_bit_cast(float, qa[j] << 16), q1 = __builtin_bit_cast(float, qa[j] & 0xffff0000u), k0 = __builtin_bit_cast(float, ka[j] << 16), k1 = __builtin_bit_cast(float, ka[j] & 0xffff0000u);
              oqd[j] = pk2(q0 * __expf(b0 - m0), q1 * __expf(b1 - m1)); okd[j] = pk2(k0 * __expf(m0 - b0), k1 * __expf(m1 - b1)); oqb[j] = pk2(q0 * __expf(b0), q1 * __expf(b1)); }
          *(v4u*)(qd + c * GL_RS64 + d0 * 2) = (v4u){oqd[0], oqd[1], oqd[2], oqd[3]};
          *(v4u*)(kd + c * GL_RS64 + d0 * 2) = (v4u){okd[0], okd[1], okd[2], okd[3]};
          *(v4u*)(qb + c * GL_RS64 + d0 * 2) = (v4u){oqb[0], oqb[1], oqb[2], oqb[3]};
          const v4u* vs = (const v4u*)(gv + (size_t)(row0 + c) * 512 + h * 128 + e0);
          *(v4u*)(vv + c * GL_RS128 + e0 * 2) = vs[0]; *(v4u*)(vv + c * GL_RS128 + e0 * 2 + 16) = vs[1];
          const f32x4* sr = (const f32x4*)(sp + (size_t)unit * 8192 + c * 128 + e0);
          const f32x4 s0 = sr[0], s1 = sr[1], s2 = sr[2], s3 = sr[3];
          *(v4u*)(ss + c * GL_RS128 + e0 * 2) = (v4u){pk2(s0[0], s0[1]), pk2(s0[2], s0[3]), pk2(s1[0], s1[1]), pk2(s1[2], s1[3])};
          *(v4u*)(ss + c * GL_RS128 + e0 * 2 + 16) = (v4u){pk2(s2[0], s2[1]), pk2(s2[2], s2[3]), pk2(s3[0], s3[1]), pk2(s3[2], s3[3])}; }
        __syncthreads();
        const bf16x8 qf0 = frag_row(qd, GL_RS64, Ti * 16, 0, fr, fq), qf1 = frag_row(qd, GL_RS64, Ti * 16, 32, fr, fq);
        f32x4 at[4];
#pragma unroll
        for (int Tj = 0; Tj < 4; ++Tj) {
            at[Tj] = (f32x4){0.f, 0.f, 0.f, 0.f};
            if (Tj <= Ti) {
                const bf16x8 kf0 = frag_row(kd, GL_RS64, Tj * 16, 0, fr, fq), kf1 = frag_row(kd, GL_RS64, Tj * 16, 32, fr, fq);
                at[Tj] = __builtin_amdgcn_mfma_f32_16x16x32_bf16(kf0, qf0, at[Tj], 0, 0, 0);
                at[Tj] = __builtin_amdgcn_mfma_f32_16x16x32_bf16(kf1, qf1, at[Tj], 0, 0, 0);
#pragma unroll
                for (int r = 0; r < 4; ++r) if (Tj * 16 + 4 * fq + r > Ti * 16 + fr) at[Tj][r] = 0.f;
            }
        }
        bf16x8 pf[2];
#pragma unroll
        for (int kk = 0; kk < 2; ++kk) { v4u w_;
            w_.x = pg8::cvt_pk_bf16(at[2 * kk][0], at[2 * kk][1]); w_.y = pg8::cvt_pk_bf16(at[2 * kk][2], at[2 * kk][3]);
            w_.z = pg8::cvt_pk_bf16(at[2 * kk + 1][0], at[2 * kk + 1][1]); w_.w = pg8::cvt_pk_bf16(at[2 * kk + 1][2], at[2 * kk + 1][3]);
            pf[kk] = __builtin_bit_cast(bf16x8, w_); }
        const bf16x8 qbf0 = frag_row_perm(qb, GL_RS64, Ti * 16, 0, 16, fr, fq), qbf1 = frag_row_perm(qb, GL_RS64, Ti * 16, 32, 48, fr, fq);
        f32x4 o[4]; float ssq = 0.f;
#pragma unroll
        for (int et = 0; et < 4; ++et) {
            const int ecol = eh * 64 + et * 16;
            f32x4 acc = {0.f, 0.f, 0.f, 0.f};
            acc = __builtin_amdgcn_mfma_f32_16x16x32_bf16(frag_tr(vv, GL_RS128, 0, 16, ecol, fr, fq), pf[0], acc, 0, 0, 0);
            if (Ti >= 2) acc = __builtin_amdgcn_mfma_f32_16x16x32_bf16(frag_tr(vv, GL_RS128, 32, 48, ecol, fr, fq), pf[1], acc, 0, 0, 0);
            acc = __builtin_amdgcn_mfma_f32_16x16x32_bf16(frag_tr(ss, GL_RS128, 0, 16, ecol, fr, fq), qbf0, acc, 0, 0, 0);
            acc = __builtin_amdgcn_mfma_f32_16x16x32_bf16(frag_tr(ss, GL_RS128, 32, 48, ecol, fr, fq), qbf1, acc, 0, 0, 0);
            o[et] = acc;
            ssq += (acc[0] * acc[0] + acc[1] * acc[1]) + (acc[2] * acc[2] + acc[3] * acc[3]);
        }
        ssq += __shfl_xor(ssq, 16); ssq += __shfl_xor(ssq, 32);
        if (fq == 0) part[wave * 16 + fr] = ssq;
        __syncthreads();
        { const float tot = part[wave * 16 + fr] + part[(wave ^ 4) * 16 + fr];
          const float rs = 1.0f / sqrtf(tot * (1.0f / 128.0f) + 1e-6f);
          const size_t row = (size_t)(row0 + Ti * 16 + fr);
#pragma unroll
          for (int et = 0; et < 4; ++et) {
              const int e = eh * 64 + et * 16 + 4 * fq;
              const unsigned long long gw2 = *(const unsigned long long*)(gr + row * 512 + h * 128 + e);
              const f32x4 hv = *(const f32x4*)(hg + e);
              f32x4 y;
              y[0] = o[et][0] * rs * hv[0] * pg8::silu_f(__builtin_bit_cast(float, (unsigned)(gw2 << 16)));
              y[1] = o[et][1] * rs * hv[1] * pg8::silu_f(__builtin_bit_cast(float, (unsigned)gw2 & 0xffff0000u));
              y[2] = o[et][2] * rs * hv[2] * pg8::silu_f(__builtin_bit_cast(float, (unsigned)(gw2 >> 32) << 16));
              y[3] = o[et][3] * rs * hv[3] * pg8::silu_f(__builtin_bit_cast(float, (unsigned)(gw2 >> 32) & 0xffff0000u));
              pg8::st_bf16x4(ao + row * 1024 + h * 128 + e, y);
          } }
        __syncthreads();
    }
}

__device__ __forceinline__ unsigned f2key(float f) { const unsigned u = __builtin_bit_cast(unsigned, f); return (u & 0x80000000u) ? ~u : (u | 0x80000000u); }

typedef float f32x16 __attribute__((ext_vector_type(16)));
__device__ __forceinline__ void dsa_select(const Args& a, unsigned char* lds, int vcu, int G, int tid) {
    unsigned char* ws = a.ws;
    const int lane0 = tid & 63, wave = __builtin_amdgcn_readfirstlane(tid >> 6);
    unsigned* sc = (unsigned*)lds;
    const bf16* iq = (const bf16*)(ws + R_IQ); const bf16* ik = (const bf16*)(ws + R_IK); const float* iw = (const float*)(ws + R_IW);
    unsigned short* idx = (unsigned short*)(ws + R_IDX);
    for (int p = vcu; p < 1024; p += G) {
#pragma unroll 1
        for (int half = 0; half < 2; ++half) {
            int lane = lane0; asm volatile("" : "+v"(lane));
            const int r32 = lane & 31, hh = lane >> 5;
            const int bb = p >> 8, x = p & 255, gi = half ? (511 - x) : x, t0 = gi * 8;
            const size_t qrow0 = (size_t)bb * SEQ + t0;
            const int t = t0 + wave;
            unsigned short* out = idx + (qrow0 + wave) * 256;
            if (t0 < 256) {
#pragma unroll
                for (int j = 0; j < 4; ++j) { const int kk = j * 64 + lane; out[kk] = (unsigned short)(kk <= t ? kk : 0xFFFF); }
                continue;
            }
            bf16x8 af[4];
#pragma unroll
            for (int ks = 0; ks < 4; ++ks) af[ks] = *(const bf16x8*)(iq + (qrow0 + (r32 >> 2)) * 256 + (r32 & 3) * 64 + ks * 16 + hh * 8);
            f32x4 w[4];
#pragma unroll
            for (int j = 0; j < 4; ++j) w[j] = *(const f32x4*)(iw + (qrow0 + 2 * j + hh) * 4);
            const int ntile = ((t0 + 7) >> 5) + 1;
            const bf16* ikb = ik + (size_t)bb * SEQ * 64 + hh * 8;
#define SEL_LOAD(dst, tb) do { _Pragma("unroll") for (int k_ = 0; k_ < 4; ++k_) { int key_ = ((tb) + 8 * k_) * 32 + r32; key_ = key_ > SEQ - 1 ? SEQ - 1 : key_; \
                const bf16* kr_ = ikb + (size_t)key_ * 64; _Pragma("unroll") for (int ks = 0; ks < 4; ++ks) dst[k_][ks] = *(const bf16x8*)(kr_ + ks * 16); } } while (0)
#define SEL_COMP(src, tb) do { _Pragma("unroll") for (int k_ = 0; k_ < 4; ++k_) { const int tile_ = (tb) + 8 * k_; if (tile_ < ntile) { const int key_ = tile_ * 32 + r32; \
                f32x16 dd; _Pragma("unroll") for (int e = 0; e < 16; ++e) dd[e] = 0.f; \
                _Pragma("unroll") for (int ks = 0; ks < 4; ++ks) dd = __builtin_amdgcn_mfma_f32_32x32x16_bf16(af[ks], src[k_][ks], dd, 0, 0, 0); \
                _Pragma("unroll") for (int j = 0; j < 4; ++j) { \
                    const float s_ = (w[j][0] * fmaxf(dd[4 * j], 0.f) + w[j][1] * fmaxf(dd[4 * j + 1], 0.f)) + (w[j][2] * fmaxf(dd[4 * j + 2], 0.f) + w[j][3] * fmaxf(dd[4 * j + 3], 0.f)) + 0.0f; \
                    const int q_ = 2 * j + hh; const unsigned kv_ = f2key(s_); sc[q_ * 4096 + key_] = (key_ <= t0 + q_) ? kv_ : 0u; } } __builtin_amdgcn_sched_barrier(0); } } while (0)
            {
                bf16x8 bufA[4][4], bufB[4][4];
                int tb = wave;
                SEL_LOAD(bufA, tb);
                for (;;) {
                    SEL_LOAD(bufB, tb + 32);
                    SEL_COMP(bufA, tb);
                    tb += 32; if (tb >= ntile) break;
                    SEL_LOAD(bufA, tb + 32);
                    SEL_COMP(bufB, tb);
                    tb += 32; if (tb >= ntile) break;
                }
            }
#undef SEL_LOAD
#undef SEL_COMP
            __syncthreads();
            {
                int ls = lane; asm volatile("" : "+v"(ls));
                const unsigned* scq = sc + wave * 4096;
                unsigned u[64];
                const int tl = t - ls;
#pragma unroll
                for (int j = 0; j < 64; ++j) { const unsigned v_ = scq[j * 64 + ls]; u[j] = (j * 64 <= tl) ? v_ : 0u; }
#define CNT_GE(acc, val, thr) asm volatile("v_cmp_ge_u32_e32 vcc, %1, %2\n\tv_addc_co_u32_e32 %0, vcc, 0, %0, vcc" : "+v"(acc) : "v"(val), "v"(thr) : "vcc")
#define CNT_GT(acc, val, thr) asm volatile("v_cmp_gt_u32_e32 vcc, %1, %2\n\tv_addc_co_u32_e32 %0, vcc, 0, %0, vcc" : "+v"(acc) : "v"(val), "v"(thr) : "vcc")
                unsigned T = 0u;
#pragma unroll 1
                for (int bit = 31; bit >= 0; --bit) {
                    unsigned cand = T | (1u << bit); asm volatile("" : "+v"(cand));
                    int c0 = 0, c1 = 0, c2 = 0, c3 = 0;
#pragma unroll
                    for (int j = 0; j < 64; j += 4) { CNT_GE(c0, u[j], cand); CNT_GE(c1, u[j + 1], cand); CNT_GE(c2, u[j + 2], cand); CNT_GE(c3, u[j + 3], cand); }
                    int cnt = (c0 + c1) + (c2 + c3);
#pragma unroll
                    for (int o = 1; o < 64; o <<= 1) cnt += __shfl_xor(cnt, o);
                    cnt = __builtin_amdgcn_readfirstlane(cnt);
                    if (cnt >= 256) T = cand;
                    if (cnt == 256) break;
                }
                int need;
                { unsigned Tv = T; asm volatile("" : "+v"(Tv));
                  int c0 = 0, c1 = 0, c2 = 0, c3 = 0;
#pragma unroll
                  for (int j = 0; j < 64; j += 4) { CNT_GT(c0, u[j], Tv); CNT_GT(c1, u[j + 1], Tv); CNT_GT(c2, u[j + 2], Tv); CNT_GT(c3, u[j + 3], Tv); }
                  int cnt = (c0 + c1) + (c2 + c3);
#pragma unroll
                  for (int o = 1; o < 64; o <<= 1) cnt += __shfl_xor(cnt, o);
                  need = 256 - __builtin_amdgcn_readfirstlane(cnt); }
#undef CNT_GE
#undef CNT_GT
                unsigned short* lst = (unsigned short*)(lds + 131072) + wave * 512;
                int basev = 0, eqv = 0;
#pragma unroll
                for (int j = 0; j < 64; ++j) {
                    const bool eq = (u[j] == T);
                    const unsigned long long me = __ballot(eq);
                    const int eqrank = __builtin_amdgcn_mbcnt_hi((unsigned)(me >> 32), __builtin_amdgcn_mbcnt_lo((unsigned)me, eqv));
                    const bool take = (u[j] > T) || (eq && eqrank < need);
                    const unsigned long long mf = __ballot(take);
                    const int pos = __builtin_amdgcn_mbcnt_hi((unsigned)(mf >> 32), __builtin_amdgcn_mbcnt_lo((unsigned)mf, basev));
                    lst[take ? pos : 256 + ls] = (unsigned short)(j * 64 + ls);
                    asm volatile("v_bcnt_u32_b32 %0, %1, %0\n\tv_bcnt_u32_b32 %0, %2, %0" : "+v"(basev) : "s"((unsigned)mf), "s"((unsigned)(mf >> 32)));
                    asm volatile("v_bcnt_u32_b32 %0, %1, %0\n\tv_bcnt_u32_b32 %0, %2, %0" : "+v"(eqv) : "s"((unsigned)me), "s"((unsigned)(me >> 32)));
                }
                LDS_WAIT(); asm volatile("" ::: "memory");
                *(unsigned long long*)(out + 4 * ls) = *(const unsigned long long*)(lst + 4 * ls);
            }
            __syncthreads();
        }
    }
}

__device__ __forceinline__ void dsa_attend(const Args& a, unsigned char* lds, int vcu, int G, int tid) {
    unsigned char* ws = a.ws;
    const int lane0 = tid & 63, wave = __builtin_amdgcn_readfirstlane(tid >> 6);
    unsigned char* wl = lds + wave * 12288;
    int* kl = (int*)(wl + 10240);
    const bf16* bq = (const bf16*)(ws + R_BQ); const bf16* bk = (const bf16*)(ws + R_BK); const bf16* bv = (const bf16*)(ws + R_BV);
    const unsigned short* idx = (const unsigned short*)(ws + R_IDX);
    bf16* ao = (bf16*)(ws + R_AO);
    const int gw = vcu * NWAVES + wave, NGW = G * NWAVES;
    for (int p = gw; p < M / 2; p += NGW) {
#pragma unroll 1
        for (int half = 0; half < 2; ++half) {
            int lane = lane0; asm volatile("" : "+v"(lane));
            const int fr = lane & 15, fq = lane >> 4;
            const int bb = p >> 11, x = p & 2047, t = half ? (SEQ - 1 - x) : x;
            const size_t q = (size_t)bb * SEQ + t;
            const int cnt = t < 255 ? t + 1 : 256;
            { const unsigned long long w4 = *(const unsigned long long*)(idx + q * 256 + 4 * lane);
              int k0 = (int)(w4 & 0xffffu), k1 = (int)((w4 >> 16) & 0xffffu), k2 = (int)((w4 >> 32) & 0xffffu), k3 = (int)(w4 >> 48);
              const int p0 = 4 * lane;
              k0 = p0 < cnt ? k0 : 0; k1 = p0 + 1 < cnt ? k1 : 0; k2 = p0 + 2 < cnt ? k2 : 0; k3 = p0 + 3 < cnt ? k3 : 0;
              *(v4u*)(kl + p0) = (v4u){(unsigned)k0, (unsigned)k1, (unsigned)k2, (unsigned)k3}; }
            bf16x8 qf[2];
#pragma unroll
            for (int ks = 0; ks < 2; ++ks) qf[ks] = *(const bf16x8*)(bq + q * 512 + (fr & 7) * 64 + ks * 32 + fq * 8);
            LDS_WAIT(); asm volatile("" ::: "memory");
            const bf16* bkb = bk + (size_t)bb * SEQ * 64 + fq * 8;
            const bf16* bvb = bv + (size_t)bb * SEQ * 64 + (lane & 7) * 8;
            v4u vreg[8];
#pragma unroll
            for (int i = 0; i < 8; ++i) vreg[i] = *(const v4u*)(bvb + (size_t)kl[(lane >> 3) + 8 * i] * 64);
            f32x4 s[16];
#pragma unroll
            for (int T = 0; T < 16; ++T) {
                const bf16* kp = bkb + (size_t)kl[T * 16 + fr] * 64;
                const bf16x8 k0 = *(const bf16x8*)kp, k1 = *(const bf16x8*)(kp + 32);
                f32x4 z = {0.f, 0.f, 0.f, 0.f};
                z = __builtin_amdgcn_mfma_f32_16x16x32_bf16(k0, qf[0], z, 0, 0, 0);
                s[T] = __builtin_amdgcn_mfma_f32_16x16x32_bf16(k1, qf[1], z, 0, 0, 0);
            }
            float mx = -INFINITY;
#pragma unroll
            for (int T = 0; T < 16; ++T)
#pragma unroll
                for (int r = 0; r < 4; ++r) { if (T * 16 + 4 * fq + r >= cnt) s[T][r] = -INFINITY; mx = fmaxf(mx, s[T][r]); }
            mx = fmaxf(mx, __shfl_xor(mx, 16)); mx = fmaxf(mx, __shfl_xor(mx, 32));
            float sum = 0.f;
#pragma unroll
            for (int T = 0; T < 16; ++T)
#pragma unroll
                for (int r = 0; r < 4; ++r) { const float pv = __expf(s[T][r] - mx); s[T][r] = pv; sum += pv; }
            sum += __shfl_xor(sum, 16); sum += __shfl_xor(sum, 32);
            const float inv = 1.0f / sum;
            bf16x8 pf[8];
#pragma unroll
            for (int kk = 0; kk < 8; ++kk) { v4u w_;
                w_.x = pg8::cvt_pk_bf16(s[2 * kk][0], s[2 * kk][1]); w_.y = pg8::cvt_pk_bf16(s[2 * kk][2], s[2 * kk][3]);
                w_.z = pg8::cvt_pk_bf16(s[2 * kk + 1][0], s[2 * kk + 1][1]); w_.w = pg8::cvt_pk_bf16(s[2 * kk + 1][2], s[2 * kk + 1][3]);
                pf[kk] = __builtin_bit_cast(bf16x8, w_); }
            f32x4 o[4];
#pragma unroll
            for (int dt = 0; dt < 4; ++dt) o[dt] = (f32x4){0.f, 0.f, 0.f, 0.f};
            const unsigned char* trb = wl + (4 * fq + (fr >> 2)) * 160 + (fr & 3) * 8;
#pragma unroll
            for (int c = 0; c < 4; ++c) {
#pragma unroll
                for (int i = 0; i < 8; ++i) *(v4u*)(wl + ((lane >> 3) + 8 * i) * 160 + (lane & 7) * 16) = vreg[i];
                if (c < 3) {
#pragma unroll
                    for (int i = 0; i < 8; ++i) vreg[i] = *(const v4u*)(bvb + (size_t)kl[64 * (c + 1) + (lane >> 3) + 8 * i] * 64);
                }
                LDS_WAIT(); asm volatile("" ::: "memory");
#pragma unroll
                for (int k2 = 0; k2 < 2; ++k2)
#pragma unroll
                    for (int dt = 0; dt < 4; ++dt) {
                        const v4i16_t a0 = tr16(trb + (2 * k2) * 16 * 160 + dt * 32), a1 = tr16(trb + (2 * k2 + 1) * 16 * 160 + dt * 32);
                        const bf16x8 vf = {a0[0], a0[1], a0[2], a0[3], a1[0], a1[1], a1[2], a1[3]};
                        o[dt] = __builtin_amdgcn_mfma_f32_16x16x32_bf16(vf, pf[2 * c + k2], o[dt], 0, 0, 0);
                    }
                LDS_WAIT(); asm volatile("" ::: "memory");
            }
            if (fr < 8) {
#pragma unroll
                for (int dt = 0; dt < 4; ++dt) pg8::st_bf16x4(ao + q * 1024 + 512 + fr * 64 + dt * 16 + 4 * fq, o[dt] * inv);
            }
        }
    }
}

__device__ __forceinline__ void ffn_fixup(const Args& a, int layer, int vcu, int G, int tid) {
    unsigned char* ws = a.ws;
    const float* hl = (const float*)(ws + R_HL); const float* hf = (const float*)(ws + R_HF);
    const float* cw = a.in[16] + (size_t)layer * 3 * DFF2; const float* cb = a.in[17] + (size_t)layer * DFF2;
    bf16* gt = (bf16*)(ws + R_GT);
    for (int it = vcu * NTHR + tid; it < 256 * 2 * (DFF / 4); it += G * NTHR) {
        const int cg = it % (DFF / 4), rr = (it / (DFF / 4)) & 1, blk = it / (2 * (DFF / 4));
        const int g0 = cg * 4; const bool bstart = (blk & 63) == 0;
        const f32x4 z4 = {0.f, 0.f, 0.f, 0.f};
        f32x4 a0g, a0u, a1g, a1u, a2g, a2u;
        { const float* h0 = hf + (size_t)(blk * 2 + rr) * DFF2 + g0; a0g = *(const f32x4*)h0; a0u = *(const f32x4*)(h0 + DFF); }
        if (rr == 1) {
            const float* h1 = hf + (size_t)(blk * 2) * DFF2 + g0; a1g = *(const f32x4*)h1; a1u = *(const f32x4*)(h1 + DFF);
            if (bstart) { a2g = z4; a2u = z4; } else { const float* h2 = hl + (size_t)((blk - 1) * 2 + 1) * DFF2 + g0; a2g = *(const f32x4*)h2; a2u = *(const f32x4*)(h2 + DFF); }
        } else {
            if (bstart) { a1g = z4; a1u = z4; a2g = z4; a2u = z4; }
            else { const float* h1 = hl + (size_t)((blk - 1) * 2 + 1) * DFF2 + g0; a1g = *(const f32x4*)h1; a1u = *(const f32x4*)(h1 + DFF);
                   const float* h2 = hl + (size_t)((blk - 1) * 2) * DFF2 + g0; a2g = *(const f32x4*)h2; a2u = *(const f32x4*)(h2 + DFF); }
        }
        const f32x4 cgv = *(const f32x4*)(cb + g0) + *(const f32x4*)(cw + g0) * a2g + *(const f32x4*)(cw + DFF2 + g0) * a1g + *(const f32x4*)(cw + 2 * DFF2 + g0) * a0g;
        const f32x4 cuv = *(const f32x4*)(cb + DFF + g0) + *(const f32x4*)(cw + DFF + g0) * a2u + *(const f32x4*)(cw + DFF2 + DFF + g0) * a1u + *(const f32x4*)(cw + 2 * DFF2 + DFF + g0) * a0u;
        f32x4 o; o[0] = pg8::silu_f(cgv[0]) * cuv[0]; o[1] = pg8::silu_f(cgv[1]) * cuv[1]; o[2] = pg8::silu_f(cgv[2]) * cuv[2]; o[3] = pg8::silu_f(cgv[3]) * cuv[3];
        pg8::st_bf16x4(gt + (size_t)(blk * 64 + rr) * DFF + g0, o);
    }
}

__device__ __forceinline__ void sgu_mix(const Args& a, unsigned char* lds, int vcu, int G, int tid) {
    unsigned char* ws = a.ws;
    constexpr int RSV = 288, RSW = 272;
    unsigned char* vn = lds;
    unsigned char* wl = lds + 128 * RSV;
    const bf16* z = (const bf16*)(ws + R_Z); bf16* sg = (bf16*)(ws + R_SG);
    const float* lns = (const float*)(ws + WS_SSQ) + 5 * M; const float* lnq = lns + M;
    const float* lg = a.in[9]; const float* lb = a.in[10]; const float* wsp = a.in[11]; const float* bs = a.in[12];
    const int lane = tid & 63, wave = tid >> 6, fr = lane & 15, fq = lane >> 4;
    int gcur = -1;
    for (int unit = vcu; unit < 1024; unit += G) {
        const int g = unit & 7, ci = unit >> 3, row0 = ci * 128;
        if (g != gcur) {
            gcur = g;
            const int t = tid >> 2, s0 = (tid & 3) * 32;
            const f32x4* wr = (const f32x4*)(wsp + ((size_t)g * 128 + t) * 128 + s0);
#pragma unroll
            for (int j = 0; j < 4; ++j) { const f32x4 w0 = wr[2 * j], w1 = wr[2 * j + 1]; const int s = s0 + 8 * j;
                *(v4u*)(wl + t * RSW + s * 2) = (v4u){pk2(s <= t ? w0[0] : 0.f, s + 1 <= t ? w0[1] : 0.f), pk2(s + 2 <= t ? w0[2] : 0.f, s + 3 <= t ? w0[3] : 0.f),
                                                     pk2(s + 4 <= t ? w1[0] : 0.f, s + 5 <= t ? w1[1] : 0.f), pk2(s + 6 <= t ? w1[2] : 0.f, s + 7 <= t ? w1[3] : 0.f)}; }
        }
        { const int s = tid >> 2, c0 = (tid & 3) * 32; const size_t row = (size_t)(row0 + s);
          const float mean = lns[row] * (1.0f / 1024.0f); const float var = lnq[row] * (1.0f / 1024.0f) - mean * mean; const float rstd = 1.0f / sqrtf(var + 1e-5f);
          const v4u* zr = (const v4u*)(z + row * 2048 + 1024 + g * 128 + c0);
#pragma unroll
          for (int j = 0; j < 4; ++j) { const v4u zw = zr[j]; const int c = g * 128 + c0 + 8 * j;
              const f32x4 g0 = *(const f32x4*)(lg + c), g1 = *(const f32x4*)(lg + c + 4), b0 = *(const f32x4*)(lb + c), b1 = *(const f32x4*)(lb + c + 4);
              const float v0 = (__builtin_bit_cast(float, zw.x << 16) - mean) * rstd * g0[0] + b0[0], v1 = (__builtin_bit_cast(float, zw.x & 0xffff0000u) - mean) * rstd * g0[1] + b0[1];
              const float v2 = (__builtin_bit_cast(float, zw.y << 16) - mean) * rstd * g0[2] + b0[2], v3 = (__builtin_bit_cast(float, zw.y & 0xffff0000u) - mean) * rstd * g0[3] + b0[3];
              const float v4 = (__builtin_bit_cast(float, zw.z << 16) - mean) * rstd * g1[0] + b1[0], v5 = (__builtin_bit_cast(float, zw.z & 0xffff0000u) - mean) * rstd * g1[1] + b1[1];
              const float v6 = (__builtin_bit_cast(float, zw.w << 16) - mean) * rstd * g1[2] + b1[2], v7 = (__builtin_bit_cast(float, zw.w & 0xffff0000u) - mean) * rstd * g1[3] + b1[3];
              *(v4u*)(vn + s * RSV + (c0 + 8 * j) * 2) = (v4u){pk2(v0, v1), pk2(v2, v3), pk2(v4, v5), pk2(v6, v7)}; } }
        __syncthreads();
        bf16x8 af[4];
#pragma unroll
        for (int ks = 0; ks < 4; ++ks) af[ks] = frag_tr(vn, RSV, 32 * ks, 32 * ks + 16, wave * 16, fr, fq);
#pragma unroll
        for (int Tt = 0; Tt < 8; ++Tt) {
            f32x4 acc = {0.f, 0.f, 0.f, 0.f};
#pragma unroll
            for (int ks = 0; ks <= Tt / 2; ++ks) acc = __builtin_amdgcn_mfma_f32_16x16x32_bf16(af[ks], frag_row_perm(wl, RSW, Tt * 16, 32 * ks, 32 * ks + 16, fr, fq), acc, 0, 0, 0);
            const int t = Tt * 16 + fr; const size_t row = (size_t)(row0 + t);
            const float bias = bs[g * 128 + t];
            const int col = g * 128 + wave * 16 + 4 * fq;
            const unsigned long long uw = *(const unsigned long long*)(z + row * 2048 + col);
            f32x4 o;
            o[0] = __builtin_bit_cast(float, (unsigned)(uw << 16)) * (acc[0] + bias); o[1] = __builtin_bit_cast(float, (unsigned)uw & 0xffff0000u) * (acc[1] + bias);
            o[2] = __builtin_bit_cast(float, (unsigned)(uw >> 32) << 16) * (acc[2] + bias); o[3] = __builtin_bit_cast(float, (unsigned)(uw >> 32) & 0xffff0000u) * (acc[3] + bias);
            pg8::st_bf16x4(sg + row * 1024 + col, o);
        }
        __syncthreads();
    }
}

__device__ __forceinline__ void final_norm(const Args& a, int vcu, int G, int tid) {
    const int lane = tid & 63, wave = tid >> 6;
    const float* g = a.in[19];
    for (int m = vcu * NWAVES + wave; m < M; m += G * NWAVES) {
        f32x4* xr = (f32x4*)(a.out + (size_t)m * DM) + lane;
        f32x4 v[4]; float s = 0.f;
#pragma unroll
        for (int j = 0; j < 4; ++j) { v[j] = xr[64 * j]; s += (v[j].x * v[j].x + v[j].y * v[j].y) + (v[j].z * v[j].z + v[j].w * v[j].w); }
        const float rs = 1.0f / sqrtf(wave_sum(s) * (1.0f / 1024.0f) + 1e-6f);
#pragma unroll
        for (int j = 0; j < 4; ++j) xr[64 * j] = v[j] * rs * *((const f32x4*)g + lane + 64 * j);
    }
}

__device__ __forceinline__ int opq(int x) { asm volatile("" : "+s"(x)); return x; }
__device__ __forceinline__ int opqv(int x) { asm volatile("" : "+v"(x)); return x; }
constexpr int NPHASE = 16;
__global__ void __launch_bounds__(NTHR, 2) fwd_megakernel(Args args) {
    extern __shared__ __attribute__((aligned(16))) unsigned char lds[];
    const int tid = threadIdx.x;
    const int G = gridDim.x; const int bx = blockIdx.x;
    const int vcu = (G % 8 == 0) ? (bx % 8) * (G / 8) + bx / 8 : bx;
    unsigned char* ws = args.ws;
    for (int u = tid; u < (LDS_BYTES - LDSCTL_OFF) / 4; u += NTHR) ((LAS unsigned*)((LAS unsigned char*)lds + LDSCTL_OFF))[u] = 0u;
    __syncthreads();
    XcdBarrier bar; bar.bar = (unsigned*)(ws + WS_CTL) + CW_BAR; bar.x = 0; bar.st = nullptr;
    const int lo = args.ph_lo, hi = args.ph_hi;
    if (hi - lo > 1) bar = xcd_barrier_post((unsigned*)(ws + WS_CTL) + CW_BAR, (volatile LAS unsigned*)((LAS unsigned char*)lds + MISC_OFF) + 8);
#ifdef PHASE_MASK
#define IN(k) (((PHASE_MASK >> (k)) & 1) && lo <= (k) && (k) < hi)
#else
#define IN(k) (lo <= (k) && (k) < hi)
#endif
#define SEAM(k) do { if (IN(k) && IN((k) + 1)) xcd_barrier(bar); } while (0)
    LAS unsigned char* ring = (LAS unsigned char*)lds;
    float* ssq = (float*)(ws + WS_SSQ);
    bf16* xb = (bf16*)(ws + WS_XB);

    if (IN(0)) { p0_prologue(args, lds, opq(vcu), G, opqv(tid)); __syncthreads(); } SEAM(0);

    if (IN(1)) {
        pg8::Gemm g{xb, (const bf16*)(ws + WS_WIN), M, NIN, DM}; pg8::StaticOrder S; S.init(M, NIN, G, opq(bx));
        pg8::EpiIn E{ssq, (const float*)(ws + WS_ROPE), (bf16*)(ws + R_GQ), (bf16*)(ws + R_GK), (bf16*)(ws + R_GV), (bf16*)(ws + R_GR), (bf16*)(ws + R_BQ), (bf16*)(ws + R_BK), (bf16*)(ws + R_BV),
                      (bf16*)(ws + R_IQ), (bf16*)(ws + R_IK), (float*)(ws + R_ALR), (float*)(ws + R_IW)};
        pg8::gemm_phase<pg8::EpiIn, pg8::StaticOrder, true, true>(ring, g, S, E);
    } SEAM(1);

    if (IN(2)) { gla_phase_a(args, lds, opq(vcu), G, opqv(tid)); dsa_select(args, lds, opq(vcu), G, opqv(tid)); __syncthreads(); } SEAM(2);
    if (IN(3)) { gla_scan(args, opq(vcu), G, opqv(tid)); dsa_attend(args, lds, opq(vcu), G, opqv(tid)); __syncthreads(); } SEAM(3);
    if (IN(4)) { gla_phase_b(args, lds, opq(vcu), G, opqv(tid)); } SEAM(4);

    if (IN(5)) {
        pg8::Gemm g{(const bf16*)(ws + R_AO), (const bf16*)(ws + WS_WO), M, DM, DM}; pg8::StaticOrder S; S.init(M, DM, G, opq(bx));
        pg8::EpiRes E{args.in[0], args.out, xb, ssq + M};
        pg8::gemm_phase<pg8::EpiRes, pg8::StaticOrder, true, true>(ring, g, S, E);
    } SEAM(5);

#pragma unroll 1
    for (int layer = 0; layer < 2; ++layer) {
        const int pb = layer == 0 ? 6 : 12;
        if (IN(pb)) {
            pg8::Gemm g{xb, (const bf16*)(ws + (layer == 0 ? WS_WUP0 : WS_WUP1)), M, DFF2, DM}; pg8::StaticOrder S; S.init(M, DFF2, G, opq(bx));
            pg8::EpiConv E{ssq + (layer == 0 ? 1 : 3) * M, args.in[16] + (size_t)layer * 3 * DFF2, args.in[17] + (size_t)layer * DFF2, (bf16*)(ws + R_GT), (float*)(ws + R_HL), (float*)(ws + R_HF)};
            pg8::gemm_phase<pg8::EpiConv, pg8::StaticOrder, true, true>(ring, g, S, E);
        } SEAM(pb);
        if (IN(pb + 1)) { ffn_fixup(args, layer, opq(vcu), G, opqv(tid)); } SEAM(pb + 1);
        if (IN(pb + 2)) {
            pg8::Gemm g{(const bf16*)(ws + R_GT), (const bf16*)(ws + (layer == 0 ? WS_WDN0 : WS_WDN1)), M, DM, DFF}; pg8::StaticOrder S; S.init(M, DM, G, opq(bx));
            pg8::EpiRes E{args.out, args.out, xb, ssq + (layer == 0 ? 2 : 4) * M};
            pg8::gemm_phase<pg8::EpiRes, pg8::StaticOrder, true, true>(ring, g, S, E);
        } SEAM(pb + 2);
        if (layer == 0) {
            if (IN(9)) {
                pg8::Gemm g{xb, (const bf16*)(ws + WS_WUV), M, 2048, DM}; pg8::StaticOrder S; S.init(M, 2048, G, opq(bx));
                pg8::EpiSgu E{ssq + 2 * M, (bf16*)(ws + R_Z), ssq + 5 * M, ssq + 6 * M};
                pg8::gemm_phase<pg8::EpiSgu, pg8::StaticOrder, true, true>(ring, g, S, E);
            } SEAM(9);
            if (IN(10)) { sgu_mix(args, lds, opq(vcu), G, opqv(tid)); } SEAM(10);
            if (IN(11)) {
                pg8::Gemm g{(const bf16*)(ws + R_SG), (const bf16*)(ws + WS_WOUT), M, DM, DM}; pg8::StaticOrder S; S.init(M, DM, G, opq(bx));
                pg8::EpiRes E{args.out, args.out, xb, ssq + 3 * M};
                pg8::gemm_phase<pg8::EpiRes, pg8::StaticOrder, true, true>(ring, g, S, E);
            } SEAM(11);
        }
    }
    if (IN(15)) { final_norm(args, opq(vcu), G, opqv(tid)); }
#undef IN
#undef SEAM
}

extern "C" void kernel_launch(void* const* d_in, const int* in_sizes, int n_in, void* d_out, int out_size, void* d_ws, size_t ws_size, hipStream_t stream) {
    static int grid = 0;
    if (grid == 0) {
        if (n_in != 20 || out_size != M * DM || ws_size < WS_END) { fprintf(stderr, "kernel_launch: unexpected problem (n_in %d, out %d, ws %zu)\n", n_in, out_size, ws_size); grid = -1; return; }
        int dev = 0, cus = 0, per_cu = 0;
        if (hipGetDevice(&dev) != hipSuccess || hipDeviceGetAttribute(&cus, hipDeviceAttributeMultiprocessorCount, dev) != hipSuccess) { grid = -1; return; }
        if (hipFuncSetAttribute((const void*)fwd_megakernel, hipFuncAttributeMaxDynamicSharedMemorySize, LDS_BYTES) != hipSuccess) { fprintf(stderr, "kernel_launch: hipFuncSetAttribute failed\n"); grid = -1; return; }
        if (hipOccupancyMaxActiveBlocksPerMultiprocessor(&per_cu, (const void*)fwd_megakernel, NTHR, LDS_BYTES) != hipSuccess || per_cu < 1)
            fprintf(stderr, "kernel_launch: note: occupancy query reports %d workgroups per CU\n", per_cu);
        (void)hipGetLastError();
        grid = cus;
    }
    if (grid < 0) return;
    if (hipMemsetAsync((char*)d_ws + WS_CTL, 0, CTL_ZERO_BYTES, stream) != hipSuccess) { fprintf(stderr, "kernel_launch: hipMemsetAsync failed\n"); return; }
    Args a{};
    for (int i = 0; i < 20; ++i) a.in[i] = (const float*)d_in[i];
    a.out = (float*)d_out; a.ws = (unsigned char*)d_ws;
#if MK_MULTI
    for (int p = 0; p < NPHASE; ++p) { a.ph_lo = p; a.ph_hi = p + 1; hipLaunchKernelGGL(fwd_megakernel, dim3(grid), dim3(NTHR), LDS_BYTES, stream, a); }
#else
    a.ph_lo = 0; a.ph_hi = NPHASE;
    hipLaunchKernelGGL(fwd_megakernel, dim3(grid), dim3(NTHR), LDS_BYTES, stream, a);
#endif
    const hipError_t le = hipPeekAtLastError();
    if (le != hipSuccess) fprintf(stderr, "kernel_launch: launch failed: %s\n", hipGetErrorName(le));
}
```

```cpp
#include <hip/hip_runtime.h>
#include <cstdio>
#include <cstdint>

#ifndef MK_MULTI
#define MK_MULTI 0
#endif

namespace pg8 {
#define PG8_LAS __attribute__((address_space(3)))
typedef unsigned short bf16_t;
typedef short bf16x8 __attribute__((ext_vector_type(8)));
typedef float f32x4 __attribute__((ext_vector_type(4)));
typedef unsigned u32x4 __attribute__((ext_vector_type(4)));
constexpr int BM = 256, BK = 64, HALF = 128, HTB = HALF * BK * 2  , STAGE_BYTES = 8 * HTB, NXCD = 8, WGM = 8;

__host__ __device__ __forceinline__ int lds_byte(int r, int c) { const int st = (r >> 4) * 2 + (c >> 5), rr = r & 15, cc = c & 31, ob = rr * 64 + cc * 2; return st * 1024 + (ob ^ (((ob >> 9) & 1) << 5)); }
__host__ __device__ __forceinline__ void stage_rc(int b, int& R, int& C) { const int st = b / 1024, sb = b % 1024, swz = sb ^ (((sb >> 9) & 1) << 5); R = (st >> 1) * 16 + swz / 64; C = (st & 1) * 32 + (swz % 64) / 2; }
__host__ __device__ __forceinline__ int perm32(int rho) { const int n = rho >> 4, i = rho & 15; return 8 * (i >> 2) + 4 * n + (i & 3); }

struct Unit { int pm, pn; };
struct Gemm { const bf16_t* A; const bf16_t* Bt; int M, N, K; };

struct StaticOrder {
    int nM, nN, nwg, G, c;
    __host__ __device__ void init(int M, int N, int G_, int c_) { nM = M / BM; nN = N / BM; nwg = nM * nN; G = G_; c = c_; }
    __host__ __device__ bool next(int i, Unit& u) const {
        const long L = (long)i * G + c; if (L >= nwg) return false;
        int wgid = (int)L; { const int q = nwg / NXCD, r = nwg % NXCD, xcd = wgid % NXCD, off = wgid / NXCD; wgid = (xcd < r ? xcd * (q + 1) : r * (q + 1) + (xcd - r) * q) + off; }
        const int nig = WGM * nN, gid = wgid / nig, fm = gid * WGM, gsz = (nM - fm) < WGM ? (nM - fm) : WGM;
        u.pm = fm + ((wgid % nig) % gsz); u.pn = (wgid % nig) / gsz; return true;
    }
    __device__ __forceinline__ void a_ready(const Unit&) const {}
    __device__ __forceinline__ void done(const Unit&) const {}
};

__device__ __forceinline__ unsigned cvt_pk_bf16(float lo, float hi) { unsigned r; asm volatile("v_cvt_pk_bf16_f32 %0, %1, %2" : "=v"(r) : "v"(lo), "v"(hi)); return r; }
typedef float f32x2 __attribute__((ext_vector_type(2)));
typedef unsigned u32x2 __attribute__((ext_vector_type(2)));
__device__ __forceinline__ void st_bf16x4(bf16_t* p, f32x4 v) { u32x2 w; w.x = cvt_pk_bf16(v[0], v[1]); w.y = cvt_pk_bf16(v[2], v[3]); *(u32x2*)p = w; }
__device__ __forceinline__ float sigm(float x) { return 1.0f / (1.0f + __expf(-x)); }
__device__ __forceinline__ float silu_f(float x) { return x * sigm(x); }
__device__ __forceinline__ float gelu_tanh_f(float x) { const float u = 0.7978845608028654f * (x + 0.044715f * x * x * x); return x * sigm(2.0f * u); }
__device__ __forceinline__ f32x4 shfl4(f32x4 v, int src) { f32x4 r; r[0] = __shfl(v[0], src); r[1] = __shfl(v[1], src); r[2] = __shfl(v[2], src); r[3] = __shfl(v[3], src); return r; }
__device__ __forceinline__ f32x4 rope4(f32x4 v, const float* tab_t, int fq) {
    const f32x4 cs = *(const f32x4*)(tab_t + 4 * fq);
    f32x4 o; o[0] = v[0] * cs[0] - v[1] * cs[1]; o[1] = v[1] * cs[0] + v[0] * cs[1]; o[2] = v[2] * cs[2] - v[3] * cs[3]; o[3] = v[3] * cs[2] + v[2] * cs[3]; return o;
}

struct EpiIn {
    static constexpr bool PERM = false, AFTER_DRAIN = false;
    const float* ssq; const float* rope;
    bf16_t *gq, *gk, *gv, *gr, *bq, *bk, *bv, *iq, *ik; float *alr, *iw;
    __device__ __forceinline__ void operator()(const f32x4 (&acc)[2][2][4][2], const Unit& u, int wr, int wc, int fr_in, int fq_in) const {
        int fr = fr_in, fq = fq_in; asm volatile("" : "+v"(fr), "+v"(fq));
        const int pn = u.pn;
        float rsv[2][4];
#pragma unroll
        for (int ai = 0; ai < 2; ++ai)
#pragma unroll
            for (int m = 0; m < 4; ++m) rsv[ai][m] = 1.0f / sqrtf(ssq[u.pm * BM + ai * HALF + wr * 64 + m * 16 + fr] * (1.0f / 1024.0f) + 1e-6f);
#pragma unroll
        for (int ai = 0; ai < 2; ++ai)
#pragma unroll
            for (int m = 0; m < 4; ++m) {
                const int r = u.pm * BM + ai * HALF + wr * 64 + m * 16 + fr;
                const float rs = rsv[ai][m];
                const float* tab_t = rope + (size_t)(r & 4095) * 16;
#pragma unroll
                for (int bj = 0; bj < 2; ++bj)
#pragma unroll
                    for (int n = 0; n < 2; ++n) {
                        f32x4 v = acc[ai][bj][m][n] * rs;
                        const int cl = bj * HALF + wc * 32 + n * 16 + 4 * fq;
                        const bool ropecol = ((wc & 1) == 0) && (n == 0);
                        if (pn == 0) { st_bf16x4(gq + (size_t)r * 256 + cl, v * 0.125f); }
                        else if (pn == 1) { st_bf16x4(gk + (size_t)r * 256 + cl, v); }
                        else if (pn < 4) { st_bf16x4(gv + (size_t)r * 512 + (pn - 2) * 256 + cl, v); }
                        else if (pn < 6) { st_bf16x4(gr + (size_t)r * 512 + (pn - 4) * 256 + cl, v); }
                        else if (pn < 8) { if (ropecol) v = rope4(v, tab_t, fq); st_bf16x4(bq + (size_t)r * 512 + (pn - 6) * 256 + cl, v * 0.125f); }
                        else if (pn == 8) { if (ropecol) v = rope4(v, tab_t, fq); st_bf16x4(iq + (size_t)r * 256 + cl, v); }
                        else {
                            const int reg = bj * 2 + (wc >> 1);
                            const int c64 = cl & 63;
                            if (reg == 0) { if (ropecol) v = rope4(v, tab_t, fq); st_bf16x4(bk + (size_t)r * 64 + c64, v); }
                            else if (reg == 1) { st_bf16x4(bv + (size_t)r * 64 + c64, v); }
                            else if (reg == 2) { if (ropecol) v = rope4(v, tab_t, fq); const int key_ = r & 4095; st_bf16x4(ik + (size_t)(r >> 12) * (4096 * 64) + ((((key_ >> 5) * 4 + (c64 >> 4)) * 64 + ((c64 >> 3) & 1) * 32 + (key_ & 31)) * 8) + (c64 & 7), v); }
                            else if ((wc & 1) == 0) {
                                if (n == 0) *(f32x4*)(alr + (size_t)r * 16 + 4 * fq) = v;
                                else if (fq == 0) *(f32x4*)(iw + (size_t)r * 4) = v * 0.5f;
                            }
                        }
                    }
            }
    }
};

struct EpiRes {
    static constexpr bool PERM = false, AFTER_DRAIN = false;
    bf16_t* xb; float* ssq;
    __device__ __forceinline__ void operator()(const f32x4 (&acc)[2][2][4][2], const Unit& u, int wr, int wc, int fr_in, int fq_in) const {
        int fr = fr_in, fq = fq_in; asm volatile("" : "+v"(fr), "+v"(fq));
#pragma unroll
        for (int ai = 0; ai < 2; ++ai)
#pragma unroll
            for (int m = 0; m < 4; ++m) {
                const int r = u.pm * BM + ai * HALF + wr * 64 + m * 16 + fr;
                float s = 0.f;
#pragma unroll
                for (int bj = 0; bj < 2; ++bj)
#pragma unroll
                    for (int n = 0; n < 2; ++n) {
                        const size_t off = (size_t)r * 1024 + u.pn * BM + bj * HALF + wc * 32 + n * 16 + 4 * fq;
                        const u32x2 bw = *(const u32x2*)(xb + off);
                        f32x4 x = acc[ai][bj][m][n];
                        x[0] += __builtin_bit_cast(float, bw.x << 16); x[1] += __builtin_bit_cast(float, bw.x & 0xffff0000u);
                        x[2] += __builtin_bit_cast(float, bw.y << 16); x[3] += __builtin_bit_cast(float, bw.y & 0xffff0000u);
                        st_bf16x4(xb + off, x);
                        s += (x[0] * x[0] + x[1] * x[1]) + (x[2] * x[2] + x[3] * x[3]);
                    }
                s += __shfl_xor(s, 16); s += __shfl_xor(s, 32);
                if (fq == 0) atomicAdd(ssq + r, s);
            }
    }
};

struct EpiSgu {
    static constexpr bool PERM = false, AFTER_DRAIN = false;
    const float* ssq; bf16_t* z; float* lns; float* lnq;
    __device__ __forceinline__ void operator()(const f32x4 (&acc)[2][2][4][2], const Unit& u, int wr, int wc, int fr_in, int fq_in) const {
        int fr = fr_in, fq = fq_in; asm volatile("" : "+v"(fr), "+v"(fq));
        const bool vhalf = u.pn >= 4;
        float rsv[2][4];
#pragma unroll
        for (int ai = 0; ai < 2; ++ai)
#pragma unroll
            for (int m = 0; m < 4; ++m) rsv[ai][m] = 1.0f / sqrtf(ssq[u.pm * BM + ai * HALF + wr * 64 + m * 16 + fr] * (1.0f / 1024.0f) + 1e-6f);
#pragma unroll
        for (int ai = 0; ai < 2; ++ai)
#pragma unroll
            for (int m = 0; m < 4; ++m) {
                const int r = u.pm * BM + ai * HALF + wr * 64 + m * 16 + fr;
                const float rs = rsv[ai][m];
                float s = 0.f, q = 0.f;
#pragma unroll
                for (int bj = 0; bj < 2; ++bj)
#pragma unroll
                    for (int n = 0; n < 2; ++n) {
                        f32x4 v = acc[ai][bj][m][n] * rs;
                        v[0] = gelu_tanh_f(v[0]); v[1] = gelu_tanh_f(v[1]); v[2] = gelu_tanh_f(v[2]); v[3] = gelu_tanh_f(v[3]);
                        st_bf16x4(z + (size_t)r * 2048 + u.pn * BM + bj * HALF + wc * 32 + n * 16 + 4 * fq, v);
                        s += (v[0] + v[1]) + (v[2] + v[3]); q += (v[0] * v[0] + v[1] * v[1]) + (v[2] * v[2] + v[3] * v[3]);
                    }
                if (vhalf) {
                    s += __shfl_xor(s, 16); s += __shfl_xor(s, 32); q += __shfl_xor(q, 16); q += __shfl_xor(q, 32);
                    if (fq == 0) { atomicAdd(lns + r, s); atomicAdd(lnq + r, q); }
                }
            }
    }
};

struct EpiConv {
    static constexpr bool PERM = false, AFTER_DRAIN = false;
    const float* ssq; const float* cw; const float* cb; bf16_t* gt; float* hl; float* hf;
    __device__ __forceinline__ void operator()(const f32x4 (&acc)[2][2][4][2], const Unit& u, int wr, int wc, int fr_in, int fq_in) const {
        int fr = fr_in, fq = fq_in; asm volatile("" : "+v"(fr), "+v"(fq));
        const int lane = fq * 16 + fr;
        const int s1 = (lane & 48) | ((fr + 15) & 15), s2 = (lane & 48) | ((fr + 14) & 15);
        float rs[2][4];
#pragma unroll
        for (int ai = 0; ai < 2; ++ai)
#pragma unroll
            for (int m = 0; m < 4; ++m) rs[ai][m] = 1.0f / sqrtf(ssq[u.pm * BM + ai * HALF + wr * 64 + m * 16 + fr] * (1.0f / 1024.0f) + 1e-6f);
#pragma unroll
        for (int n = 0; n < 2; ++n) {
            asm volatile("" ::: "memory");
            const int g0 = u.pn * 128 + wc * 32 + n * 16 + 4 * fq;
            const f32x4 bg = *(const f32x4*)(cb + g0), wg0 = *(const f32x4*)(cw + g0), wg1 = *(const f32x4*)(cw + 5632 + g0), wg2 = *(const f32x4*)(cw + 2 * 5632 + g0);
            const f32x4 bu = *(const f32x4*)(cb + 2816 + g0), wu0 = *(const f32x4*)(cw + 2816 + g0), wu1 = *(const f32x4*)(cw + 5632 + 2816 + g0), wu2 = *(const f32x4*)(cw + 2 * 5632 + 2816 + g0);
#pragma unroll
            for (int ai = 0; ai < 2; ++ai) {
                const int blk = u.pm * 4 + ai * 2 + wr;
                f32x4 pg1 = {0.f, 0.f, 0.f, 0.f}, pg2 = pg1, pu1 = pg1, pu2 = pg1;
#pragma unroll
                for (int m = 0; m < 4; ++m) {
                    const int r = u.pm * BM + ai * HALF + wr * 64 + m * 16 + fr;
                    const f32x4 ag = acc[ai][0][m][n] * rs[ai][m], au = acc[ai][1][m][n] * rs[ai][m];
                    if (m == 3 && fr >= 14) { float* h = hl + (size_t)(blk * 2 + (fr - 14)) * 5632 + g0; *(f32x4*)h = ag; *(f32x4*)(h + 2816) = au; }
                    if (m == 0 && fr < 2) { float* h = hf + (size_t)(blk * 2 + fr) * 5632 + g0; *(f32x4*)h = ag; *(f32x4*)(h + 2816) = au; }
                    f32x4 o;
                    { const f32x4 g1 = shfl4(ag, s1), g2 = shfl4(ag, s2);
                      const f32x4 p1g = fr >= 1 ? g1 : pg1, p2g = fr >= 2 ? g2 : pg2;
                      const f32x4 cg = bg + wg0 * p2g + wg1 * p1g + wg2 * ag;
                      o[0] = silu_f(cg[0]); o[1] = silu_f(cg[1]); o[2] = silu_f(cg[2]); o[3] = silu_f(cg[3]);
                      pg1 = g1; pg2 = g2; }
                    { const f32x4 u1 = shfl4(au, s1), u2 = shfl4(au, s2);
                      const f32x4 p1u = fr >= 1 ? u1 : pu1, p2u = fr >= 2 ? u2 : pu2;
                      const f32x4 cu = bu + wu0 * p2u + wu1 * p1u + wu2 * au;
                      o = o * cu;
                      pu1 = u1; pu2 = u2; }
                    st_bf16x4(gt + (size_t)r * 2816 + g0, o);
                }
            }
        }
    }
};

template <class Epi, class Sched, bool ALIGN_EPI = false, bool SP2 = false>
__device__ __forceinline__ void gemm_phase(PG8_LAS unsigned char* lds, const Gemm g, const Sched& S, const Epi& E) {
    int tid_ = threadIdx.x; asm volatile("" : "+v"(tid_));
    const int tid = tid_, wid = __builtin_amdgcn_readfirstlane(tid >> 6), lane = tid & 63, wr = wid >> 2, wc = wid & 3, fr = lane & 15, fq = lane >> 4;
    const int K = g.K, nt = K / BK;
    unsigned voffA[2], voffB[2];
#pragma unroll
    for (int i = 0; i < 2; ++i) { int R, C; stage_rc(tid * 16 + i * 8192, R, C); const int Rb = Epi::PERM ? ((R & ~31) + perm32(R & 31)) : R;
        voffA[i] = (unsigned)(R * K + C) * 2u; voffB[i] = (unsigned)(Rb * K + C) * 2u; }
    const size_t kstep = (size_t)(BK * 2);
    const size_t hstep = (size_t)HALF * K * 2;
    const size_t tstep = 2 * hstep;
    const unsigned ldsw = (unsigned)wid * 1024u;
    const int aoff = lds_byte(wr * 64 + fr, fq * 8), boff = lds_byte(wc * 32 + fr, fq * 8);
#define PG8_SA(b, h) (((b) * 2 + (h)) * HTB)
#define PG8_SB(b, h) ((4 + (b) * 2 + (h)) * HTB)
#define PG8_STAGE(bufoff, gbase, voff) do { _Pragma("unroll") for (int _i = 0; _i < 2; ++_i) \
        __builtin_amdgcn_global_load_lds((const unsigned*)((const char*)(gbase) + (voff)[_i]), (PG8_LAS unsigned*)(lds + (bufoff) + ldsw + _i * 8192), 16, 0, 0); } while (0)
#define PG8_LDA(dst, b, h) do { _Pragma("unroll") for (int m = 0; m < 4; ++m) _Pragma("unroll") for (int k = 0; k < 2; ++k) dst[m][k] = *(const PG8_LAS bf16x8*)(lds + PG8_SA(b, h) + aoff + m * 2048 + k * 1024); } while (0)
#define PG8_LDB(dst, b, h) do { _Pragma("unroll") for (int n = 0; n < 2; ++n) _Pragma("unroll") for (int k = 0; k < 2; ++k) dst[n][k] = *(const PG8_LAS bf16x8*)(lds + PG8_SB(b, h) + boff + n * 2048 + k * 1024); } while (0)
#define PG8_MMA(ai, bj, At, Bt) do { __builtin_amdgcn_s_setprio(1); _Pragma("unroll") for (int m = 0; m < 4; ++m) _Pragma("unroll") for (int n = 0; n < 2; ++n) _Pragma("unroll") for (int k = 0; k < 2; ++k) \
        acc[ai][bj][m][n] = __builtin_amdgcn_mfma_f32_16x16x32_bf16(Bt[n][k], At[m][k], acc[ai][bj][m][n], 0, 0, 0); __builtin_amdgcn_s_setprio(0); } while (0)
#define PG8_WAIT_V(n) asm volatile("s_waitcnt vmcnt(" #n ")" ::: "memory")
#define PG8_WAIT_L(n) asm volatile("s_waitcnt lgkmcnt(" #n ")" ::: "memory")
#define PG8_BAR __builtin_amdgcn_s_barrier()
#define PG8_SCHED __builtin_amdgcn_sched_barrier(0)
    Unit cur, nxt; int ui = 0;
    if (!S.next(0, cur)) return;
    f32x4 acc[2][2][4][2];
#pragma unroll
    for (int a = 0; a < 2; ++a)
#pragma unroll
        for (int b = 0; b < 2; ++b)
#pragma unroll
            for (int m = 0; m < 4; ++m)
#pragma unroll
                for (int n = 0; n < 2; ++n) acc[a][b][m][n] = (f32x4){0.f, 0.f, 0.f, 0.f};
    bf16x8 At[4][2], B0[2][2], B1[2][2];
    const char* cA = (const char*)g.A + (size_t)cur.pm * tstep; const char* cB = (const char*)g.Bt + (size_t)cur.pn * tstep;
    S.a_ready(cur);
    if constexpr (SP2) {
        PG8_STAGE(PG8_SB(0, 0), cB, voffB); PG8_STAGE(PG8_SB(0, 1), cB + hstep, voffB); PG8_STAGE(PG8_SA(0, 0), cA, voffA); PG8_STAGE(PG8_SA(0, 1), cA + hstep, voffA);
        if (wr == 1) PG8_BAR;
        PG8_WAIT_V(2); PG8_BAR;
        PG8_STAGE(PG8_SB(1, 0), cB + kstep, voffB); PG8_STAGE(PG8_SA(1, 0), cA + kstep, voffA); PG8_STAGE(PG8_SB(1, 1), cB + hstep + kstep, voffB);
        PG8_WAIT_V(6); PG8_BAR;
    } else {
        PG8_STAGE(PG8_SB(0, 0), cB, voffB); PG8_STAGE(PG8_SA(0, 0), cA, voffA); PG8_STAGE(PG8_SB(0, 1), cB + hstep, voffB); PG8_STAGE(PG8_SA(0, 1), cA + hstep, voffA);
        if (wr == 1) PG8_BAR;
        PG8_WAIT_V(4); PG8_BAR;
        PG8_STAGE(PG8_SB(1, 0), cB + kstep, voffB); PG8_STAGE(PG8_SA(1, 0), cA + kstep, voffA); PG8_STAGE(PG8_SB(1, 1), cB + hstep + kstep, voffB);
        PG8_WAIT_V(6); PG8_BAR;
    }
    for (;;) {
        const bool has_next = S.next(ui + 1, nxt);
        const char* nA = has_next ? (const char*)g.A + (size_t)nxt.pm * tstep : cA; const char* nB = has_next ? (const char*)g.Bt + (size_t)nxt.pn * tstep : cB;
        for (int t = 0; t < nt; t += 2) {
            const bool last = (t == nt - 2);
            const char* a1 = cA + (size_t)(t + 1) * kstep;
            const char* a2 = last ? nA : cA + (size_t)(t + 2) * kstep; const char* b2 = last ? nB : cB + (size_t)(t + 2) * kstep;
            const char* a3 = a2 + kstep; const char* b3 = b2 + kstep;
            if (last && has_next) S.a_ready(nxt);
            if constexpr (SP2) {
            PG8_LDB(B0, 0, 0); PG8_LDB(B1, 0, 1); PG8_SCHED; PG8_LDA(At, 0, 0); PG8_STAGE(PG8_SA(1, 1), a1 + hstep, voffA);
            PG8_WAIT_V(8); PG8_WAIT_L(0); PG8_BAR; PG8_MMA(0, 0, At, B0); PG8_MMA(0, 1, At, B1); PG8_BAR; PG8_SCHED;
            PG8_LDA(At, 0, 1); PG8_STAGE(PG8_SB(0, 0), b2, voffB); PG8_STAGE(PG8_SB(0, 1), b2 + hstep, voffB); PG8_STAGE(PG8_SA(0, 0), a2, voffA);
            PG8_WAIT_V(8); PG8_WAIT_L(0); PG8_BAR; PG8_MMA(1, 0, At, B0); PG8_MMA(1, 1, At, B1); PG8_BAR; PG8_SCHED;
            PG8_LDB(B0, 1, 0); PG8_LDB(B1, 1, 1); PG8_SCHED; PG8_LDA(At, 1, 0); PG8_STAGE(PG8_SA(0, 1), a2 + hstep, voffA);
            PG8_WAIT_V(8); PG8_WAIT_L(0); PG8_BAR; PG8_MMA(0, 0, At, B0); PG8_MMA(0, 1, At, B1); PG8_BAR; PG8_SCHED;
            PG8_LDA(At, 1, 1); PG8_STAGE(PG8_SB(1, 0), b3, voffB); PG8_STAGE(PG8_SB(1, 1), b3 + hstep, voffB); PG8_STAGE(PG8_SA(1, 0), a3, voffA);
            PG8_WAIT_V(8); PG8_WAIT_L(0); PG8_BAR; PG8_MMA(1, 0, At, B0); PG8_MMA(1, 1, At, B1); PG8_BAR; PG8_SCHED;
            } else {
            PG8_LDB(B0, 0, 0); PG8_SCHED; PG8_LDA(At, 0, 0); PG8_STAGE(PG8_SA(1, 1), a1 + hstep, voffA);
            PG8_WAIT_L(8); PG8_BAR; PG8_WAIT_L(0); PG8_MMA(0, 0, At, B0); PG8_BAR; PG8_SCHED;
            PG8_LDB(B1, 0, 1); PG8_STAGE(PG8_SB(0, 0), b2, voffB);
            PG8_BAR; PG8_WAIT_L(0); PG8_MMA(0, 1, At, B1); PG8_BAR;
            PG8_LDA(At, 0, 1); PG8_STAGE(PG8_SA(0, 0), a2, voffA);
            PG8_BAR; PG8_WAIT_L(0); PG8_MMA(1, 0, At, B0); PG8_BAR; PG8_SCHED;
            PG8_STAGE(PG8_SB(0, 1), b2 + hstep, voffB);
            PG8_WAIT_V(6); PG8_BAR; PG8_MMA(1, 1, At, B1); PG8_BAR;
            PG8_LDB(B0, 1, 0); PG8_SCHED; PG8_LDA(At, 1, 0); PG8_STAGE(PG8_SA(0, 1), a2 + hstep, voffA);
            PG8_WAIT_L(8); PG8_BAR; PG8_WAIT_L(0); PG8_MMA(0, 0, At, B0); PG8_BAR; PG8_SCHED;
            PG8_LDB(B1, 1, 1); PG8_STAGE(PG8_SB(1, 0), b3, voffB);
            PG8_BAR; PG8_WAIT_L(0); PG8_MMA(0, 1, At, B1); PG8_BAR;
            PG8_LDA(At, 1, 1); PG8_STAGE(PG8_SA(1, 0), a3, voffA);
            PG8_BAR; PG8_WAIT_L(0); PG8_MMA(1, 0, At, B0); PG8_BAR; PG8_SCHED;
            PG8_STAGE(PG8_SB(1, 1), b3 + hstep, voffB);
            PG8_WAIT_V(6); PG8_BAR; PG8_MMA(1, 1, At, B1); PG8_BAR;
            }
        }
        if constexpr (ALIGN_EPI) { if (wr == 0) PG8_BAR; }
        if constexpr (!Epi::AFTER_DRAIN) { E(acc, cur, wr, wc, fr, fq); S.done(cur); }
        if (!has_next) break;
#pragma unroll
        for (int a = 0; a < 2; ++a)
#pragma unroll
            for (int b = 0; b < 2; ++b)
#pragma unroll
                for (int m = 0; m < 4; ++m)
#pragma unroll
                    for (int n = 0; n < 2; ++n) acc[a][b][m][n] = (f32x4){0.f, 0.f, 0.f, 0.f};
        cur = nxt; cA = nA; cB = nB; ++ui;
        if constexpr (ALIGN_EPI) { if (wr == 1) PG8_BAR; }
    }
    PG8_WAIT_V(0);
    if constexpr (!ALIGN_EPI) { if (wr == 0) PG8_BAR; }
    PG8_BAR;
    if constexpr (Epi::AFTER_DRAIN) { E.fused(acc, cur, wr, wc, fr, fq, lds, wid, lane); S.done(cur); }
#undef PG8_SA
#undef PG8_SB
#undef PG8_STAGE
#undef PG8_LDA
#undef PG8_LDB
#undef PG8_MMA
#undef PG8_WAIT_V
#undef PG8_WAIT_L
#undef PG8_BAR
#undef PG8_SCHED
}
}
#define GAS __attribute__((address_space(1)))
#define LAS __attribute__((address_space(3)))
typedef unsigned short bf16;
typedef unsigned v4u __attribute__((ext_vector_type(4)));
typedef float f32x4 __attribute__((ext_vector_type(4)));
typedef short bf16x8 __attribute__((ext_vector_type(8)));
typedef GAS unsigned gu32;
typedef GAS unsigned long long gu64;
#define RLX_AGENT __ATOMIC_RELAXED, __HIP_MEMORY_SCOPE_AGENT
#define LDS_WAIT() asm volatile("s_waitcnt lgkmcnt(0)" ::: "memory")
#define VM_WAIT() asm volatile("s_waitcnt vmcnt(0)" ::: "memory")
__device__ __forceinline__ unsigned long long rt() { return __builtin_amdgcn_s_memrealtime(); }
__device__ __forceinline__ unsigned f2bf(float f) { unsigned u = __builtin_bit_cast(unsigned, f); return (u + 0x7fffu + ((u >> 16) & 1u)) >> 16; }
__device__ __forceinline__ unsigned pk2(float lo, float hi) { return f2bf(lo) | (f2bf(hi) << 16); }

#define XB_TMO      128
#define XB_XCNT(j)  (256  + 64 * (j))
#define XB_XSUB(j)  (1280 + 64 * (j))
#define XB_XGEN(j)  (2304 + 64 * (j))
#define XB_TOP      3328
#define XB_TOPGEN   3392
#define XCD_BAR_WORDS 3456
#define XB_SPIN_CAP (1u << 18)

__device__ __forceinline__ unsigned xb_ld(unsigned* p)              { return __hip_atomic_load(p, __ATOMIC_RELAXED, __HIP_MEMORY_SCOPE_AGENT); }
__device__ __forceinline__ unsigned xb_add(unsigned* p, unsigned v) { return __hip_atomic_fetch_add(p, v, __ATOMIC_RELAXED, __HIP_MEMORY_SCOPE_AGENT); }
__device__ __forceinline__ unsigned xb_xcc_id() { return (unsigned)__builtin_amdgcn_s_getreg((3 << 11) | 20) & 0xFu; }
#define XB_SPIN(cond, bar) do { unsigned _sp = 0; while (cond) { __builtin_amdgcn_s_sleep(1); \
    if ((++_sp & 255u) == 0u) { if (xb_ld(&(bar)[XB_TMO])) break; if (_sp > XB_SPIN_CAP) { atomicAdd(&(bar)[XB_TMO], 1u); break; } } } } while (0)

struct XcdBarrier {
    unsigned* bar; unsigned x;
    volatile LAS unsigned* st;
};

__device__ __forceinline__ XcdBarrier xcd_barrier_post(unsigned* bar, volatile LAS unsigned* st) {
    XcdBarrier b; b.bar = bar; b.x = xb_xcc_id(); b.st = st;
    if (threadIdx.x == 0) (void)xb_add(&bar[XB_XCNT(b.x)], 1u);
    return b;
}
__device__ __forceinline__ void xcd_barrier_complete(unsigned* bar, unsigned x, unsigned& nloc, unsigned& nx) {
    const unsigned G = gridDim.x * gridDim.y * gridDim.z;
    unsigned sum, cnt, mine, sp = 0u;
    for (;;) {
        sum = 0u; cnt = 0u; mine = 0u;
#pragma unroll
        for (unsigned j = 0; j < 16; ++j) { const unsigned c = xb_ld(&bar[XB_XCNT(j)]); sum += c; cnt += (c > 0u) ? 1u : 0u; mine = (j == x) ? c : mine; }
        if (sum == G) break;
        __builtin_amdgcn_s_sleep(1);
        if ((++sp & 255u) == 0u) { if (xb_ld(&bar[XB_TMO])) break; if (sp > XB_SPIN_CAP) { atomicAdd(&bar[XB_TMO], 1u); break; } }
    }
    nloc = mine > 0u ? mine : 1u; nx = cnt > 0u ? cnt : 1u;
}

__device__ __forceinline__ void xcd_barrier(const XcdBarrier& b) {
    asm volatile("s_waitcnt vmcnt(0)" ::: "memory");
    __syncthreads();
    if (threadIdx.x == 0) {
        unsigned* bar = b.bar;
        __builtin_amdgcn_s_waitcnt(0);
        unsigned nloc = b.st[0], nx = b.st[1];
        if (nloc == 0u) { xcd_barrier_complete(bar, b.x, nloc, nx); b.st[0] = nloc; b.st[1] = nx; }
        const unsigned old = xb_add(&bar[XB_XSUB(b.x)], 1u);
        const unsigned gen = old / nloc;
        if (old + 1u == (gen + 1u) * nloc) {
            __builtin_amdgcn_fence(__ATOMIC_RELEASE, "agent");
            asm volatile("s_waitcnt vmcnt(0)" ::: "memory");
            const unsigned og = xb_add(&bar[XB_TOP], 1u);
            const unsigned tg = og / nx;
            if (og + 1u == (tg + 1u) * nx) xb_add(&bar[XB_TOPGEN], 1u);
            else XB_SPIN(xb_ld(&bar[XB_TOPGEN]) == tg, bar);
            __builtin_amdgcn_fence(__ATOMIC_ACQUIRE, "agent");
            xb_add(&bar[XB_XGEN(b.x)], 1u);
            asm volatile("s_waitcnt vmcnt(0)" ::: "memory");
        } else {
            XB_SPIN(xb_ld(&bar[XB_XGEN(b.x)]) == gen, bar);
            __builtin_amdgcn_fence(__ATOMIC_ACQUIRE, "agent");
            asm volatile("s_waitcnt vmcnt(0)" ::: "memory");
        }
    }
    __syncthreads();
}

constexpr int NWAVES = 8, NTHR = 512;
constexpr int NB = 4, SEQ = 4096, M = NB * SEQ, DM = 1024;
constexpr int IN_W = 2516, NIN = 2560;
constexpr int DFF = 2816, DFF2 = 5632;
constexpr int NUNIT_GLA = NB * 4 * 64;

constexpr size_t MiB = 1u << 20;
constexpr size_t WS_CTL = 0, CTL_ZERO_BYTES = 1 * MiB;
constexpr size_t WS_ROPE = 1 * MiB;
constexpr size_t WS_SSQ = 2 * MiB;
constexpr size_t WS_WIN = 4 * MiB, WS_WO = 9 * MiB, WS_WUP0 = 11 * MiB, WS_WUP1 = 22 * MiB, WS_WDN0 = 33 * MiB, WS_WDN1 = 39 * MiB, WS_WUV = 45 * MiB, WS_WOUT = 49 * MiB;
constexpr size_t WS_XB = 51 * MiB;
constexpr size_t WS_R = 83 * MiB;
constexpr size_t R_GQ = WS_R, R_GK = R_GQ + 8 * MiB, R_GV = R_GK + 8 * MiB, R_GR = R_GV + 16 * MiB, R_BQ = R_GR + 16 * MiB, R_IQ = R_BQ + 16 * MiB, R_BK = R_IQ + 16 * MiB,
                 R_BV = R_BK + 2 * MiB, R_IK = R_BV + 2 * MiB, R_ALR = R_IK + 4 * MiB, R_IW = R_ALR + 1 * MiB, R_DS = R_IW + 1 * MiB, R_DEC = R_DS + 32 * MiB, R_IDX = R_DEC + 1 * MiB,
                 R_AO = R_IDX + 8 * MiB, R_END0 = R_AO + 32 * MiB;
constexpr size_t R_GT = WS_R, R_HL = R_GT + 88 * MiB, R_HF = R_HL + 11 * MiB, R_END1 = R_HF + 11 * MiB;
constexpr size_t R_Z = WS_R, R_SG = R_Z + 64 * MiB, R_END2 = R_SG + 32 * MiB;
constexpr size_t WS_END = 256 * MiB;
static_assert(R_END0 <= WS_END && R_END1 <= WS_END && R_END2 <= WS_END, "d_ws map");
constexpr int CW_BAR = 4096;

constexpr int RING_BYTES = 131072, LDS_BYTES = 147456, LDSCTL_OFF = LDS_BYTES - 512, MISC_OFF = LDSCTL_OFF;

typedef unsigned short bf16;
__device__ __forceinline__ float bf2f(unsigned short h) { return __builtin_bit_cast(float, (unsigned)h << 16); }
__device__ __forceinline__ float wave_sum(float v) {
#pragma unroll
    for (int o = 1; o < 64; o <<= 1) v += __shfl_xor(v, o);
    return v;
}
__device__ __forceinline__ float wave_max(float v) {
#pragma unroll
    for (int o = 1; o < 64; o <<= 1) v = fmaxf(v, __shfl_xor(v, o));
    return v;
}

struct Args { const float* in[20]; float* out; unsigned char* ws; int ph_lo, ph_hi; };

__device__ __forceinline__ int ropeperm(int p) { return p < 16 ? ((p >> 1) + 8 * (p & 1)) : p; }
__device__ __forceinline__ int win_src(int n) {
    if (n < 1536) return n;
    if (n < 2048) { const int c = n - 1536; return 1552 + (c & ~63) + ropeperm(c & 63); }
    if (n < 2304) { const int c = n - 2048; return 2192 + (c & ~63) + ropeperm(c & 63); }
    const int c = n - 2304;
    if (c < 64) return 2064 + ropeperm(c);
    if (c < 128) return 2128 + (c - 64);
    if (c < 192) return 2448 + ropeperm(c - 128);
    if (c < 208) return 1536 + (c - 192);
    if (c < 212) return 2512 + (c - 208);
    return -1;
}
__device__ __forceinline__ int up_src(int r) { const int pn = r >> 8, w = r & 255; return (w >> 7) * DFF + pn * 128 + (w & 127); }

__device__ __forceinline__ int ropeinv(int d) { return d < 16 ? (d < 8 ? 2 * d : 2 * (d - 8) + 1) : d; }
__device__ __forceinline__ int win_dst(int s) {
    if (s < 1536) return s;
    if (s < 1552) return 2304 + 192 + (s - 1536);
    if (s < 2064) { const int c = s - 1552; return 1536 + (c & ~63) + ropeinv(c & 63); }
    if (s < 2128) return 2304 + ropeinv(s - 2064);
    if (s < 2192) return 2304 + 64 + (s - 2128);
    if (s < 2448) { const int c = s - 2192; return 2048 + (c & ~63) + ropeinv(c & 63); }
    if (s < 2512) return 2304 + 128 + ropeinv(s - 2448);
    return 2304 + 208 + (s - 2512);
}
__device__ __forceinline__ int up_dst(int s) { const int bj = s >= DFF ? 1 : 0, rem = s - bj * DFF; return (rem >> 7) * 256 + bj * 128 + (rem & 127); }

typedef short v4i16p_t __attribute__((ext_vector_type(4)));
template <int MAP  >
__device__ __forceinline__ void transpose_item(const float* W, int K, int Nsrc, const float* g, bf16* WT, unsigned char* scr, int item, int lane) {
    const int nsb = (Nsrc + 63) >> 6, kb = item / nsb, sb = item % nsb, k0 = 64 * kb, s0 = 64 * sb;
    const int lr = lane >> 4, s4 = 4 * (lane & 15);
    const bool inb = s0 + s4 < Nsrc;
#pragma unroll 4
    for (int i = 0; i < 16; ++i) { const int kk = 4 * i + lr;
        f32x4 v = {0.f, 0.f, 0.f, 0.f};
        if (inb) { v = *(const f32x4*)(W + (size_t)(k0 + kk) * Nsrc + s0 + s4); if (g) v = v * g[k0 + kk]; }
        *(unsigned long long*)(scr + kk * 144 + s4 * 2) = (unsigned long long)pk2(v[0], v[1]) | ((unsigned long long)pk2(v[2], v[3]) << 32); }
    LDS_WAIT(); asm volatile("" ::: "memory");
    const int grp = lane >> 4, li = lane & 15;
#pragma unroll
    for (int j = 0; j < 8; ++j) { const int c = j, sblk = grp;
        const unsigned char* b = scr + (8 * c + (li >> 2)) * 144 + (16 * sblk + 4 * (li & 3)) * 2;
        const v4i16p_t a0 = __builtin_amdgcn_ds_read_tr16_b64_v4i16((LAS v4i16p_t*)(LAS unsigned char*)b), a1 = __builtin_amdgcn_ds_read_tr16_b64_v4i16((LAS v4i16p_t*)(LAS unsigned char*)(b + 4 * 144));
        const int s = s0 + 16 * sblk + li;
        if (s < Nsrc) { const int dst = MAP == 0 ? s : (MAP == 1 ? win_dst(s) : up_dst(s));
            v4u o; o.x = (unsigned)(unsigned short)a0[0] | ((unsigned)(unsigned short)a0[1] << 16); o.y = (unsigned)(unsigned short)a0[2] | ((unsigned)(unsigned short)a0[3] << 16);
            o.z = (unsigned)(unsigned short)a1[0] | ((unsigned)(unsigned short)a1[1] << 16); o.w = (unsigned)(unsigned short)a1[2] | ((unsigned)(unsigned short)a1[3] << 16);
            *(v4u*)(WT + (size_t)dst * K + k0 + 8 * c) = o; } }
    LDS_WAIT(); asm volatile("" ::: "memory");
}

__device__ __forceinline__ void sincos_d(double a, float& c, float& s) {
    const double k = __builtin_rint(a * 0.15915494309189535);
    double r = a - k * 6.283185307179586; r -= k * 2.4492935982947064e-16;
    const double r2 = r * r;
    double sp = -1.0 / 51090942171709440000.0, cp = 1.0 / 1124000727777607680000.0;
    sp = sp * r2 + 1.0 / 121645100408832000.0;  cp = cp * r2 - 1.0 / 2432902008176640000.0;
    sp = sp * r2 - 1.0 / 355687428096000.0;     cp = cp * r2 + 1.0 / 6402373705728000.0;
    sp = sp * r2 + 1.0 / 1307674368000.0;       cp = cp * r2 - 1.0 / 20922789888000.0;
    sp = sp * r2 - 1.0 / 6227020800.0;          cp = cp * r2 + 1.0 / 87178291200.0;
    sp = sp * r2 + 1.0 / 39916800.0;            cp = cp * r2 - 1.0 / 479001600.0;
    sp = sp * r2 - 1.0 / 362880.0;              cp = cp * r2 + 1.0 / 3628800.0;
    sp = sp * r2 + 1.0 / 5040.0;                cp = cp * r2 - 1.0 / 40320.0;
    sp = sp * r2 - 1.0 / 120.0;                 cp = cp * r2 + 1.0 / 720.0;
    sp = sp * r2 + 1.0 / 6.0;                   cp = cp * r2 - 1.0 / 24.0;
    cp = cp * r2 + 0.5;
    s = (float)(r - r * r2 * sp); c = (float)(1.0 - r2 * cp);
}

__device__ __forceinline__ void p0_prologue(const Args& a, unsigned char* lds, int vcu, int G, int tid) {
    unsigned char* ws = a.ws;
    const int lane = tid & 63, wave = tid >> 6;
    unsigned char* scr = lds + wave * 9216;
    const int gw = vcu * NWAVES + wave, NGW = G * NWAVES;
    constexpr int I_WIN = 16 * ((IN_W + 63) / 64), I_WO = 16 * 16, I_WUP = 16 * (DFF2 / 64), I_WDN = (DFF / 64) * 16, I_WUV = 16 * 32, I_WOUT = 16 * 16;
    constexpr int NITEMS = I_WIN + I_WO + 2 * I_WUP + 2 * I_WDN + I_WUV + I_WOUT;
    for (int it = gw; it < NITEMS; it += NGW) {
        int r = it;
        if (r < I_WIN) { transpose_item<1>(a.in[2], 1024, IN_W, a.in[1], (bf16*)(ws + WS_WIN), scr, r, lane); continue; } r -= I_WIN;
        if (r < I_WO) { transpose_item<0>(a.in[6], 1024, 1024, nullptr, (bf16*)(ws + WS_WO), scr, r, lane); continue; } r -= I_WO;
        if (r < I_WUP) { transpose_item<2>(a.in[15], 1024, DFF2, a.in[14], (bf16*)(ws + WS_WUP0), scr, r, lane); continue; } r -= I_WUP;
        if (r < I_WUP) { transpose_item<2>(a.in[15] + (size_t)1024 * DFF2, 1024, DFF2, a.in[14] + 1024, (bf16*)(ws + WS_WUP1), scr, r, lane); continue; } r -= I_WUP;
        if (r < I_WDN) { transpose_item<0>(a.in[18], DFF, 1024, nullptr, (bf16*)(ws + WS_WDN0), scr, r, lane); continue; } r -= I_WDN;
        if (r < I_WDN) { transpose_item<0>(a.in[18] + (size_t)DFF * 1024, DFF, 1024, nullptr, (bf16*)(ws + WS_WDN1), scr, r, lane); continue; } r -= I_WDN;
        if (r < I_WUV) { transpose_item<0>(a.in[8], 1024, 2048, a.in[7], (bf16*)(ws + WS_WUV), scr, r, lane); continue; } r -= I_WUV;
        transpose_item<0>(a.in[13], 1024, 1024, nullptr, (bf16*)(ws + WS_WOUT), scr, r, lane);
    }
    { const int gt0 = vcu * NTHR + tid; v4u* zp = (v4u*)((bf16*)(ws + WS_WIN) + (size_t)(2304 + 212) * 1024);
      for (int i = gt0; i < 44 * 1024 / 8; i += G * NTHR) zp[i] = (v4u){0u, 0u, 0u, 0u}; }
    float* ssq = (float*)(ws + WS_SSQ);
    bf16* xb = (bf16*)(ws + WS_XB);
    for (int m = gw; m < M; m += NGW) {
        const f32x4* xr = (const f32x4*)(a.in[0] + (size_t)m * DM) + lane;
        unsigned long long* o8 = (unsigned long long*)(xb + (size_t)m * DM) + lane;
        float s = 0.f;
#pragma unroll
        for (int j = 0; j < 4; ++j) { const f32x4 v = xr[64 * j]; s += (v.x * v.x + v.y * v.y) + (v.z * v.z + v.w * v.w);
            o8[64 * j] = (unsigned long long)pk2(v.x, v.y) | ((unsigned long long)pk2(v.z, v.w) << 32); }
        s = wave_sum(s);
        if (lane == 0) ssq[m] = s;
    }
    const int gt = vcu * NTHR + tid, NGT = G * NTHR;
    for (int i = gt; i < 6 * M; i += NGT) ssq[M + i] = 0.f;
    float* rope = (float*)(ws + WS_ROPE);
    for (int i = gt; i < SEQ * 8; i += NGT) {
        const int t = i >> 3, j = i & 7;
        const double inv = j == 0 ? 1.0 : j == 1 ? 0.19392274474868576 : j == 2 ? 0.03760603093086393 : j == 3 ? 0.007292664737217109 : j == 4 ? 0.001414213562373095
                         : j == 5 ? 0.0002742481756762073 : j == 6 ? 5.318295896944988e-05 : 1.031338537721246e-05;
        float c, s; sincos_d((double)t * inv, c, s);
        rope[2 * i] = c; rope[2 * i + 1] = s;
    }
}

__device__ __forceinline__ float logsigmoid_f(float z) { return fminf(z, 0.f) - log1pf(__expf(-fabsf(z))); }
typedef short v4i16_t __attribute__((ext_vector_type(4)));
__device__ __forceinline__ v4i16_t tr16(const unsigned char* p) { return __builtin_amdgcn_ds_read_tr16_b64_v4i16((LAS v4i16_t*)(LAS unsigned char*)p); }
__device__ __forceinline__ bf16x8 frag_tr(const unsigned char* X, int RS, int rowA, int rowB, int col0, int fr, int fq) {
    const unsigned char* b = X + (4 * fq + (fr >> 2)) * RS + (col0 + 4 * (fr & 3)) * 2;
    const v4i16_t a0 = tr16(b + rowA * RS), a1 = tr16(b + rowB * RS);
    return (bf16x8){a0[0], a0[1], a0[2], a0[3], a1[0], a1[1], a1[2], a1[3]};
}
__device__ __forceinline__ bf16x8 frag_row_perm(const unsigned char* X, int RS, int row0, int colA, int colB, int fr, int fq) {
    const unsigned char* b = X + (row0 + fr) * RS + 8 * fq;
    const v4i16_t a0 = *(const v4i16_t*)(b + colA * 2), a1 = *(const v4i16_t*)(b + colB * 2);
    return (bf16x8){a0[0], a0[1], a0[2], a0[3], a1[0], a1[1], a1[2], a1[3]};
}
__device__ __forceinline__ bf16x8 frag_row(const unsigned char* X, int RS, int row0, int col0, int fr, int fq) { return *(const bf16x8*)(X + (row0 + fr) * RS + (col0 + 8 * fq) * 2); }

__device__ __forceinline__ void gla_cumdecay(float* bl, float* gt, const float* alr, const float* wa2, const float* ba, int row0, int h, int tid) {
    { const int c = tid >> 3, d0 = (tid & 7) * 8;
      float z[8];
#pragma unroll
      for (int j = 0; j < 8; ++j) z[j] = ba[h * 64 + d0 + j];
      const float* ar = alr + (size_t)(row0 + c) * 16;
#pragma unroll
      for (int r = 0; r < 16; ++r) { const float x = ar[r];
#pragma unroll
          for (int j = 0; j < 8; ++j) z[j] += x * wa2[r * 256 + h * 64 + d0 + j]; }
#pragma unroll
      for (int j = 0; j < 8; ++j) bl[c * 64 + d0 + j] = logsigmoid_f(z[j]) * (1.0f / 16.0f); }
    __syncthreads();
    const int d = tid & 63, g = tid >> 6;
    float v[8]; float s = 0.f;
#pragma unroll
    for (int j = 0; j < 8; ++j) { s += bl[(8 * g + j) * 64 + d]; v[j] = s; }
    gt[g * 64 + d] = s;
    __syncthreads();
    float off = 0.f;
#pragma unroll
    for (int g2 = 0; g2 < 7; ++g2) off += (g2 < g) ? gt[g2 * 64 + d] : 0.f;
#pragma unroll
    for (int j = 0; j < 8; ++j) bl[(8 * g + j) * 64 + d] = v[j] + off;
    __syncthreads();
}

constexpr int GL_BL = 0, GL_GT = 16384, GL_QD = 18432, GL_KD = 27648, GL_QB = 36864, GL_VV = 46080, GL_SS = 64512, GL_PART = 82944;
constexpr int GL_RS64 = 144, GL_RS128 = 288, GL_RSKL = 160;

__device__ __forceinline__ void gla_phase_a(const Args& a, unsigned char* lds, int vcu, int G, int tid) {
    unsigned char* ws = a.ws;
    float* bl = (float*)(lds + GL_BL); float* gt = (float*)(lds + GL_GT);
    unsigned char* kl = lds + GL_QD; unsigned char* vv = lds + GL_VV;
    const bf16* gk = (const bf16*)(ws + R_GK); const bf16* gv = (const bf16*)(ws + R_GV);
    const float* alr = (const float*)(ws + R_ALR);
    float* ds = (float*)(ws + R_DS); float* dec = (float*)(ws + R_DEC);
    const int lane = tid & 63, wave = tid >> 6, fr = lane & 15, fq = lane >> 4;
    for (int unit = vcu; unit < NUNIT_GLA; unit += G) {
        const int bb = unit >> 8, h = (unit >> 6) & 3, n = unit & 63, row0 = bb * SEQ + n * 64;
        gla_cumdecay(bl, gt, alr, a.in[3], a.in[4], row0, h, tid);
        { const int c = tid >> 3, sub = tid & 7, d0 = sub * 8, e0 = sub * 16;
          const v4u kw = *(const v4u*)(gk + (size_t)(row0 + c) * 256 + h * 64 + d0);
          float kf[8] = {__builtin_bit_cast(float, kw.x << 16), __builtin_bit_cast(float, kw.x & 0xffff0000u), __builtin_bit_cast(float, kw.y << 16), __builtin_bit_cast(float, kw.y & 0xffff0000u),
                         __builtin_bit_cast(float, kw.z << 16), __builtin_bit_cast(float, kw.z & 0xffff0000u), __builtin_bit_cast(float, kw.w << 16), __builtin_bit_cast(float, kw.w & 0xffff0000u)};
#pragma unroll
          for (int j = 0; j < 8; ++j) kf[j] *= __expf(bl[63 * 64 + d0 + j] - bl[c * 64 + d0 + j]);
          *(v4u*)(kl + c * GL_RSKL + d0 * 2) = (v4u){pk2(kf[0], kf[1]), pk2(kf[2], kf[3]), pk2(kf[4], kf[5]), pk2(kf[6], kf[7])};
          const v4u* vs = (const v4u*)(gv + (size_t)(row0 + c) * 512 + h * 128 + e0);
          *(v4u*)(vv + c * GL_RS128 + e0 * 2) = vs[0]; *(v4u*)(vv + c * GL_RS128 + e0 * 2 + 16) = vs[1]; }
        if (tid < 64) dec[unit * 64 + tid] = __expf(bl[63 * 64 + tid]);
        __syncthreads();
        { const bf16x8 va0 = frag_tr(vv, GL_RS128, 0, 16, wave * 16, fr, fq), va1 = frag_tr(vv, GL_RS128, 32, 48, wave * 16, fr, fq);
#pragma unroll
          for (int dtile = 0; dtile < 4; ++dtile) {
              const bf16x8 kb0 = frag_tr(kl, GL_RSKL, 0, 16, dtile * 16, fr, fq), kb1 = frag_tr(kl, GL_RSKL, 32, 48, dtile * 16, fr, fq);
              f32x4 acc = {0.f, 0.f, 0.f, 0.f};
              acc = __builtin_amdgcn_mfma_f32_16x16x32_bf16(va0, kb0, acc, 0, 0, 0);
              acc = __builtin_amdgcn_mfma_f32_16x16x32_bf16(va1, kb1, acc, 0, 0, 0);
              *(f32x4*)(ds + (size_t)unit * 8192 + (dtile * 16 + fr) * 128 + wave * 16 + 4 * fq) = acc;
          } }
        __syncthreads();
    }
}

__device__ __forceinline__ void gla_scan(const Args& a, int vcu, int G, int tid) {
    float* ds = (float*)(a.ws + R_DS); const float* dec = (const float*)(a.ws + R_DEC);
    for (int e = vcu * NTHR + tid; e < 16 * 8192; e += G * NTHR) {
        const int bh = e >> 13, de = e & 8191, d = de >> 7;
        float S = 0.f;
#pragma unroll 8
        for (int n = 0; n < 64; ++n) { const int unit = bh * 64 + n; float* p = ds + (size_t)unit * 8192 + de;
            const float t = *p; const float dc = dec[unit * 64 + d]; *p = S; S = dc * S + t; }
    }
}

__device__ __forceinline__ void gla_phase_b(const Args& a, unsigned char* lds, int vcu, int G, int tid) {
    unsigned char* ws = a.ws;
    float* bl = (float*)(lds + GL_BL); float* gt = (float*)(lds + GL_GT); float* part = (float*)(lds + GL_PART);
    unsigned char* qd = lds + GL_QD; unsigned char* kd = lds + GL_KD; unsigned char* qb = lds + GL_QB; unsigned char* vv = lds + GL_VV; unsigned char* ss = lds + GL_SS;
    const bf16* gq = (const bf16*)(ws + R_GQ); const bf16* gk = (const bf16*)(ws + R_GK); const bf16* gv = (const bf16*)(ws + R_GV); const bf16* gr = (const bf16*)(ws + R_GR);
    const float* alr = (const float*)(ws + R_ALR); const float* sp = (const float*)(ws + R_DS);
    bf16* ao = (bf16*)(ws + R_AO); const float* hg = a.in[5];
    const int lane = tid & 63, wave = tid >> 6, fr = lane & 15, fq = lane >> 4;
    const int Ti = wave & 3, eh = wave >> 2;
    for (int unit = vcu; unit < NUNIT_GLA; unit += G) {
        const int bb = unit >> 8, h = (unit >> 6) & 3, n = unit & 63, row0 = bb * SEQ + n * 64;
        gla_cumdecay(bl, gt, alr, a.in[3], a.in[4], row0, h, tid);
        { const int c = tid >> 3, sub = tid & 7, d0 = sub * 8, e0 = sub * 16;
          const v4u qw = *(const v4u*)(gq + (size_t)(row0 + c) * 256 + h * 64 + d0), kw = *(const v4u*)(gk + (size_t)(row0 + c) * 256 + h * 64 + d0);
          const unsigned qa[4] = {qw.x, qw.y, qw.z, qw.w}, ka[4] = {kw.x, kw.y, kw.z, kw.w};
          unsigned oqd[4], okd[4], oqb[4];
#pragma unroll
          for (int j = 0; j < 4; ++j) {
              const int d = d0 + 2 * j;
              const float b0 = bl[c * 64 + d], b1 = bl[c * 64 + d + 1], m0 = bl[32 * 64 + d], m1 = bl[32 * 64 + d + 1];
              const float q0 = __builtin_bit_cast(float, qa[j] << 16), q1 = __builtin_bit_cast(float, qa[j] & 0xffff0000u), k0 = __builtin_bit_cast(float, ka[j] << 16), k1 = __builtin_bit_cast(float, ka[j] & 0xffff0000u);
              oqd[j] = pk2(q0 * __expf(b0 - m0), q1 * __expf(b1 - m1)); okd[j] = pk2(k0 * __expf(m0 - b0), k1 * __expf(m1 - b1)); oqb[j] = pk2(q0 * __expf(b0), q1 * __expf(b1)); }
          *(v4u*)(qd + c * GL_RS64 + d0 * 2) = (v4u){oqd[0], oqd[1], oqd[2], oqd[3]};
          *(v4u*)(kd + c * GL_RS64 + d0 * 2) = (v4u){okd[0], okd[1], okd[2], okd[3]};
          *(v4u*)(qb + c * GL_RS64 + d0 * 2) = (v4u){oqb[0], oqb[1], oqb[2], oqb[3]};
          const v4u* vs = (const v4u*)(gv + (size_t)(row0 + c) * 512 + h * 128 + e0);
          *(v4u*)(vv + c * GL_RS128 + e0 * 2) = vs[0]; *(v4u*)(vv + c * GL_RS128 + e0 * 2 + 16) = vs[1];
          const f32x4* sr = (const f32x4*)(sp + (size_t)unit * 8192 + c * 128 + e0);
          const f32x4 s0 = sr[0], s1 = sr[1], s2 = sr[2], s3 = sr[3];
          *(v4u*)(ss + c * GL_RS128 + e0 * 2) = (v4u){pk2(s0[0], s0[1]), pk2(s0[2], s0[3]), pk2(s1[0], s1[1]), pk2(s1[2], s1[3])};
          *(v4u*)(ss + c * GL_RS128 + e0 * 2 + 16) = (v4u){pk2(s2[0], s2[1]), pk2(s2[2], s2[3]), pk2(s3[0], s3[1]), pk2(s3[2], s3[3])}; }
        __syncthreads();
        const bf16x8 qf0 = frag_row(qd, GL_RS64, Ti * 16, 0, fr, fq), qf1 = frag_row(qd, GL_RS64, Ti * 16, 32, fr, fq);
        f32x4 at[4];
#pragma unroll
        for (int Tj = 0; Tj < 4; ++Tj) {
            at[Tj] = (f32x4){0.f, 0.f, 0.f, 0.f};
            if (Tj <= Ti) {
                const bf16x8 kf0 = frag_row(kd, GL_RS64, Tj * 16, 0, fr, fq), kf1 = frag_row(kd, GL_RS64, Tj * 16, 32, fr, fq);
                at[Tj] = __builtin_amdgcn_mfma_f32_16x16x32_bf16(kf0, qf0, at[Tj], 0, 0, 0);
                at[Tj] = __builtin_amdgcn_mfma_f32_16x16x32_bf16(kf1, qf1, at[Tj], 0, 0, 0);
#pragma unroll
                for (int r = 0; r < 4; ++r) if (Tj * 16 + 4 * fq + r > Ti * 16 + fr) at[Tj][r] = 0.f;
            }
        }
        bf16x8 pf[2];
#pragma unroll
        for (int kk = 0; kk < 2; ++kk) { v4u w_;
            w_.x = pg8::cvt_pk_bf16(at[2 * kk][0], at[2 * kk][1]); w_.y = pg8::cvt_pk_bf16(at[2 * kk][2], at[2 * kk][3]);
            w_.z = pg8::cvt_pk_bf16(at[2 * kk + 1][0], at[2 * kk + 1][1]); w_.w = pg8::cvt_pk_bf16(at[2 * kk + 1][2], at[2 * kk + 1][3]);
            pf[kk] = __builtin_bit_cast(bf16x8, w_); }
        const bf16x8 qbf0 = frag_row_perm(qb, GL_RS64, Ti * 16, 0, 16, fr, fq), qbf1 = frag_row_perm(qb, GL_RS64, Ti * 16, 32, 48, fr, fq);
        f32x4 o[4]; float ssq = 0.f;
#pragma unroll
        for (int et = 0; et < 4; ++et) {
            const int ecol = eh * 64 + et * 16;
            f32x4 acc = {0.f, 0.f, 0.f, 0.f};
            acc = __builtin_amdgcn_mfma_f32_16x16x32_bf16(frag_tr(vv, GL_RS128, 0, 16, ecol, fr, fq), pf[0], acc, 0, 0, 0);
            if (Ti >= 2) acc = __builtin_amdgcn_mfma_f32_16x16x32_bf16(frag_tr(vv, GL_RS128, 32, 48, ecol, fr, fq), pf[1], acc, 0, 0, 0);
            acc = __builtin_amdgcn_mfma_f32_16x16x32_bf16(frag_tr(ss, GL_RS128, 0, 16, ecol, fr, fq), qbf0, acc, 0, 0, 0);
            acc = __builtin_amdgcn_mfma_f32_16x16x32_bf16(frag_tr(ss, GL_RS128, 32, 48, ecol, fr, fq), qbf1, acc, 0, 0, 0);
            o[et] = acc;
            ssq += (acc[0] * acc[0] + acc[1] * acc[1]) + (acc[2] * acc[2] + acc[3] * acc[3]);
        }
        ssq += __shfl_xor(ssq, 16); ssq += __shfl_xor(ssq, 32);
        if (fq == 0) part[wave * 16 + fr] = ssq;
        __syncthreads();
        { const float tot = part[wave * 16 + fr] + part[(wave ^ 4) * 16 + fr];
          const float rs = 1.0f / sqrtf(tot * (1.0f / 128.0f) + 1e-6f);
          const size_t row = (size_t)(row0 + Ti * 16 + fr);
#pragma unroll
          for (int et = 0; et < 4; ++et) {
              const int e = eh * 64 + et * 16 + 4 * fq;
              const unsigned long long gw2 = *(const unsigned long long*)(gr + row * 512 + h * 128 + e);
              const f32x4 hv = *(const f32x4*)(hg + e);
              f32x4 y;
              y[0] = o[et][0] * rs * hv[0] * pg8::silu_f(__builtin_bit_cast(float, (unsigned)(gw2 << 16)));
              y[1] = o[et][1] * rs * hv[1] * pg8::silu_f(__builtin_bit_cast(float, (unsigned)gw2 & 0xffff0000u));
              y[2] = o[et][2] * rs * hv[2] * pg8::silu_f(__builtin_bit_cast(float, (unsigned)(gw2 >> 32) << 16));
              y[3] = o[et][3] * rs * hv[3] * pg8::silu_f(__builtin_bit_cast(float, (unsigned)(gw2 >> 32) & 0xffff0000u));
              pg8::st_bf16x4(ao + row * 1024 + h * 128 + e, y);
          } }
        __syncthreads();
    }
}

__device__ __forceinline__ unsigned f2key(float f) { const unsigned u = __builtin_bit_cast(unsigned, f); return (u & 0x80000000u) ? ~u : (u | 0x80000000u); }

typedef float f32x16 __attribute__((ext_vector_type(16)));
__device__ __forceinline__ int wave_sum_i(int v) {
    v += __builtin_amdgcn_update_dpp(0, v, 0xB1, 0xf, 0xf, true);
    v += __builtin_amdgcn_update_dpp(0, v, 0x4E, 0xf, 0xf, true);
    v += __builtin_amdgcn_update_dpp(0, v, 0x141, 0xf, 0xf, true);
    v += __builtin_amdgcn_update_dpp(0, v, 0x140, 0xf, 0xf, true);
    return (__builtin_amdgcn_readlane(v, 0) + __builtin_amdgcn_readlane(v, 16)) + (__builtin_amdgcn_readlane(v, 32) + __builtin_amdgcn_readlane(v, 48));
}
__device__ __forceinline__ void dsa_select(const Args& a, unsigned char* lds, int vcu, int G, int tid) {
    unsigned char* ws = a.ws;
    const int lane0 = tid & 63, wave = __builtin_amdgcn_readfirstlane(tid >> 6);
    unsigned* sc = (unsigned*)lds;
    const bf16* iq = (const bf16*)(ws + R_IQ); const bf16* ik = (const bf16*)(ws + R_IK); const float* iw = (const float*)(ws + R_IW);
    unsigned short* idx = (unsigned short*)(ws + R_IDX);
    for (int p = vcu; p < 1024; p += G) {
#pragma unroll 1
        for (int half = 0; half < 2; ++half) {
            int lane = lane0; asm volatile("" : "+v"(lane));
            const int r32 = lane & 31, hh = lane >> 5;
            const int bb = p >> 8, x = p & 255, gi = half ? (511 - x) : x, t0 = gi * 8;
            const size_t qrow0 = (size_t)bb * SEQ + t0;
            const int t = t0 + wave;
            unsigned short* out = idx + (qrow0 + wave) * 256;
            if (t0 < 256) {
#pragma unroll
                for (int j = 0; j < 4; ++j) { const int kk = j * 64 + lane; out[kk] = (unsigned short)(kk <= t ? kk : 0xFFFF); }
                continue;
            }
            bf16x8 af[4];
#pragma unroll
            for (int ks = 0; ks < 4; ++ks) af[ks] = *(const bf16x8*)(iq + (qrow0 + (r32 >> 2)) * 256 + (r32 & 3) * 64 + ks * 16 + hh * 8);
            f32x4 w[4];
#pragma unroll
            for (int j = 0; j < 4; ++j) w[j] = *(const f32x4*)(iw + (qrow0 + 2 * j + hh) * 4);
            const int ntile = ((t0 + 7) >> 5) + 1;
            const bf16* ikb = ik + (size_t)bb * SEQ * 64 + lane * 8;
#define SEL_LOAD(dst, tb) do { _Pragma("unroll") for (int k_ = 0; k_ < 4; ++k_) { int tl_ = (tb) + 8 * k_; tl_ = tl_ > 127 ? 127 : tl_; \
                const bf16* kr_ = ikb + (size_t)tl_ * 2048; _Pragma("unroll") for (int ks = 0; ks < 4; ++ks) dst[k_][ks] = *(const bf16x8*)(kr_ + ks * 512); } } while (0)
#define SEL_COMP(src, tb) do { _Pragma("unroll") for (int k_ = 0; k_ < 4; ++k_) { const int tile_ = (tb) + 8 * k_; if (tile_ < ntile) { const int key_ = tile_ * 32 + r32; \
                f32x16 dd; _Pragma("unroll") for (int e = 0; e < 16; ++e) dd[e] = 0.f; \
                _Pragma("unroll") for (int ks = 0; ks < 4; ++ks) dd = __builtin_amdgcn_mfma_f32_32x32x16_bf16(af[ks], src[k_][ks], dd, 0, 0, 0); \
                _Pragma("unroll") for (int j = 0; j < 4; ++j) { \
                    const float s_ = (w[j][0] * fmaxf(dd[4 * j], 0.f) + w[j][1] * fmaxf(dd[4 * j + 1], 0.f)) + (w[j][2] * fmaxf(dd[4 * j + 2], 0.f) + w[j][3] * fmaxf(dd[4 * j + 3], 0.f)) + 0.0f; \
                    const int q_ = 2 * j + hh; const unsigned kv_ = f2key(s_); sc[q_ * 4096 + key_] = (key_ <= t0 + q_) ? kv_ : 0u; } } __builtin_amdgcn_sched_barrier(0); } } while (0)
            {
                bf16x8 bufA[4][4], bufB[4][4];
                int tb = wave;
                SEL_LOAD(bufA, tb);
                for (;;) {
                    SEL_LOAD(bufB, tb + 32);
                    SEL_COMP(bufA, tb);
                    tb += 32; if (tb >= ntile) break;
                    SEL_LOAD(bufA, tb + 32);
                    SEL_COMP(bufB, tb);
                    tb += 32; if (tb >= ntile) break;
                }
            }
#undef SEL_LOAD
#undef SEL_COMP
            __syncthreads();
            {
                int ls = lane; asm volatile("" : "+v"(ls));
                const unsigned* scq = sc + wave * 4096;
                unsigned u[64];
                const int tl = t - ls;
                const int ng = __builtin_amdgcn_readfirstlane(((t >> 6) + 8) >> 3);
#pragma unroll
                for (int g8 = 0; g8 < 8; ++g8) {
                    if (g8 < ng) {
#pragma unroll
                        for (int j = 8 * g8; j < 8 * g8 + 8; ++j) { const unsigned v_ = scq[j * 64 + ls]; u[j] = (j * 64 <= tl) ? v_ : 0u; }
                    } else {
#pragma unroll
                        for (int j = 8 * g8; j < 8 * g8 + 8; ++j) u[j] = 0u;
                    }
                }
#define CNT_GE(acc, val, thr) asm volatile("v_cmp_ge_u32_e32 vcc, %1, %2\n\tv_addc_co_u32_e32 %0, vcc, 0, %0, vcc" : "+v"(acc) : "v"(val), "v"(thr) : "vcc")
                unsigned T = 0u; int cT = 4096;
#pragma unroll 1
                for (int bit = 31; bit >= 0; --bit) {
                    unsigned cand = T | (1u << bit); asm volatile("" : "+v"(cand));
                    int c0 = 0, c1 = 0, cs = 0;
#pragma unroll
                    for (int g8 = 0; g8 < 8; ++g8) if (g8 < ng) {
                        const int j = 8 * g8;
                        CNT_GE(c0, u[j], cand); CNT_GE(c1, u[j + 1], cand); CNT_GE(c0, u[j + 2], cand); CNT_GE(c1, u[j + 3], cand); CNT_GE(c0, u[j + 4], cand); CNT_GE(c1, u[j + 5], cand); CNT_GE(c0, u[j + 6], cand); CNT_GE(c1, u[j + 7], cand);
                    }
                    const int cnt = wave_sum_i(c0 + c1) + cs;
                    if (cnt >= 256) { T = cand; cT = cnt; }
                    if (cnt == 256) break;
                }
#undef CNT_GE
                unsigned short* lst = (unsigned short*)(lds + 131072) + wave * 512;
                if (cT == 256) {
                    unsigned wlo = 0u, whi = 0u;
#pragma unroll
                    for (int j = 0; j < 64; ++j) if ((j >> 3) < ng) { const unsigned long long m_ = __ballot(u[j] >= T);
                        wlo = (ls == j) ? (unsigned)m_ : wlo; whi = (ls == j) ? (unsigned)(m_ >> 32) : whi; }
                    const int cl = __popc(wlo) + __popc(whi);
                    int inc = cl;
                    inc += __builtin_amdgcn_update_dpp(0, inc, 0x111, 0xf, 0xf, true); inc += __builtin_amdgcn_update_dpp(0, inc, 0x112, 0xf, 0xf, true);
                    inc += __builtin_amdgcn_update_dpp(0, inc, 0x114, 0xf, 0xf, true); inc += __builtin_amdgcn_update_dpp(0, inc, 0x118, 0xf, 0xf, true);
                    inc += __builtin_amdgcn_update_dpp(0, inc, 0x142, 0xa, 0xf, false); inc += __builtin_amdgcn_update_dpp(0, inc, 0x143, 0xc, 0xf, false);
                    int off = inc - cl;
                    while (__any((wlo | whi) != 0u)) {
                        const bool has = (wlo | whi) != 0u;
                        const int b_ = wlo ? __builtin_ctz(wlo) : 32 + __builtin_ctz(whi | 0x80000000u * (whi == 0u));
                        lst[has ? off : 256 + ls] = (unsigned short)(ls * 64 + b_);
                        off += has ? 1 : 0;
                        if (wlo) wlo &= wlo - 1u; else whi &= whi - 1u;
                    }
                } else {
                    int ngt = 0;
#pragma unroll
                    for (int j = 0; j < 64; ++j) if ((j >> 3) < ng) ngt += __popcll(__ballot(u[j] > T));
                    const int need = 256 - ngt;
                    const unsigned long long lt = (1ull << ls) - 1ull;
                    int base = 0, eqt = 0;
#pragma unroll
                    for (int j = 0; j < 64; ++j) if ((j >> 3) < ng) {
                        const bool eq = (u[j] == T);
                        const unsigned long long me = __ballot(eq);
                        const bool take = (u[j] > T) || (eq && (eqt + __popcll(me & lt) < need));
                        const unsigned long long mf = __ballot(take);
                        lst[take ? base + __popcll(mf & lt) : 256 + ls] = (unsigned short)(j * 64 + ls);
                        base += __popcll(mf); eqt += __popcll(me);
                    }
                }
                LDS_WAIT(); asm volatile("" ::: "memory");
                *(unsigned long long*)(out + 4 * ls) = *(const unsigned long long*)(lst + 4 * ls);
            }
            __syncthreads();
        }
    }
}

__device__ __forceinline__ void dsa_attend(const Args& a, unsigned char* lds, int vcu, int G, int tid) {
    unsigned char* ws = a.ws;
    const int lane0 = tid & 63, wave = __builtin_amdgcn_readfirstlane(tid >> 6);
    unsigned char* wl = lds + wave * 12288;
    int* kl = (int*)(wl + 10240);
    const bf16* bq = (const bf16*)(ws + R_BQ); const bf16* bk = (const bf16*)(ws + R_BK); const bf16* bv = (const bf16*)(ws + R_BV);
    const unsigned short* idx = (const unsigned short*)(ws + R_IDX);
    bf16* ao = (bf16*)(ws + R_AO);
    const int gw = vcu * NWAVES + wave, NGW = G * NWAVES;
    const int nq = 2 * ((M / 2 - gw + NGW - 1) / NGW);
    unsigned long long nw4; bf16x8 nqf0, nqf1;
#define ATT_Q(i, bb_, t_) const int p_ = gw + ((i) >> 1) * NGW; const int bb_ = p_ >> 11, x_ = p_ & 2047, t_ = ((i) & 1) ? (SEQ - 1 - x_) : x_
    { ATT_Q(0, bb0, t0); const size_t q0 = (size_t)bb0 * SEQ + t0;
      nw4 = *(const unsigned long long*)(idx + q0 * 256 + 4 * lane0);
      nqf0 = *(const bf16x8*)(bq + q0 * 512 + (lane0 & 7) * 64 + (lane0 >> 4) * 8); nqf1 = *(const bf16x8*)(bq + q0 * 512 + (lane0 & 7) * 64 + 32 + (lane0 >> 4) * 8); }
#pragma unroll 1
    for (int i = 0; i < nq; ++i) {
        int lane = lane0; asm volatile("" : "+v"(lane));
        const int fr = lane & 15, fq = lane >> 4;
        ATT_Q(i, bb, t);
        const size_t q = (size_t)bb * SEQ + t;
        const int cnt = t < 255 ? t + 1 : 256;
        { const unsigned long long w4 = nw4;
          int k0 = (int)(w4 & 0xffffu), k1 = (int)((w4 >> 16) & 0xffffu), k2 = (int)((w4 >> 32) & 0xffffu), k3 = (int)(w4 >> 48);
          const int p0 = 4 * lane;
          k0 = p0 < cnt ? k0 : 0; k1 = p0 + 1 < cnt ? k1 : 0; k2 = p0 + 2 < cnt ? k2 : 0; k3 = p0 + 3 < cnt ? k3 : 0;
          *(v4u*)(kl + p0) = (v4u){(unsigned)k0, (unsigned)k1, (unsigned)k2, (unsigned)k3}; }
        const bf16x8 qf0 = nqf0, qf1 = nqf1;
        LDS_WAIT(); asm volatile("" ::: "memory");
        const bf16* bkb = bk + (size_t)bb * SEQ * 64 + fq * 8;
        const bf16* bvb = bv + (size_t)bb * SEQ * 64 + (lane & 7) * 8;
        bf16x8 kf[16][2];
#pragma unroll
        for (int T = 0; T < 16; ++T) { const bf16* kp = bkb + (size_t)kl[T * 16 + fr] * 64; kf[T][0] = *(const bf16x8*)kp; kf[T][1] = *(const bf16x8*)(kp + 32); }
        v4u vreg[8];
#pragma unroll
        for (int i2 = 0; i2 < 8; ++i2) vreg[i2] = *(const v4u*)(bvb + (size_t)kl[(lane >> 3) + 8 * i2] * 64);
        if (i + 1 < nq) { ATT_Q(i + 1, bbn, tn); const size_t qn = (size_t)bbn * SEQ + tn;
            nw4 = *(const unsigned long long*)(idx + qn * 256 + 4 * lane);
            nqf0 = *(const bf16x8*)(bq + qn * 512 + (fr & 7) * 64 + fq * 8); nqf1 = *(const bf16x8*)(bq + qn * 512 + (fr & 7) * 64 + 32 + fq * 8); }
        f32x4 s[16];
#pragma unroll
        for (int T = 0; T < 16; ++T) {
            f32x4 z = {0.f, 0.f, 0.f, 0.f};
            z = __builtin_amdgcn_mfma_f32_16x16x32_bf16(kf[T][0], qf0, z, 0, 0, 0);
            s[T] = __builtin_amdgcn_mfma_f32_16x16x32_bf16(kf[T][1], qf1, z, 0, 0, 0);
        }
        float mx = -INFINITY;
#pragma unroll
        for (int T = 0; T < 16; ++T)
#pragma unroll
            for (int r = 0; r < 4; ++r) { if (T * 16 + 4 * fq + r >= cnt) s[T][r] = -INFINITY; mx = fmaxf(mx, s[T][r]); }
        mx = fmaxf(mx, __shfl_xor(mx, 16)); mx = fmaxf(mx, __shfl_xor(mx, 32));
        float sum = 0.f;
#pragma unroll
        for (int T = 0; T < 16; ++T)
#pragma unroll
            for (int r = 0; r < 4; ++r) { const float pv = __expf(s[T][r] - mx); s[T][r] = pv; sum += pv; }
        sum += __shfl_xor(sum, 16); sum += __shfl_xor(sum, 32);
        const float inv = 1.0f / sum;
        bf16x8 pf[8];
#pragma unroll
        for (int kk = 0; kk < 8; ++kk) { v4u w_;
            w_.x = pg8::cvt_pk_bf16(s[2 * kk][0], s[2 * kk][1]); w_.y = pg8::cvt_pk_bf16(s[2 * kk][2], s[2 * kk][3]);
            w_.z = pg8::cvt_pk_bf16(s[2 * kk + 1][0], s[2 * kk + 1][1]); w_.w = pg8::cvt_pk_bf16(s[2 * kk + 1][2], s[2 * kk + 1][3]);
            pf[kk] = __builtin_bit_cast(bf16x8, w_); }
        f32x4 o[4];
#pragma unroll
        for (int dt = 0; dt < 4; ++dt) o[dt] = (f32x4){0.f, 0.f, 0.f, 0.f};
        const unsigned char* trb = wl + (4 * fq + (fr >> 2)) * 160 + (fr & 3) * 8;
#pragma unroll
        for (int c = 0; c < 4; ++c) {
#pragma unroll
            for (int i2 = 0; i2 < 8; ++i2) *(v4u*)(wl + ((lane >> 3) + 8 * i2) * 160 + (lane & 7) * 16) = vreg[i2];
            if (c < 3) {
#pragma unroll
                for (int i2 = 0; i2 < 8; ++i2) vreg[i2] = *(const v4u*)(bvb + (size_t)kl[64 * (c + 1) + (lane >> 3) + 8 * i2] * 64);
            }
            LDS_WAIT(); asm volatile("" ::: "memory");
#pragma unroll
            for (int k2 = 0; k2 < 2; ++k2)
#pragma unroll
                for (int dt = 0; dt < 4; ++dt) {
                    const v4i16_t a0 = tr16(trb + (2 * k2) * 16 * 160 + dt * 32), a1 = tr16(trb + (2 * k2 + 1) * 16 * 160 + dt * 32);
                    const bf16x8 vf = {a0[0], a0[1], a0[2], a0[3], a1[0], a1[1], a1[2], a1[3]};
                    o[dt] = __builtin_amdgcn_mfma_f32_16x16x32_bf16(vf, pf[2 * c + k2], o[dt], 0, 0, 0);
                }
            LDS_WAIT(); asm volatile("" ::: "memory");
        }
        if (fr < 8) {
#pragma unroll
            for (int dt = 0; dt < 4; ++dt) pg8::st_bf16x4(ao + q * 1024 + 512 + fr * 64 + dt * 16 + 4 * fq, o[dt] * inv);
        }
    }
#undef ATT_Q
}

__device__ __forceinline__ void ffn_fixup(const Args& a, int layer, int vcu, int G, int tid) {
    unsigned char* ws = a.ws;
    const float* hl = (const float*)(ws + R_HL); const float* hf = (const float*)(ws + R_HF);
    const float* cw = a.in[16] + (size_t)layer * 3 * DFF2; const float* cb = a.in[17] + (size_t)layer * DFF2;
    bf16* gt = (bf16*)(ws + R_GT);
    for (int it = vcu * NTHR + tid; it < 256 * 2 * (DFF / 4); it += G * NTHR) {
        const int cg = it % (DFF / 4), rr = (it / (DFF / 4)) & 1, blk = it / (2 * (DFF / 4));
        const int g0 = cg * 4; const bool bstart = (blk & 63) == 0;
        const f32x4 z4 = {0.f, 0.f, 0.f, 0.f};
        f32x4 a0g, a0u, a1g, a1u, a2g, a2u;
        { const float* h0 = hf + (size_t)(blk * 2 + rr) * DFF2 + g0; a0g = *(const f32x4*)h0; a0u = *(const f32x4*)(h0 + DFF); }
        if (rr == 1) {
            const float* h1 = hf + (size_t)(blk * 2) * DFF2 + g0; a1g = *(const f32x4*)h1; a1u = *(const f32x4*)(h1 + DFF);
            if (bstart) { a2g = z4; a2u = z4; } else { const float* h2 = hl + (size_t)((blk - 1) * 2 + 1) * DFF2 + g0; a2g = *(const f32x4*)h2; a2u = *(const f32x4*)(h2 + DFF); }
        } else {
            if (bstart) { a1g = z4; a1u = z4; a2g = z4; a2u = z4; }
            else { const float* h1 = hl + (size_t)((blk - 1) * 2 + 1) * DFF2 + g0; a1g = *(const f32x4*)h1; a1u = *(const f32x4*)(h1 + DFF);
                   const float* h2 = hl + (size_t)((blk - 1) * 2) * DFF2 + g0; a2g = *(const f32x4*)h2; a2u = *(const f32x4*)(h2 + DFF); }
        }
        const f32x4 cgv = *(const f32x4*)(cb + g0) + *(const f32x4*)(cw + g0) * a2g + *(const f32x4*)(cw + DFF2 + g0) * a1g + *(const f32x4*)(cw + 2 * DFF2 + g0) * a0g;
        const f32x4 cuv = *(const f32x4*)(cb + DFF + g0) + *(const f32x4*)(cw + DFF + g0) * a2u + *(const f32x4*)(cw + DFF2 + DFF + g0) * a1u + *(const f32x4*)(cw + 2 * DFF2 + DFF + g0) * a0u;
        f32x4 o; o[0] = pg8::silu_f(cgv[0]) * cuv[0]; o[1] = pg8::silu_f(cgv[1]) * cuv[1]; o[2] = pg8::silu_f(cgv[2]) * cuv[2]; o[3] = pg8::silu_f(cgv[3]) * cuv[3];
        pg8::st_bf16x4(gt + (size_t)(blk * 64 + rr) * DFF + g0, o);
    }
}

__device__ __forceinline__ void sgu_mix(const Args& a, unsigned char* lds, int vcu, int G, int tid) {
    unsigned char* ws = a.ws;
    constexpr int RSV = 288, RSW = 272;
    unsigned char* vn = lds;
    unsigned char* wl = lds + 128 * RSV;
    const bf16* z = (const bf16*)(ws + R_Z); bf16* sg = (bf16*)(ws + R_SG);
    const float* lns = (const float*)(ws + WS_SSQ) + 5 * M; const float* lnq = lns + M;
    const float* lg = a.in[9]; const float* lb = a.in[10]; const float* wsp = a.in[11]; const float* bs = a.in[12];
    const int lane = tid & 63, wave = tid >> 6, fr = lane & 15, fq = lane >> 4;
    int gcur = -1;
    for (int unit = vcu; unit < 1024; unit += G) {
        const int g = unit & 7, ci = unit >> 3, row0 = ci * 128;
        if (g != gcur) {
            gcur = g;
            const int t = tid >> 2, s0 = (tid & 3) * 32;
            const f32x4* wr = (const f32x4*)(wsp + ((size_t)g * 128 + t) * 128 + s0);
#pragma unroll
            for (int j = 0; j < 4; ++j) { const f32x4 w0 = wr[2 * j], w1 = wr[2 * j + 1]; const int s = s0 + 8 * j;
                *(v4u*)(wl + t * RSW + s * 2) = (v4u){pk2(s <= t ? w0[0] : 0.f, s + 1 <= t ? w0[1] : 0.f), pk2(s + 2 <= t ? w0[2] : 0.f, s + 3 <= t ? w0[3] : 0.f),
                                                     pk2(s + 4 <= t ? w1[0] : 0.f, s + 5 <= t ? w1[1] : 0.f), pk2(s + 6 <= t ? w1[2] : 0.f, s + 7 <= t ? w1[3] : 0.f)}; }
        }
        { const int s = tid >> 2, c0 = (tid & 3) * 32; const size_t row = (size_t)(row0 + s);
          const float mean = lns[row] * (1.0f / 1024.0f); const float var = lnq[row] * (1.0f / 1024.0f) - mean * mean; const float rstd = 1.0f / sqrtf(var + 1e-5f);
          const v4u* zr = (const v4u*)(z + row * 2048 + 1024 + g * 128 + c0);
#pragma unroll
          for (int j = 0; j < 4; ++j) { const v4u zw = zr[j]; const int c = g * 128 + c0 + 8 * j;
              const f32x4 g0 = *(const f32x4*)(lg + c), g1 = *(const f32x4*)(lg + c + 4), b0 = *(const f32x4*)(lb + c), b1 = *(const f32x4*)(lb + c + 4);
              const float v0 = (__builtin_bit_cast(float, zw.x << 16) - mean) * rstd * g0[0] + b0[0], v1 = (__builtin_bit_cast(float, zw.x & 0xffff0000u) - mean) * rstd * g0[1] + b0[1];
              const float v2 = (__builtin_bit_cast(float, zw.y << 16) - mean) * rstd * g0[2] + b0[2], v3 = (__builtin_bit_cast(float, zw.y & 0xffff0000u) - mean) * rstd * g0[3] + b0[3];
              const float v4 = (__builtin_bit_cast(float, zw.z << 16) - mean) * rstd * g1[0] + b1[0], v5 = (__builtin_bit_cast(float, zw.z & 0xffff0000u) - mean) * rstd * g1[1] + b1[1];
              const float v6 = (__builtin_bit_cast(float, zw.w << 16) - mean) * rstd * g1[2] + b1[2], v7 = (__builtin_bit_cast(float, zw.w & 0xffff0000u) - mean) * rstd * g1[3] + b1[3];
              *(v4u*)(vn + s * RSV + (c0 + 8 * j) * 2) = (v4u){pk2(v0, v1), pk2(v2, v3), pk2(v4, v5), pk2(v6, v7)}; } }
        __syncthreads();
        bf16x8 af[4];
#pragma unroll
        for (int ks = 0; ks < 4; ++ks) af[ks] = frag_tr(vn, RSV, 32 * ks, 32 * ks + 16, wave * 16, fr, fq);
#pragma unroll
        for (int Tt = 0; Tt < 8; ++Tt) {
            f32x4 acc = {0.f, 0.f, 0.f, 0.f};
#pragma unroll
            for (int ks = 0; ks <= Tt / 2; ++ks) acc = __builtin_amdgcn_mfma_f32_16x16x32_bf16(af[ks], frag_row_perm(wl, RSW, Tt * 16, 32 * ks, 32 * ks + 16, fr, fq), acc, 0, 0, 0);
            const int t = Tt * 16 + fr; const size_t row = (size_t)(row0 + t);
            const float bias = bs[g * 128 + t];
            const int col = g * 128 + wave * 16 + 4 * fq;
            const unsigned long long uw = *(const unsigned long long*)(z + row * 2048 + col);
            f32x4 o;
            o[0] = __builtin_bit_cast(float, (unsigned)(uw << 16)) * (acc[0] + bias); o[1] = __builtin_bit_cast(float, (unsigned)uw & 0xffff0000u) * (acc[1] + bias);
            o[2] = __builtin_bit_cast(float, (unsigned)(uw >> 32) << 16) * (acc[2] + bias); o[3] = __builtin_bit_cast(float, (unsigned)(uw >> 32) & 0xffff0000u) * (acc[3] + bias);
            pg8::st_bf16x4(sg + row * 1024 + col, o);
        }
        __syncthreads();
    }
}

__device__ __forceinline__ void final_norm(const Args& a, int vcu, int G, int tid) {
    const int lane = tid & 63, wave = tid >> 6;
    const float* g = a.in[19];
    const bf16* xb = (const bf16*)(a.ws + WS_XB); const float* ssq4 = (const float*)(a.ws + WS_SSQ) + 4 * M;
    for (int m = vcu * NWAVES + wave; m < M; m += G * NWAVES) {
        const float rs = 1.0f / sqrtf(ssq4[m] * (1.0f / 1024.0f) + 1e-6f);
        const v4u* xr = (const v4u*)(xb + (size_t)m * DM) + lane;
        f32x4* orow = (f32x4*)(a.out + (size_t)m * DM);
#pragma unroll
        for (int j = 0; j < 2; ++j) { const v4u w = xr[64 * j]; const int c = (lane + 64 * j) * 8;
            const f32x4 g0 = *(const f32x4*)(g + c), g1 = *(const f32x4*)(g + c + 4);
            f32x4 o0, o1;
            o0[0] = __builtin_bit_cast(float, w.x << 16) * rs * g0[0]; o0[1] = __builtin_bit_cast(float, w.x & 0xffff0000u) * rs * g0[1];
            o0[2] = __builtin_bit_cast(float, w.y << 16) * rs * g0[2]; o0[3] = __builtin_bit_cast(float, w.y & 0xffff0000u) * rs * g0[3];
            o1[0] = __builtin_bit_cast(float, w.z << 16) * rs * g1[0]; o1[1] = __builtin_bit_cast(float, w.z & 0xffff0000u) * rs * g1[1];
            o1[2] = __builtin_bit_cast(float, w.w << 16) * rs * g1[2]; o1[3] = __builtin_bit_cast(float, w.w & 0xffff0000u) * rs * g1[3];
            orow[c / 4] = o0; orow[c / 4 + 1] = o1; }
    }
}

__device__ __forceinline__ int opq(int x) { asm volatile("" : "+s"(x)); return x; }
__device__ __forceinline__ int opqv(int x) { asm volatile("" : "+v"(x)); return x; }
constexpr int NPHASE = 16;
__global__ void __launch_bounds__(NTHR, 2) fwd_megakernel(Args args) {
    extern __shared__ __attribute__((aligned(16))) unsigned char lds[];
    const int tid = threadIdx.x;
    const int G = gridDim.x; const int bx = blockIdx.x;
    const int vcu = (G % 8 == 0) ? (bx % 8) * (G / 8) + bx / 8 : bx;
    unsigned char* ws = args.ws;
    for (int u = tid; u < (LDS_BYTES - LDSCTL_OFF) / 4; u += NTHR) ((LAS unsigned*)((LAS unsigned char*)lds + LDSCTL_OFF))[u] = 0u;
    __syncthreads();
    XcdBarrier bar; bar.bar = (unsigned*)(ws + WS_CTL) + CW_BAR; bar.x = 0; bar.st = nullptr;
    const int lo = args.ph_lo, hi = args.ph_hi;
    if (hi - lo > 1) bar = xcd_barrier_post((unsigned*)(ws + WS_CTL) + CW_BAR, (volatile LAS unsigned*)((LAS unsigned char*)lds + MISC_OFF) + 8);
#ifdef PHASE_MASK
#define IN(k) (((PHASE_MASK >> (k)) & 1) && lo <= (k) && (k) < hi)
#else
#define IN(k) (lo <= (k) && (k) < hi)
#endif
#define SEAM(k) do { if (IN(k) && IN((k) + 1)) xcd_barrier(bar); } while (0)
    LAS unsigned char* ring = (LAS unsigned char*)lds;
    float* ssq = (float*)(ws + WS_SSQ);
    bf16* xb = (bf16*)(ws + WS_XB);

    if (IN(0)) { p0_prologue(args, lds, opq(vcu), G, opqv(tid)); __syncthreads(); } SEAM(0);

    if (IN(1)) {
        pg8::Gemm g{xb, (const bf16*)(ws + WS_WIN), M, NIN, DM}; pg8::StaticOrder S; S.init(M, NIN, G, opq(bx));
        pg8::EpiIn E{ssq, (const float*)(ws + WS_ROPE), (bf16*)(ws + R_GQ), (bf16*)(ws + R_GK), (bf16*)(ws + R_GV), (bf16*)(ws + R_GR), (bf16*)(ws + R_BQ), (bf16*)(ws + R_BK), (bf16*)(ws + R_BV),
                      (bf16*)(ws + R_IQ), (bf16*)(ws + R_IK), (float*)(ws + R_ALR), (float*)(ws + R_IW)};
        pg8::gemm_phase<pg8::EpiIn, pg8::StaticOrder, true, true>(ring, g, S, E);
    } SEAM(1);

    if (IN(2)) { gla_phase_a(args, lds, opq(vcu), G, opqv(tid)); dsa_select(args, lds, opq(vcu), G, opqv(tid)); __syncthreads(); } SEAM(2);
    if (IN(3)) { gla_scan(args, opq(vcu), G, opqv(tid)); dsa_attend(args, lds, opq(vcu), G, opqv(tid)); __syncthreads(); } SEAM(3);
    if (IN(4)) { gla_phase_b(args, lds, opq(vcu), G, opqv(tid)); } SEAM(4);

    if (IN(5)) {
        pg8::Gemm g{(const bf16*)(ws + R_AO), (const bf16*)(ws + WS_WO), M, DM, DM}; pg8::StaticOrder S; S.init(M, DM, G, opq(bx));
        pg8::EpiRes E{xb, ssq + M};
        pg8::gemm_phase<pg8::EpiRes, pg8::StaticOrder, true, true>(ring, g, S, E);
    } SEAM(5);

#pragma unroll 1
    for (int layer = 0; layer < 2; ++layer) {
        const int pb = layer == 0 ? 6 : 12;
        if (IN(pb)) {
            pg8::Gemm g{xb, (const bf16*)(ws + (layer == 0 ? WS_WUP0 : WS_WUP1)), M, DFF2, DM}; pg8::StaticOrder S; S.init(M, DFF2, G, opq(bx));
            pg8::EpiConv E{ssq + (layer == 0 ? 1 : 3) * M, args.in[16] + (size_t)layer * 3 * DFF2, args.in[17] + (size_t)layer * DFF2, (bf16*)(ws + R_GT), (float*)(ws + R_HL), (float*)(ws + R_HF)};
            pg8::gemm_phase<pg8::EpiConv, pg8::StaticOrder, true, true>(ring, g, S, E);
        } SEAM(pb);
        if (IN(pb + 1)) { ffn_fixup(args, layer, opq(vcu), G, opqv(tid)); } SEAM(pb + 1);
        if (IN(pb + 2)) {
            pg8::Gemm g{(const bf16*)(ws + R_GT), (const bf16*)(ws + (layer == 0 ? WS_WDN0 : WS_WDN1)), M, DM, DFF}; pg8::StaticOrder S; S.init(M, DM, G, opq(bx));
            pg8::EpiRes E{xb, ssq + (layer == 0 ? 2 : 4) * M};
            pg8::gemm_phase<pg8::EpiRes, pg8::StaticOrder, true, true>(ring, g, S, E);
        } SEAM(pb + 2);
        if (layer == 0) {
            if (IN(9)) {
                pg8::Gemm g{xb, (const bf16*)(ws + WS_WUV), M, 2048, DM}; pg8::StaticOrder S; S.init(M, 2048, G, opq(bx));
                pg8::EpiSgu E{ssq + 2 * M, (bf16*)(ws + R_Z), ssq + 5 * M, ssq + 6 * M};
                pg8::gemm_phase<pg8::EpiSgu, pg8::StaticOrder, true, true>(ring, g, S, E);
            } SEAM(9);
            if (IN(10)) { sgu_mix(args, lds, opq(vcu), G, opqv(tid)); } SEAM(10);
            if (IN(11)) {
                pg8::Gemm g{(const bf16*)(ws + R_SG), (const bf16*)(ws + WS_WOUT), M, DM, DM}; pg8::StaticOrder S; S.init(M, DM, G, opq(bx));
                pg8::EpiRes E{xb, ssq + 3 * M};
                pg8::gemm_phase<pg8::EpiRes, pg8::StaticOrder, true, true>(ring, g, S, E);
            } SEAM(11);
        }
    }
    if (IN(15)) { final_norm(args, opq(vcu), G, opqv(tid)); }
#undef IN
#undef SEAM
}

extern "C" void kernel_launch(void* const* d_in, const int* in_sizes, int n_in, void* d_out, int out_size, void* d_ws, size_t ws_size, hipStream_t stream) {
    static int grid = 0;
    if (grid == 0) {
        if (n_in != 20 || out_size != M * DM || ws_size < WS_END) { fprintf(stderr, "kernel_launch: unexpected problem (n_in %d, out %d, ws %zu)\n", n_in, out_size, ws_size); grid = -1; return; }
        int dev = 0, cus = 0, per_cu = 0;
        if (hipGetDevice(&dev) != hipSuccess || hipDeviceGetAttribute(&cus, hipDeviceAttributeMultiprocessorCount, dev) != hipSuccess) { grid = -1; return; }
        if (hipFuncSetAttribute((const void*)fwd_megakernel, hipFuncAttributeMaxDynamicSharedMemorySize, LDS_BYTES) != hipSuccess) { fprintf(stderr, "kernel_launch: hipFuncSetAttribute failed\n"); grid = -1; return; }
        if (hipOccupancyMaxActiveBlocksPerMultiprocessor(&per_cu, (const void*)fwd_megakernel, NTHR, LDS_BYTES) != hipSuccess || per_cu < 1)
            fprintf(stderr, "kernel_launch: note: occupancy query reports %d workgroups per CU\n", per_cu);
        (void)hipGetLastError();
        grid = cus;
    }
    if (grid < 0) return;
    if (hipMemsetAsync((char*)d_ws + WS_CTL, 0, CTL_ZERO_BYTES, stream) != hipSuccess) { fprintf(stderr, "kernel_launch: hipMemsetAsync failed\n"); return; }
    Args a{};
    for (int i = 0; i < 20; ++i) a.in[i] = (const float*)d_in[i];
    a.out = (float*)d_out; a.ws = (unsigned char*)d_ws;
#if MK_MULTI
    for (int p = 0; p < NPHASE; ++p) { a.ph_lo = p; a.ph_hi = p + 1; hipLaunchKernelGGL(fwd_megakernel, dim3(grid), dim3(NTHR), LDS_BYTES, stream, a); }
#else
    a.ph_lo = 0; a.ph_hi = NPHASE;
    hipLaunchKernelGGL(fwd_megakernel, dim3(grid), dim3(NTHR), LDS_BYTES, stream, a);
#endif
    const hipError_t le = hipPeekAtLastError();
    if (le != hipSuccess) fprintf(stderr, "kernel_launch: launch failed: %s\n", hipGetErrorName(le));
}
```

```cpp
#include <hip/hip_runtime.h>
#include <cstdio>
#include <cstdint>

#ifndef MK_MULTI
#define MK_MULTI 0
#endif

namespace pg8 {
#define PG8_LAS __attribute__((address_space(3)))
typedef unsigned short bf16_t;
typedef short bf16x8 __attribute__((ext_vector_type(8)));
typedef float f32x4 __attribute__((ext_vector_type(4)));
typedef unsigned u32x4 __attribute__((ext_vector_type(4)));
constexpr int BM = 256, BK = 64, HALF = 128, HTB = HALF * BK * 2  , STAGE_BYTES = 8 * HTB, NXCD = 8, WGM = 8;

__host__ __device__ __forceinline__ int lds_byte(int r, int c) { const int st = (r >> 4) * 2 + (c >> 5), rr = r & 15, cc = c & 31, ob = rr * 64 + cc * 2; return st * 1024 + (ob ^ (((ob >> 9) & 1) << 5)); }
__host__ __device__ __forceinline__ void stage_rc(int b, int& R, int& C) { const int st = b / 1024, sb = b % 1024, swz = sb ^ (((sb >> 9) & 1) << 5); R = (st >> 1) * 16 + swz / 64; C = (st & 1) * 32 + (swz % 64) / 2; }
__host__ __device__ __forceinline__ int perm32(int rho) { const int n = rho >> 4, i = rho & 15; return 8 * (i >> 2) + 4 * n + (i & 3); }

struct Unit { int pm, pn; };
struct Gemm { const bf16_t* A; const bf16_t* Bt; int M, N, K; };

struct StaticOrder {
    int nM, nN, nwg, G, c;
    __host__ __device__ void init(int M, int N, int G_, int c_) { nM = M / BM; nN = N / BM; nwg = nM * nN; G = G_; c = c_; }
    __host__ __device__ bool next(int i, Unit& u) const {
        const long L = (long)i * G + c; if (L >= nwg) return false;
        int wgid = (int)L; { const int q = nwg / NXCD, r = nwg % NXCD, xcd = wgid % NXCD, off = wgid / NXCD; wgid = (xcd < r ? xcd * (q + 1) : r * (q + 1) + (xcd - r) * q) + off; }
        const int nig = WGM * nN, gid = wgid / nig, fm = gid * WGM, gsz = (nM - fm) < WGM ? (nM - fm) : WGM;
        u.pm = fm + ((wgid % nig) % gsz); u.pn = (wgid % nig) / gsz; return true;
    }
    __device__ __forceinline__ void a_ready(const Unit&) const {}
    __device__ __forceinline__ void done(const Unit&) const {}
};

__device__ __forceinline__ unsigned cvt_pk_bf16(float lo, float hi) { unsigned r; asm volatile("v_cvt_pk_bf16_f32 %0, %1, %2" : "=v"(r) : "v"(lo), "v"(hi)); return r; }
typedef float f32x2 __attribute__((ext_vector_type(2)));
typedef unsigned u32x2 __attribute__((ext_vector_type(2)));
__device__ __forceinline__ void st_bf16x4(bf16_t* p, f32x4 v) { u32x2 w; w.x = cvt_pk_bf16(v[0], v[1]); w.y = cvt_pk_bf16(v[2], v[3]); *(u32x2*)p = w; }
__device__ __forceinline__ float sigm(float x) { return __builtin_amdgcn_rcpf(1.0f + __builtin_amdgcn_exp2f(-1.4426950408889634f * x)); }
__device__ __forceinline__ float silu_f(float x) { return x * sigm(x); }
__device__ __forceinline__ float gelu_tanh_f(float x) { const float u = 0.7978845608028654f * (x + 0.044715f * x * x * x); return x * sigm(2.0f * u); }
__device__ __forceinline__ f32x4 shfl4(f32x4 v, int src) { f32x4 r; r[0] = __shfl(v[0], src); r[1] = __shfl(v[1], src); r[2] = __shfl(v[2], src); r[3] = __shfl(v[3], src); return r; }
__device__ __forceinline__ f32x4 rope4(f32x4 v, const float* tab_t, int fq) {
    const f32x4 cs = *(const f32x4*)(tab_t + 4 * fq);
    f32x4 o; o[0] = v[0] * cs[0] - v[1] * cs[1]; o[1] = v[1] * cs[0] + v[0] * cs[1]; o[2] = v[2] * cs[2] - v[3] * cs[3]; o[3] = v[3] * cs[2] + v[2] * cs[3]; return o;
}

struct EpiIn {
    static constexpr bool PERM = false, AFTER_DRAIN = false;
    const float* ssq; const float* rope;
    bf16_t *gq, *gk, *gv, *gr, *bq, *bk, *bv, *iq, *ik; float *alr, *iw;
    __device__ __forceinline__ void operator()(const f32x4 (&acc)[2][2][4][2], const Unit& u, int wr, int wc, int fr_in, int fq_in) const {
        int fr = fr_in, fq = fq_in; asm volatile("" : "+v"(fr), "+v"(fq));
        const int pn = u.pn;
        float rsv[2][4];
#pragma unroll
        for (int ai = 0; ai < 2; ++ai)
#pragma unroll
            for (int m = 0; m < 4; ++m) rsv[ai][m] = __builtin_amdgcn_rsqf(ssq[u.pm * BM + ai * HALF + wr * 64 + m * 16 + fr] * (1.0f / 1024.0f) + 1e-6f);
#pragma unroll
        for (int ai = 0; ai < 2; ++ai)
#pragma unroll
            for (int m = 0; m < 4; ++m) {
                const int r = u.pm * BM + ai * HALF + wr * 64 + m * 16 + fr;
                const float rs = rsv[ai][m];
                const float* tab_t = rope + (size_t)(r & 4095) * 16;
#pragma unroll
                for (int bj = 0; bj < 2; ++bj)
#pragma unroll
                    for (int n = 0; n < 2; ++n) {
                        f32x4 v = acc[ai][bj][m][n] * rs;
                        const int cl = bj * HALF + wc * 32 + n * 16 + 4 * fq;
                        const bool ropecol = ((wc & 1) == 0) && (n == 0);
                        if (pn == 0) { st_bf16x4(gq + (size_t)r * 256 + cl, v * 0.125f); }
                        else if (pn == 1) { st_bf16x4(gk + (size_t)r * 256 + cl, v); }
                        else if (pn < 4) { st_bf16x4(gv + (size_t)r * 512 + (pn - 2) * 256 + cl, v); }
                        else if (pn < 6) { st_bf16x4(gr + (size_t)r * 512 + (pn - 4) * 256 + cl, v); }
                        else if (pn < 8) { if (ropecol) v = rope4(v, tab_t, fq); st_bf16x4(bq + (size_t)r * 512 + (pn - 6) * 256 + cl, v * 0.125f); }
                        else if (pn == 8) { if (ropecol) v = rope4(v, tab_t, fq); st_bf16x4(iq + (size_t)r * 256 + cl, v); }
                        else {
                            const int reg = bj * 2 + (wc >> 1);
                            const int c64 = cl & 63;
                            if (reg == 0) { if (ropecol) v = rope4(v, tab_t, fq); st_bf16x4(bk + (size_t)r * 64 + c64, v); }
                            else if (reg == 1) { st_bf16x4(bv + (size_t)r * 64 + c64, v); }
                            else if (reg == 2) { if (ropecol) v = rope4(v, tab_t, fq); const int key_ = r & 4095; st_bf16x4(ik + (size_t)(r >> 12) * (4096 * 64) + ((((key_ >> 5) * 4 + (c64 >> 4)) * 64 + ((c64 >> 3) & 1) * 32 + (key_ & 31)) * 8) + (c64 & 7), v); }
                            else if ((wc & 1) == 0) {
                                if (n == 0) *(f32x4*)(alr + (size_t)r * 16 + 4 * fq) = v;
                                else if (fq == 0) *(f32x4*)(iw + (size_t)r * 4) = v * 0.5f;
                            }
                        }
                    }
            }
    }
};

struct EpiRes {
    static constexpr bool PERM = false, AFTER_DRAIN = false;
    bf16_t* xb; float* ssq;
    __device__ __forceinline__ void operator()(const f32x4 (&acc)[2][2][4][2], const Unit& u, int wr, int wc, int fr_in, int fq_in) const {
        int fr = fr_in, fq = fq_in; asm volatile("" : "+v"(fr), "+v"(fq));
#pragma unroll
        for (int ai = 0; ai < 2; ++ai)
#pragma unroll
            for (int m = 0; m < 4; ++m) {
                const int r = u.pm * BM + ai * HALF + wr * 64 + m * 16 + fr;
                float s = 0.f;
#pragma unroll
                for (int bj = 0; bj < 2; ++bj)
#pragma unroll
                    for (int n = 0; n < 2; ++n) {
                        const size_t off = (size_t)r * 1024 + u.pn * BM + bj * HALF + wc * 32 + n * 16 + 4 * fq;
                        const u32x2 bw = *(const u32x2*)(xb + off);
                        f32x4 x = acc[ai][bj][m][n];
                        x[0] += __builtin_bit_cast(float, bw.x << 16); x[1] += __builtin_bit_cast(float, bw.x & 0xffff0000u);
                        x[2] += __builtin_bit_cast(float, bw.y << 16); x[3] += __builtin_bit_cast(float, bw.y & 0xffff0000u);
                        st_bf16x4(xb + off, x);
                        s += (x[0] * x[0] + x[1] * x[1]) + (x[2] * x[2] + x[3] * x[3]);
                    }
                s += __shfl_xor(s, 16); s += __shfl_xor(s, 32);
                if (fq == 0) atomicAdd(ssq + r, s);
            }
    }
};

struct EpiSgu {
    static constexpr bool PERM = false, AFTER_DRAIN = false;
    const float* ssq; bf16_t* z; float* lns; float* lnq;
    __device__ __forceinline__ void operator()(const f32x4 (&acc)[2][2][4][2], const Unit& u, int wr, int wc, int fr_in, int fq_in) const {
        int fr = fr_in, fq = fq_in; asm volatile("" : "+v"(fr), "+v"(fq));
        const bool vhalf = u.pn >= 4;
        float rsv[2][4];
#pragma unroll
        for (int ai = 0; ai < 2; ++ai)
#pragma unroll
            for (int m = 0; m < 4; ++m) rsv[ai][m] = __builtin_amdgcn_rsqf(ssq[u.pm * BM + ai * HALF + wr * 64 + m * 16 + fr] * (1.0f / 1024.0f) + 1e-6f);
#pragma unroll
        for (int ai = 0; ai < 2; ++ai)
#pragma unroll
            for (int m = 0; m < 4; ++m) {
                const int r = u.pm * BM + ai * HALF + wr * 64 + m * 16 + fr;
                const float rs = rsv[ai][m];
                float s = 0.f, q = 0.f;
#pragma unroll
                for (int bj = 0; bj < 2; ++bj)
#pragma unroll
                    for (int n = 0; n < 2; ++n) {
                        f32x4 v = acc[ai][bj][m][n] * rs;
                        v[0] = gelu_tanh_f(v[0]); v[1] = gelu_tanh_f(v[1]); v[2] = gelu_tanh_f(v[2]); v[3] = gelu_tanh_f(v[3]);
                        st_bf16x4(z + (size_t)r * 2048 + u.pn * BM + bj * HALF + wc * 32 + n * 16 + 4 * fq, v);
                        s += (v[0] + v[1]) + (v[2] + v[3]); q += (v[0] * v[0] + v[1] * v[1]) + (v[2] * v[2] + v[3] * v[3]);
                    }
                if (vhalf) {
                    s += __shfl_xor(s, 16); s += __shfl_xor(s, 32); q += __shfl_xor(q, 16); q += __shfl_xor(q, 32);
                    if (fq == 0) { atomicAdd(lns + r, s); atomicAdd(lnq + r, q); }
                }
            }
    }
};

struct EpiConv {
    static constexpr bool PERM = false, AFTER_DRAIN = false;
    const float* ssq; const float* cw; const float* cb; bf16_t* gt; float* hl; float* hf;
    __device__ __forceinline__ void operator()(const f32x4 (&acc)[2][2][4][2], const Unit& u, int wr, int wc, int fr_in, int fq_in) const {
        int fr = fr_in, fq = fq_in; asm volatile("" : "+v"(fr), "+v"(fq));
        const int lane = fq * 16 + fr;
        const int s1 = (lane & 48) | ((fr + 15) & 15), s2 = (lane & 48) | ((fr + 14) & 15);
        float rs[2][4];
#pragma unroll
        for (int ai = 0; ai < 2; ++ai)
#pragma unroll
            for (int m = 0; m < 4; ++m) rs[ai][m] = __builtin_amdgcn_rsqf(ssq[u.pm * BM + ai * HALF + wr * 64 + m * 16 + fr] * (1.0f / 1024.0f) + 1e-6f);
#pragma unroll
        for (int n = 0; n < 2; ++n) {
            asm volatile("" ::: "memory");
            const int g0 = u.pn * 128 + wc * 32 + n * 16 + 4 * fq;
            const f32x4 bg = *(const f32x4*)(cb + g0), wg0 = *(const f32x4*)(cw + g0), wg1 = *(const f32x4*)(cw + 5632 + g0), wg2 = *(const f32x4*)(cw + 2 * 5632 + g0);
            const f32x4 bu = *(const f32x4*)(cb + 2816 + g0), wu0 = *(const f32x4*)(cw + 2816 + g0), wu1 = *(const f32x4*)(cw + 5632 + 2816 + g0), wu2 = *(const f32x4*)(cw + 2 * 5632 + 2816 + g0);
#pragma unroll
            for (int ai = 0; ai < 2; ++ai) {
                const int blk = u.pm * 4 + ai * 2 + wr;
                f32x4 pg1 = {0.f, 0.f, 0.f, 0.f}, pg2 = pg1, pu1 = pg1, pu2 = pg1;
#pragma unroll
                for (int m = 0; m < 4; ++m) {
                    const int r = u.pm * BM + ai * HALF + wr * 64 + m * 16 + fr;
                    const f32x4 ag = acc[ai][0][m][n] * rs[ai][m], au = acc[ai][1][m][n] * rs[ai][m];
                    if (m == 3 && fr >= 14) { float* h = hl + (size_t)(blk * 2 + (fr - 14)) * 5632 + g0; *(f32x4*)h = ag; *(f32x4*)(h + 2816) = au; }
                    if (m == 0 && fr < 2) { float* h = hf + (size_t)(blk * 2 + fr) * 5632 + g0; *(f32x4*)h = ag; *(f32x4*)(h + 2816) = au; }
                    f32x4 o;
                    { const f32x4 g1 = shfl4(ag, s1), g2 = shfl4(ag, s2);
                      const f32x4 p1g = fr >= 1 ? g1 : pg1, p2g = fr >= 2 ? g2 : pg2;
                      const f32x4 cg = bg + wg0 * p2g + wg1 * p1g + wg2 * ag;
                      o[0] = silu_f(cg[0]); o[1] = silu_f(cg[1]); o[2] = silu_f(cg[2]); o[3] = silu_f(cg[3]);
                      pg1 = g1; pg2 = g2; }
                    { const f32x4 u1 = shfl4(au, s1), u2 = shfl4(au, s2);
                      const f32x4 p1u = fr >= 1 ? u1 : pu1, p2u = fr >= 2 ? u2 : pu2;
                      const f32x4 cu = bu + wu0 * p2u + wu1 * p1u + wu2 * au;
                      o = o * cu;
                      pu1 = u1; pu2 = u2; }
                    st_bf16x4(gt + (size_t)r * 2816 + g0, o);
                }
            }
        }
    }
};

template <class Epi, class Sched, bool ALIGN_EPI = false, bool SP2 = false>
__device__ __forceinline__ void gemm_phase(PG8_LAS unsigned char* lds, const Gemm g, const Sched& S, const Epi& E) {
    int tid_ = threadIdx.x; asm volatile("" : "+v"(tid_));
    const int tid = tid_, wid = __builtin_amdgcn_readfirstlane(tid >> 6), lane = tid & 63, wr = wid >> 2, wc = wid & 3, fr = lane & 15, fq = lane >> 4;
    const int K = g.K, nt = K / BK;
    unsigned voffA[2], voffB[2];
#pragma unroll
    for (int i = 0; i < 2; ++i) { int R, C; stage_rc(tid * 16 + i * 8192, R, C); const int Rb = Epi::PERM ? ((R & ~31) + perm32(R & 31)) : R;
        voffA[i] = (unsigned)(R * K + C) * 2u; voffB[i] = (unsigned)(Rb * K + C) * 2u; }
    const size_t kstep = (size_t)(BK * 2);
    const size_t hstep = (size_t)HALF * K * 2;
    const size_t tstep = 2 * hstep;
    const unsigned ldsw = (unsigned)wid * 1024u;
    const int aoff = lds_byte(wr * 64 + fr, fq * 8), boff = lds_byte(wc * 32 + fr, fq * 8);
#define PG8_SA(b, h) (((b) * 2 + (h)) * HTB)
#define PG8_SB(b, h) ((4 + (b) * 2 + (h)) * HTB)
#define PG8_STAGE(bufoff, gbase, voff) do { _Pragma("unroll") for (int _i = 0; _i < 2; ++_i) \
        __builtin_amdgcn_global_load_lds((const unsigned*)((const char*)(gbase) + (voff)[_i]), (PG8_LAS unsigned*)(lds + (bufoff) + ldsw + _i * 8192), 16, 0, 0); } while (0)
#define PG8_LDA(dst, b, h) do { _Pragma("unroll") for (int m = 0; m < 4; ++m) _Pragma("unroll") for (int k = 0; k < 2; ++k) dst[m][k] = *(const PG8_LAS bf16x8*)(lds + PG8_SA(b, h) + aoff + m * 2048 + k * 1024); } while (0)
#define PG8_LDB(dst, b, h) do { _Pragma("unroll") for (int n = 0; n < 2; ++n) _Pragma("unroll") for (int k = 0; k < 2; ++k) dst[n][k] = *(const PG8_LAS bf16x8*)(lds + PG8_SB(b, h) + boff + n * 2048 + k * 1024); } while (0)
#define PG8_MMA(ai, bj, At, Bt) do { __builtin_amdgcn_s_setprio(1); _Pragma("unroll") for (int m = 0; m < 4; ++m) _Pragma("unroll") for (int n = 0; n < 2; ++n) _Pragma("unroll") for (int k = 0; k < 2; ++k) \
        acc[ai][bj][m][n] = __builtin_amdgcn_mfma_f32_16x16x32_bf16(Bt[n][k], At[m][k], acc[ai][bj][m][n], 0, 0, 0); __builtin_amdgcn_s_setprio(0); } while (0)
#define PG8_WAIT_V(n) asm volatile("s_waitcnt vmcnt(" #n ")" ::: "memory")
#define PG8_WAIT_L(n) asm volatile("s_waitcnt lgkmcnt(" #n ")" ::: "memory")
#define PG8_BAR __builtin_amdgcn_s_barrier()
#define PG8_SCHED __builtin_amdgcn_sched_barrier(0)
    Unit cur, nxt; int ui = 0;
    if (!S.next(0, cur)) return;
    f32x4 acc[2][2][4][2];
#pragma unroll
    for (int a = 0; a < 2; ++a)
#pragma unroll
        for (int b = 0; b < 2; ++b)
#pragma unroll
            for (int m = 0; m < 4; ++m)
#pragma unroll
                for (int n = 0; n < 2; ++n) acc[a][b][m][n] = (f32x4){0.f, 0.f, 0.f, 0.f};
    bf16x8 At[4][2], B0[2][2], B1[2][2];
    const char* cA = (const char*)g.A + (size_t)cur.pm * tstep; const char* cB = (const char*)g.Bt + (size_t)cur.pn * tstep;
    S.a_ready(cur);
    if constexpr (SP2) {
        PG8_STAGE(PG8_SB(0, 0), cB, voffB); PG8_STAGE(PG8_SB(0, 1), cB + hstep, voffB); PG8_STAGE(PG8_SA(0, 0), cA, voffA); PG8_STAGE(PG8_SA(0, 1), cA + hstep, voffA);
        if (wr == 1) PG8_BAR;
        PG8_WAIT_V(2); PG8_BAR;
        PG8_STAGE(PG8_SB(1, 0), cB + kstep, voffB); PG8_STAGE(PG8_SA(1, 0), cA + kstep, voffA); PG8_STAGE(PG8_SB(1, 1), cB + hstep + kstep, voffB);
        PG8_WAIT_V(6); PG8_BAR;
    } else {
        PG8_STAGE(PG8_SB(0, 0), cB, voffB); PG8_STAGE(PG8_SA(0, 0), cA, voffA); PG8_STAGE(PG8_SB(0, 1), cB + hstep, voffB); PG8_STAGE(PG8_SA(0, 1), cA + hstep, voffA);
        if (wr == 1) PG8_BAR;
        PG8_WAIT_V(4); PG8_BAR;
        PG8_STAGE(PG8_SB(1, 0), cB + kstep, voffB); PG8_STAGE(PG8_SA(1, 0), cA + kstep, voffA); PG8_STAGE(PG8_SB(1, 1), cB + hstep + kstep, voffB);
        PG8_WAIT_V(6); PG8_BAR;
    }
    for (;;) {
        const bool has_next = S.next(ui + 1, nxt);
        const char* nA = has_next ? (const char*)g.A + (size_t)nxt.pm * tstep : cA; const char* nB = has_next ? (const char*)g.Bt + (size_t)nxt.pn * tstep : cB;
        for (int t = 0; t < nt; t += 2) {
            const bool last = (t == nt - 2);
            const char* a1 = cA + (size_t)(t + 1) * kstep;
            const char* a2 = last ? nA : cA + (size_t)(t + 2) * kstep; const char* b2 = last ? nB : cB + (size_t)(t + 2) * kstep;
            const char* a3 = a2 + kstep; const char* b3 = b2 + kstep;
            if (last && has_next) S.a_ready(nxt);
            if constexpr (SP2) {
            PG8_LDB(B0, 0, 0); PG8_LDB(B1, 0, 1); PG8_SCHED; PG8_LDA(At, 0, 0); PG8_STAGE(PG8_SA(1, 1), a1 + hstep, voffA);
            PG8_WAIT_V(8); PG8_WAIT_L(0); PG8_BAR; PG8_MMA(0, 0, At, B0); PG8_MMA(0, 1, At, B1); PG8_BAR; PG8_SCHED;
            PG8_LDA(At, 0, 1); PG8_STAGE(PG8_SB(0, 0), b2, voffB); PG8_STAGE(PG8_SB(0, 1), b2 + hstep, voffB); PG8_STAGE(PG8_SA(0, 0), a2, voffA);
            PG8_WAIT_V(8); PG8_WAIT_L(0); PG8_BAR; PG8_MMA(1, 0, At, B0); PG8_MMA(1, 1, At, B1); PG8_BAR; PG8_SCHED;
            PG8_LDB(B0, 1, 0); PG8_LDB(B1, 1, 1); PG8_SCHED; PG8_LDA(At, 1, 0); PG8_STAGE(PG8_SA(0, 1), a2 + hstep, voffA);
            PG8_WAIT_V(8); PG8_WAIT_L(0); PG8_BAR; PG8_MMA(0, 0, At, B0); PG8_MMA(0, 1, At, B1); PG8_BAR; PG8_SCHED;
            PG8_LDA(At, 1, 1); PG8_STAGE(PG8_SB(1, 0), b3, voffB); PG8_STAGE(PG8_SB(1, 1), b3 + hstep, voffB); PG8_STAGE(PG8_SA(1, 0), a3, voffA);
            PG8_WAIT_V(8); PG8_WAIT_L(0); PG8_BAR; PG8_MMA(1, 0, At, B0); PG8_MMA(1, 1, At, B1); PG8_BAR; PG8_SCHED;
            } else {
            PG8_LDB(B0, 0, 0); PG8_SCHED; PG8_LDA(At, 0, 0); PG8_STAGE(PG8_SA(1, 1), a1 + hstep, voffA);
            PG8_WAIT_L(8); PG8_BAR; PG8_WAIT_L(0); PG8_MMA(0, 0, At, B0); PG8_BAR; PG8_SCHED;
            PG8_LDB(B1, 0, 1); PG8_STAGE(PG8_SB(0, 0), b2, voffB);
            PG8_BAR; PG8_WAIT_L(0); PG8_MMA(0, 1, At, B1); PG8_BAR;
            PG8_LDA(At, 0, 1); PG8_STAGE(PG8_SA(0, 0), a2, voffA);
            PG8_BAR; PG8_WAIT_L(0); PG8_MMA(1, 0, At, B0); PG8_BAR; PG8_SCHED;
            PG8_STAGE(PG8_SB(0, 1), b2 + hstep, voffB);
            PG8_WAIT_V(6); PG8_BAR; PG8_MMA(1, 1, At, B1); PG8_BAR;
            PG8_LDB(B0, 1, 0); PG8_SCHED; PG8_LDA(At, 1, 0); PG8_STAGE(PG8_SA(0, 1), a2 + hstep, voffA);
            PG8_WAIT_L(8); PG8_BAR; PG8_WAIT_L(0); PG8_MMA(0, 0, At, B0); PG8_BAR; PG8_SCHED;
            PG8_LDB(B1, 1, 1); PG8_STAGE(PG8_SB(1, 0), b3, voffB);
            PG8_BAR; PG8_WAIT_L(0); PG8_MMA(0, 1, At, B1); PG8_BAR;
            PG8_LDA(At, 1, 1); PG8_STAGE(PG8_SA(1, 0), a3, voffA);
            PG8_BAR; PG8_WAIT_L(0); PG8_MMA(1, 0, At, B0); PG8_BAR; PG8_SCHED;
            PG8_STAGE(PG8_SB(1, 1), b3 + hstep, voffB);
            PG8_WAIT_V(6); PG8_BAR; PG8_MMA(1, 1, At, B1); PG8_BAR;
            }
        }
        if constexpr (ALIGN_EPI) { if (wr == 0) PG8_BAR; }
        if constexpr (!Epi::AFTER_DRAIN) { E(acc, cur, wr, wc, fr, fq); S.done(cur); }
        if (!has_next) break;
#pragma unroll
        for (int a = 0; a < 2; ++a)
#pragma unroll
            for (int b = 0; b < 2; ++b)
#pragma unroll
                for (int m = 0; m < 4; ++m)
#pragma unroll
                    for (int n = 0; n < 2; ++n) acc[a][b][m][n] = (f32x4){0.f, 0.f, 0.f, 0.f};
        cur = nxt; cA = nA; cB = nB; ++ui;
        if constexpr (ALIGN_EPI) { if (wr == 1) PG8_BAR; }
    }
    PG8_WAIT_V(0);
    if constexpr (!ALIGN_EPI) { if (wr == 0) PG8_BAR; }
    PG8_BAR;
    if constexpr (Epi::AFTER_DRAIN) { E.fused(acc, cur, wr, wc, fr, fq, lds, wid, lane); S.done(cur); }
#undef PG8_SA
#undef PG8_SB
#undef PG8_STAGE
#undef PG8_LDA
#undef PG8_LDB
#undef PG8_MMA
#undef PG8_WAIT_V
#undef PG8_WAIT_L
#undef PG8_BAR
#undef PG8_SCHED
}
}
#define GAS __attribute__((address_space(1)))
#define LAS __attribute__((address_space(3)))
typedef unsigned short bf16;
typedef unsigned v4u __attribute__((ext_vector_type(4)));
typedef float f32x4 __attribute__((ext_vector_type(4)));
typedef short bf16x8 __attribute__((ext_vector_type(8)));
typedef GAS unsigned gu32;
typedef GAS unsigned long long gu64;
#define RLX_AGENT __ATOMIC_RELAXED, __HIP_MEMORY_SCOPE_AGENT
#define LDS_WAIT() asm volatile("s_waitcnt lgkmcnt(0)" ::: "memory")
#define VM_WAIT() asm volatile("s_waitcnt vmcnt(0)" ::: "memory")
__device__ __forceinline__ unsigned long long rt() { return __builtin_amdgcn_s_memrealtime(); }
__device__ __forceinline__ unsigned f2bf(float f) { unsigned u = __builtin_bit_cast(unsigned, f); return (u + 0x7fffu + ((u >> 16) & 1u)) >> 16; }
__device__ __forceinline__ unsigned pk2(float lo, float hi) { return f2bf(lo) | (f2bf(hi) << 16); }

#define XB_TMO      128
#define XB_XCNT(j)  (256  + 64 * (j))
#define XB_XSUB(j)  (1280 + 64 * (j))
#define XB_XGEN(j)  (2304 + 64 * (j))
#define XB_TOP      3328
#define XB_TOPGEN   3392
#define XCD_BAR_WORDS 3456
#define XB_SPIN_CAP (1u << 18)

__device__ __forceinline__ unsigned xb_ld(unsigned* p)              { return __hip_atomic_load(p, __ATOMIC_RELAXED, __HIP_MEMORY_SCOPE_AGENT); }
__device__ __forceinline__ unsigned xb_add(unsigned* p, unsigned v) { return __hip_atomic_fetch_add(p, v, __ATOMIC_RELAXED, __HIP_MEMORY_SCOPE_AGENT); }
__device__ __forceinline__ unsigned xb_xcc_id() { return (unsigned)__builtin_amdgcn_s_getreg((3 << 11) | 20) & 0xFu; }
#define XB_SPIN(cond, bar) do { unsigned _sp = 0; while (cond) { __builtin_amdgcn_s_sleep(1); \
    if ((++_sp & 255u) == 0u) { if (xb_ld(&(bar)[XB_TMO])) break; if (_sp > XB_SPIN_CAP) { atomicAdd(&(bar)[XB_TMO], 1u); break; } } } } while (0)

struct XcdBarrier {
    unsigned* bar; unsigned x;
    volatile LAS unsigned* st;
};

__device__ __forceinline__ XcdBarrier xcd_barrier_post(unsigned* bar, volatile LAS unsigned* st) {
    XcdBarrier b; b.bar = bar; b.x = xb_xcc_id(); b.st = st;
    if (threadIdx.x == 0) (void)xb_add(&bar[XB_XCNT(b.x)], 1u);
    return b;
}
__device__ __forceinline__ void xcd_barrier_complete(unsigned* bar, unsigned x, unsigned& nloc, unsigned& nx) {
    const unsigned G = gridDim.x * gridDim.y * gridDim.z;
    unsigned sum, cnt, mine, sp = 0u;
    for (;;) {
        sum = 0u; cnt = 0u; mine = 0u;
#pragma unroll
        for (unsigned j = 0; j < 16; ++j) { const unsigned c = xb_ld(&bar[XB_XCNT(j)]); sum += c; cnt += (c > 0u) ? 1u : 0u; mine = (j == x) ? c : mine; }
        if (sum == G) break;
        __builtin_amdgcn_s_sleep(1);
        if ((++sp & 255u) == 0u) { if (xb_ld(&bar[XB_TMO])) break; if (sp > XB_SPIN_CAP) { atomicAdd(&bar[XB_TMO], 1u); break; } }
    }
    nloc = mine > 0u ? mine : 1u; nx = cnt > 0u ? cnt : 1u;
}

__device__ __forceinline__ void xcd_barrier(const XcdBarrier& b) {
    asm volatile("s_waitcnt vmcnt(0)" ::: "memory");
    __syncthreads();
    if (threadIdx.x == 0) {
        unsigned* bar = b.bar;
        __builtin_amdgcn_s_waitcnt(0);
        unsigned nloc = b.st[0], nx = b.st[1];
        if (nloc == 0u) { xcd_barrier_complete(bar, b.x, nloc, nx); b.st[0] = nloc; b.st[1] = nx; }
        const unsigned old = xb_add(&bar[XB_XSUB(b.x)], 1u);
        const unsigned gen = old / nloc;
        if (old + 1u == (gen + 1u) * nloc) {
            __builtin_amdgcn_fence(__ATOMIC_RELEASE, "agent");
            asm volatile("s_waitcnt vmcnt(0)" ::: "memory");
            const unsigned og = xb_add(&bar[XB_TOP], 1u);
            const unsigned tg = og / nx;
            if (og + 1u == (tg + 1u) * nx) xb_add(&bar[XB_TOPGEN], 1u);
            else XB_SPIN(xb_ld(&bar[XB_TOPGEN]) == tg, bar);
            __builtin_amdgcn_fence(__ATOMIC_ACQUIRE, "agent");
            xb_add(&bar[XB_XGEN(b.x)], 1u);
            asm volatile("s_waitcnt vmcnt(0)" ::: "memory");
        } else {
            XB_SPIN(xb_ld(&bar[XB_XGEN(b.x)]) == gen, bar);
            __builtin_amdgcn_fence(__ATOMIC_ACQUIRE, "agent");
            asm volatile("s_waitcnt vmcnt(0)" ::: "memory");
        }
    }
    __syncthreads();
}

constexpr int NWAVES = 8, NTHR = 512;
constexpr int NB = 4, SEQ = 4096, M = NB * SEQ, DM = 1024;
constexpr int IN_W = 2516, NIN = 2560;
constexpr int DFF = 2816, DFF2 = 5632;
constexpr int NUNIT_GLA = NB * 4 * 64;

constexpr size_t MiB = 1u << 20;
constexpr size_t WS_CTL = 0, CTL_ZERO_BYTES = 1 * MiB;
constexpr size_t WS_ROPE = 1 * MiB;
constexpr size_t WS_SSQ = 2 * MiB;
constexpr size_t WS_WIN = 4 * MiB, WS_WO = 9 * MiB, WS_WUP0 = 11 * MiB, WS_WUP1 = 22 * MiB, WS_WDN0 = 33 * MiB, WS_WDN1 = 39 * MiB, WS_WUV = 45 * MiB, WS_WOUT = 49 * MiB;
constexpr size_t WS_XB = 51 * MiB;
constexpr size_t WS_R = 83 * MiB;
constexpr size_t R_GQ = WS_R, R_GK = R_GQ + 8 * MiB, R_GV = R_GK + 8 * MiB, R_GR = R_GV + 16 * MiB, R_BQ = R_GR + 16 * MiB, R_IQ = R_BQ + 16 * MiB, R_BK = R_IQ + 16 * MiB,
                 R_BV = R_BK + 2 * MiB, R_IK = R_BV + 2 * MiB, R_ALR = R_IK + 4 * MiB, R_IW = R_ALR + 1 * MiB, R_DS = R_IW + 1 * MiB, R_DEC = R_DS + 32 * MiB, R_IDX = R_DEC + 1 * MiB,
                 R_AO = R_IDX + 8 * MiB, R_END0 = R_AO + 32 * MiB;
constexpr size_t R_GT = WS_R, R_HL = R_GT + 88 * MiB, R_HF = R_HL + 11 * MiB, R_END1 = R_HF + 11 * MiB;
constexpr size_t R_Z = WS_R, R_SG = R_Z + 64 * MiB, R_END2 = R_SG + 32 * MiB;
constexpr size_t WS_END = 256 * MiB;
static_assert(R_END0 <= WS_END && R_END1 <= WS_END && R_END2 <= WS_END, "d_ws map");
constexpr int CW_BAR = 4096;

constexpr int RING_BYTES = 131072, LDS_BYTES = 147456, LDSCTL_OFF = LDS_BYTES - 512, MISC_OFF = LDSCTL_OFF;

typedef unsigned short bf16;
__device__ __forceinline__ float bf2f(unsigned short h) { return __builtin_bit_cast(float, (unsigned)h << 16); }
__device__ __forceinline__ float wave_sum(float v) {
#pragma unroll
    for (int o = 1; o < 64; o <<= 1) v += __shfl_xor(v, o);
    return v;
}
__device__ __forceinline__ float wave_max(float v) {
#pragma unroll
    for (int o = 1; o < 64; o <<= 1) v = fmaxf(v, __shfl_xor(v, o));
    return v;
}

struct Args { const float* in[20]; float* out; unsigned char* ws; int ph_lo, ph_hi; };

__device__ __forceinline__ int ropeperm(int p) { return p < 16 ? ((p >> 1) + 8 * (p & 1)) : p; }
__device__ __forceinline__ int win_src(int n) {
    if (n < 1536) return n;
    if (n < 2048) { const int c = n - 1536; return 1552 + (c & ~63) + ropeperm(c & 63); }
    if (n < 2304) { const int c = n - 2048; return 2192 + (c & ~63) + ropeperm(c & 63); }
    const int c = n - 2304;
    if (c < 64) return 2064 + ropeperm(c);
    if (c < 128) return 2128 + (c - 64);
    if (c < 192) return 2448 + ropeperm(c - 128);
    if (c < 208) return 1536 + (c - 192);
    if (c < 212) return 2512 + (c - 208);
    return -1;
}
__device__ __forceinline__ int up_src(int r) { const int pn = r >> 8, w = r & 255; return (w >> 7) * DFF + pn * 128 + (w & 127); }

__device__ __forceinline__ int ropeinv(int d) { return d < 16 ? (d < 8 ? 2 * d : 2 * (d - 8) + 1) : d; }
__device__ __forceinline__ int win_dst(int s) {
    if (s < 1536) return s;
    if (s < 1552) return 2304 + 192 + (s - 1536);
    if (s < 2064) { const int c = s - 1552; return 1536 + (c & ~63) + ropeinv(c & 63); }
    if (s < 2128) return 2304 + ropeinv(s - 2064);
    if (s < 2192) return 2304 + 64 + (s - 2128);
    if (s < 2448) { const int c = s - 2192; return 2048 + (c & ~63) + ropeinv(c & 63); }
    if (s < 2512) return 2304 + 128 + ropeinv(s - 2448);
    return 2304 + 208 + (s - 2512);
}
__device__ __forceinline__ int up_dst(int s) { const int bj = s >= DFF ? 1 : 0, rem = s - bj * DFF; return (rem >> 7) * 256 + bj * 128 + (rem & 127); }

typedef short v4i16p_t __attribute__((ext_vector_type(4)));
template <int MAP  >
__device__ __forceinline__ void transpose_item(const float* W, int K, int Nsrc, const float* g, bf16* WT, unsigned char* scr, int item, int lane) {
    const int nsb = (Nsrc + 63) >> 6, kb = item / nsb, sb = item % nsb, k0 = 64 * kb, s0 = 64 * sb;
    const int lr = lane >> 4, s4 = 4 * (lane & 15);
    const bool inb = s0 + s4 < Nsrc;
    f32x4 vv[16]; float gg[16];
    const float* wp = W + (size_t)(k0 + lr) * Nsrc + (inb ? s0 + s4 : 0);
#pragma unroll
    for (int i = 0; i < 16; ++i) { vv[i] = *(const f32x4*)(wp + (size_t)(4 * i) * Nsrc); gg[i] = g ? g[k0 + 4 * i + lr] : 1.0f; }
#pragma unroll
    for (int i = 0; i < 16; ++i) { const int kk = 4 * i + lr;
        const f32x4 v = inb ? vv[i] * gg[i] : (f32x4){0.f, 0.f, 0.f, 0.f};
        *(unsigned long long*)(scr + kk * 144 + s4 * 2) = (unsigned long long)pg8::cvt_pk_bf16(v[0], v[1]) | ((unsigned long long)pg8::cvt_pk_bf16(v[2], v[3]) << 32); }
    LDS_WAIT(); asm volatile("" ::: "memory");
    const int grp = lane >> 4, li = lane & 15;
#pragma unroll
    for (int j = 0; j < 8; ++j) { const int c = j, sblk = grp;
        const unsigned char* b = scr + (8 * c + (li >> 2)) * 144 + (16 * sblk + 4 * (li & 3)) * 2;
        const v4i16p_t a0 = __builtin_amdgcn_ds_read_tr16_b64_v4i16((LAS v4i16p_t*)(LAS unsigned char*)b), a1 = __builtin_amdgcn_ds_read_tr16_b64_v4i16((LAS v4i16p_t*)(LAS unsigned char*)(b + 4 * 144));
        const int s = s0 + 16 * sblk + li;
        if (s < Nsrc) { const int dst = MAP == 0 ? s : (MAP == 1 ? win_dst(s) : up_dst(s));
            v4u o; o.x = (unsigned)(unsigned short)a0[0] | ((unsigned)(unsigned short)a0[1] << 16); o.y = (unsigned)(unsigned short)a0[2] | ((unsigned)(unsigned short)a0[3] << 16);
            o.z = (unsigned)(unsigned short)a1[0] | ((unsigned)(unsigned short)a1[1] << 16); o.w = (unsigned)(unsigned short)a1[2] | ((unsigned)(unsigned short)a1[3] << 16);
            *(v4u*)(WT + (size_t)dst * K + k0 + 8 * c) = o; } }
    LDS_WAIT(); asm volatile("" ::: "memory");
}

__device__ __forceinline__ void sincos_d(double a, float& c, float& s) {
    const double k = __builtin_rint(a * 0.15915494309189535);
    double r = a - k * 6.283185307179586; r -= k * 2.4492935982947064e-16;
    const double r2 = r * r;
    double sp = -1.0 / 51090942171709440000.0, cp = 1.0 / 1124000727777607680000.0;
    sp = sp * r2 + 1.0 / 121645100408832000.0;  cp = cp * r2 - 1.0 / 2432902008176640000.0;
    sp = sp * r2 - 1.0 / 355687428096000.0;     cp = cp * r2 + 1.0 / 6402373705728000.0;
    sp = sp * r2 + 1.0 / 1307674368000.0;       cp = cp * r2 - 1.0 / 20922789888000.0;
    sp = sp * r2 - 1.0 / 6227020800.0;          cp = cp * r2 + 1.0 / 87178291200.0;
    sp = sp * r2 + 1.0 / 39916800.0;            cp = cp * r2 - 1.0 / 479001600.0;
    sp = sp * r2 - 1.0 / 362880.0;              cp = cp * r2 + 1.0 / 3628800.0;
    sp = sp * r2 + 1.0 / 5040.0;                cp = cp * r2 - 1.0 / 40320.0;
    sp = sp * r2 - 1.0 / 120.0;                 cp = cp * r2 + 1.0 / 720.0;
    sp = sp * r2 + 1.0 / 6.0;                   cp = cp * r2 - 1.0 / 24.0;
    cp = cp * r2 + 0.5;
    s = (float)(r - r * r2 * sp); c = (float)(1.0 - r2 * cp);
}

__device__ __forceinline__ void p0_prologue(const Args& a, unsigned char* lds, int vcu, int G, int tid) {
    unsigned char* ws = a.ws;
    const int lane = tid & 63, wave = tid >> 6;
    unsigned char* scr = lds + wave * 9216;
    const int gw = vcu * NWAVES + wave, NGW = G * NWAVES;
    constexpr int I_WIN = 16 * ((IN_W + 63) / 64), I_WO = 16 * 16, I_WUP = 16 * (DFF2 / 64), I_WDN = (DFF / 64) * 16, I_WUV = 16 * 32, I_WOUT = 16 * 16;
    constexpr int NITEMS = I_WIN + I_WO + 2 * I_WUP + 2 * I_WDN + I_WUV + I_WOUT;
    for (int it = gw; it < NITEMS; it += NGW) {
        int r = it;
        if (r < I_WIN) { transpose_item<1>(a.in[2], 1024, IN_W, a.in[1], (bf16*)(ws + WS_WIN), scr, r, lane); continue; } r -= I_WIN;
        if (r < I_WO) { transpose_item<0>(a.in[6], 1024, 1024, nullptr, (bf16*)(ws + WS_WO), scr, r, lane); continue; } r -= I_WO;
        if (r < I_WUP) { transpose_item<2>(a.in[15], 1024, DFF2, a.in[14], (bf16*)(ws + WS_WUP0), scr, r, lane); continue; } r -= I_WUP;
        if (r < I_WUP) { transpose_item<2>(a.in[15] + (size_t)1024 * DFF2, 1024, DFF2, a.in[14] + 1024, (bf16*)(ws + WS_WUP1), scr, r, lane); continue; } r -= I_WUP;
        if (r < I_WDN) { transpose_item<0>(a.in[18], DFF, 1024, nullptr, (bf16*)(ws + WS_WDN0), scr, r, lane); continue; } r -= I_WDN;
        if (r < I_WDN) { transpose_item<0>(a.in[18] + (size_t)DFF * 1024, DFF, 1024, nullptr, (bf16*)(ws + WS_WDN1), scr, r, lane); continue; } r -= I_WDN;
        if (r < I_WUV) { transpose_item<0>(a.in[8], 1024, 2048, a.in[7], (bf16*)(ws + WS_WUV), scr, r, lane); continue; } r -= I_WUV;
        transpose_item<0>(a.in[13], 1024, 1024, nullptr, (bf16*)(ws + WS_WOUT), scr, r, lane);
    }
    { const int gt0 = vcu * NTHR + tid; v4u* zp = (v4u*)((bf16*)(ws + WS_WIN) + (size_t)(2304 + 212) * 1024);
      for (int i = gt0; i < 44 * 1024 / 8; i += G * NTHR) zp[i] = (v4u){0u, 0u, 0u, 0u}; }
    float* ssq = (float*)(ws + WS_SSQ);
    bf16* xb = (bf16*)(ws + WS_XB);
    for (int m = gw; m < M; m += NGW) {
        const f32x4* xr = (const f32x4*)(a.in[0] + (size_t)m * DM) + lane;
        unsigned long long* o8 = (unsigned long long*)(xb + (size_t)m * DM) + lane;
        float s = 0.f;
#pragma unroll
        for (int j = 0; j < 4; ++j) { const f32x4 v = xr[64 * j]; s += (v.x * v.x + v.y * v.y) + (v.z * v.z + v.w * v.w);
            o8[64 * j] = (unsigned long long)pk2(v.x, v.y) | ((unsigned long long)pk2(v.z, v.w) << 32); }
        s = wave_sum(s);
        if (lane == 0) ssq[m] = s;
    }
    const int gt = vcu * NTHR + tid, NGT = G * NTHR;
    for (int i = gt; i < 6 * M; i += NGT) ssq[M + i] = 0.f;
    float* rope = (float*)(ws + WS_ROPE);
    for (int i = gt; i < SEQ * 8; i += NGT) {
        const int t = i >> 3, j = i & 7;
        const double inv = j == 0 ? 1.0 : j == 1 ? 0.19392274474868576 : j == 2 ? 0.03760603093086393 : j == 3 ? 0.007292664737217109 : j == 4 ? 0.001414213562373095
                         : j == 5 ? 0.0002742481756762073 : j == 6 ? 5.318295896944988e-05 : 1.031338537721246e-05;
        float c, s; sincos_d((double)t * inv, c, s);
        rope[2 * i] = c; rope[2 * i + 1] = s;
    }
}

__device__ __forceinline__ float logsigmoid_f(float z) { return fminf(z, 0.f) - 0.6931471805599453f * __builtin_amdgcn_logf(1.0f + __builtin_amdgcn_exp2f(-1.4426950408889634f * fabsf(z))); }
typedef short v4i16_t __attribute__((ext_vector_type(4)));
__device__ __forceinline__ v4i16_t tr16(const unsigned char* p) { return __builtin_amdgcn_ds_read_tr16_b64_v4i16((LAS v4i16_t*)(LAS unsigned char*)p); }
__device__ __forceinline__ bf16x8 frag_tr(const unsigned char* X, int RS, int rowA, int rowB, int col0, int fr, int fq) {
    const unsigned char* b = X + (4 * fq + (fr >> 2)) * RS + (col0 + 4 * (fr & 3)) * 2;
    const v4i16_t a0 = tr16(b + rowA * RS), a1 = tr16(b + rowB * RS);
    return (bf16x8){a0[0], a0[1], a0[2], a0[3], a1[0], a1[1], a1[2], a1[3]};
}
__device__ __forceinline__ bf16x8 frag_row_perm(const unsigned char* X, int RS, int row0, int colA, int colB, int fr, int fq) {
    const unsigned char* b = X + (row0 + fr) * RS + 8 * fq;
    const v4i16_t a0 = *(const v4i16_t*)(b + colA * 2), a1 = *(const v4i16_t*)(b + colB * 2);
    return (bf16x8){a0[0], a0[1], a0[2], a0[3], a1[0], a1[1], a1[2], a1[3]};
}
__device__ __forceinline__ bf16x8 frag_row(const unsigned char* X, int RS, int row0, int col0, int fr, int fq) { return *(const bf16x8*)(X + (row0 + fr) * RS + (col0 + 8 * fq) * 2); }

__device__ __forceinline__ void gla_cumdecay(float* bl, float* gt, const float* alr, const float* wa2, const float* ba, int row0, int h, int tid) {
    { const int c = tid >> 3, d0 = (tid & 7) * 8;
      float z[8];
#pragma unroll
      for (int j = 0; j < 8; ++j) z[j] = ba[h * 64 + d0 + j];
      const float* ar = alr + (size_t)(row0 + c) * 16;
#pragma unroll
      for (int r = 0; r < 16; ++r) { const float x = ar[r];
#pragma unroll
          for (int j = 0; j < 8; ++j) z[j] += x * wa2[r * 256 + h * 64 + d0 + j]; }
#pragma unroll
      for (int j = 0; j < 8; ++j) bl[c * 64 + d0 + j] = logsigmoid_f(z[j]) * (1.0f / 16.0f); }
    __syncthreads();
    const int d = tid & 63, g = tid >> 6;
    float v[8]; float s = 0.f;
#pragma unroll
    for (int j = 0; j < 8; ++j) { s += bl[(8 * g + j) * 64 + d]; v[j] = s; }
    gt[g * 64 + d] = s;
    __syncthreads();
    float off = 0.f;
#pragma unroll
    for (int g2 = 0; g2 < 7; ++g2) off += (g2 < g) ? gt[g2 * 64 + d] : 0.f;
#pragma unroll
    for (int j = 0; j < 8; ++j) bl[(8 * g + j) * 64 + d] = v[j] + off;
    __syncthreads();
}

constexpr int GL_BL = 0, GL_GT = 16384, GL_QD = 18432, GL_KD = 27648, GL_QB = 36864, GL_VV = 46080, GL_SS = 64512, GL_PART = 82944;
constexpr int GL_RS64 = 144, GL_RS128 = 288, GL_RSKL = 160;

__device__ __forceinline__ void gla_phase_a(const Args& a, unsigned char* lds, int vcu, int G, int tid) {
    unsigned char* ws = a.ws;
    float* bl = (float*)(lds + GL_BL); float* gt = (float*)(lds + GL_GT);
    unsigned char* kl = lds + GL_QD; unsigned char* vv = lds + GL_VV;
    const bf16* gk = (const bf16*)(ws + R_GK); const bf16* gv = (const bf16*)(ws + R_GV);
    const float* alr = (const float*)(ws + R_ALR);
    float* ds = (float*)(ws + R_DS); float* dec = (float*)(ws + R_DEC);
    const int lane = tid & 63, wave = tid >> 6, fr = lane & 15, fq = lane >> 4;
    for (int unit = vcu; unit < NUNIT_GLA; unit += G) {
        const int bb = unit >> 8, h = (unit >> 6) & 3, n = unit & 63, row0 = bb * SEQ + n * 64;
        gla_cumdecay(bl, gt, alr, a.in[3], a.in[4], row0, h, tid);
        { const int c = tid >> 3, sub = tid & 7, d0 = sub * 8, e0 = sub * 16;
          const v4u kw = *(const v4u*)(gk + (size_t)(row0 + c) * 256 + h * 64 + d0);
          float kf[8] = {__builtin_bit_cast(float, kw.x << 16), __builtin_bit_cast(float, kw.x & 0xffff0000u), __builtin_bit_cast(float, kw.y << 16), __builtin_bit_cast(float, kw.y & 0xffff0000u),
                         __builtin_bit_cast(float, kw.z << 16), __builtin_bit_cast(float, kw.z & 0xffff0000u), __builtin_bit_cast(float, kw.w << 16), __builtin_bit_cast(float, kw.w & 0xffff0000u)};
#pragma unroll
          for (int j = 0; j < 8; ++j) kf[j] *= __expf(bl[63 * 64 + d0 + j] - bl[c * 64 + d0 + j]);
          *(v4u*)(kl + c * GL_RSKL + d0 * 2) = (v4u){pk2(kf[0], kf[1]), pk2(kf[2], kf[3]), pk2(kf[4], kf[5]), pk2(kf[6], kf[7])};
          const v4u* vs = (const v4u*)(gv + (size_t)(row0 + c) * 512 + h * 128 + e0);
          *(v4u*)(vv + c * GL_RS128 + e0 * 2) = vs[0]; *(v4u*)(vv + c * GL_RS128 + e0 * 2 + 16) = vs[1]; }
        if (tid < 64) dec[unit * 64 + tid] = __expf(bl[63 * 64 + tid]);
        __syncthreads();
        { const bf16x8 va0 = frag_tr(vv, GL_RS128, 0, 16, wave * 16, fr, fq), va1 = frag_tr(vv, GL_RS128, 32, 48, wave * 16, fr, fq);
#pragma unroll
          for (int dtile = 0; dtile < 4; ++dtile) {
              const bf16x8 kb0 = frag_tr(kl, GL_RSKL, 0, 16, dtile * 16, fr, fq), kb1 = frag_tr(kl, GL_RSKL, 32, 48, dtile * 16, fr, fq);
              f32x4 acc = {0.f, 0.f, 0.f, 0.f};
              acc = __builtin_amdgcn_mfma_f32_16x16x32_bf16(va0, kb0, acc, 0, 0, 0);
              acc = __builtin_amdgcn_mfma_f32_16x16x32_bf16(va1, kb1, acc, 0, 0, 0);
              *(f32x4*)(ds + (size_t)unit * 8192 + (dtile * 16 + fr) * 128 + wave * 16 + 4 * fq) = acc;
          } }
        __syncthreads();
    }
}

__device__ __forceinline__ void gla_scan(const Args& a, int vcu, int G, int tid) {
    float* ds = (float*)(a.ws + R_DS); const float* dec = (const float*)(a.ws + R_DEC);
    for (int e = vcu * NTHR + tid; e < 16 * 8192; e += G * NTHR) {
        const int bh = e >> 13, de = e & 8191, d = de >> 7;
        float S = 0.f;
#pragma unroll 8
        for (int n = 0; n < 64; ++n) { const int unit = bh * 64 + n; float* p = ds + (size_t)unit * 8192 + de;
            const float t = *p; const float dc = dec[unit * 64 + d]; *p = S; S = dc * S + t; }
    }
}

__device__ __forceinline__ void gla_phase_b(const Args& a, unsigned char* lds, int vcu, int G, int tid) {
    unsigned char* ws = a.ws;
    float* bl = (float*)(lds + GL_BL); float* gt = (float*)(lds + GL_GT); float* part = (float*)(lds + GL_PART);
    unsigned char* qd = lds + GL_QD; unsigned char* kd = lds + GL_KD; unsigned char* qb = lds + GL_QB; unsigned char* vv = lds + GL_VV; unsigned char* ss = lds + GL_SS;
    const bf16* gq = (const bf16*)(ws + R_GQ); const bf16* gk = (const bf16*)(ws + R_GK); const bf16* gv = (const bf16*)(ws + R_GV); const bf16* gr = (const bf16*)(ws + R_GR);
    const float* alr = (const float*)(ws + R_ALR); const float* sp = (const float*)(ws + R_DS);
    bf16* ao = (bf16*)(ws + R_AO); const float* hg = a.in[5];
    const int lane = tid & 63, wave = tid >> 6, fr = lane & 15, fq = lane >> 4;
    const int Ti = wave & 3, eh = wave >> 2;
    for (int unit = vcu; unit < NUNIT_GLA; unit += G) {
        const int bb = unit >> 8, h = (unit >> 6) & 3, n = unit & 63, row0 = bb * SEQ + n * 64;
        gla_cumdecay(bl, gt, alr, a.in[3], a.in[4], row0, h, tid);
        { const int c = tid >> 3, sub = tid & 7, d0 = sub * 8, e0 = sub * 16;
          const v4u qw = *(const v4u*)(gq + (size_t)(row0 + c) * 256 + h * 64 + d0), kw = *(const v4u*)(gk + (size_t)(row0 + c) * 256 + h * 64 + d0);
          const unsigned qa[4] = {qw.x, qw.y, qw.z, qw.w}, ka[4] = {kw.x, kw.y, kw.z, kw.w};
          unsigned oqd[4], okd[4], oqb[4];
#pragma unroll
          for (int j = 0; j < 4; ++j) {
              const int d = d0 + 2 * j;
              const float b0 = bl[c * 64 + d], b1 = bl[c * 64 + d + 1], m0 = bl[32 * 64 + d], m1 = bl[32 * 64 + d + 1];
              const float q0 = __builtin_bit_cast(float, qa[j] << 16), q1 = __builtin_bit_cast(float, qa[j] & 0xffff0000u), k0 = __builtin_bit_cast(float, ka[j] << 16), k1 = __builtin_bit_cast(float, ka[j] & 0xffff0000u);
              oqd[j] = pk2(q0 * __expf(b0 - m0), q1 * __expf(b1 - m1)); okd[j] = pk2(k0 * __expf(m0 - b0), k1 * __expf(m1 - b1)); oqb[j] = pk2(q0 * __expf(b0), q1 * __expf(b1)); }
          *(v4u*)(qd + c * GL_RS64 + d0 * 2) = (v4u){oqd[0], oqd[1], oqd[2], oqd[3]};
          *(v4u*)(kd + c * GL_RS64 + d0 * 2) = (v4u){okd[0], okd[1], okd[2], okd[3]};
          *(v4u*)(qb + c * GL_RS64 + d0 * 2) = (v4u){oqb[0], oqb[1], oqb[2], oqb[3]};
          const v4u* vs = (const v4u*)(gv + (size_t)(row0 + c) * 512 + h * 128 + e0);
          *(v4u*)(vv + c * GL_RS128 + e0 * 2) = vs[0]; *(v4u*)(vv + c * GL_RS128 + e0 * 2 + 16) = vs[1];
          const f32x4* sr = (const f32x4*)(sp + (size_t)unit * 8192 + c * 128 + e0);
          const f32x4 s0 = sr[0], s1 = sr[1], s2 = sr[2], s3 = sr[3];
          *(v4u*)(ss + c * GL_RS128 + e0 * 2) = (v4u){pk2(s0[0], s0[1]), pk2(s0[2], s0[3]), pk2(s1[0], s1[1]), pk2(s1[2], s1[3])};
          *(v4u*)(ss + c * GL_RS128 + e0 * 2 + 16) = (v4u){pk2(s2[0], s2[1]), pk2(s2[2], s2[3]), pk2(s3[0], s3[1]), pk2(s3[2], s3[3])}; }
        __syncthreads();
        const bf16x8 qf0 = frag_row(qd, GL_RS64, Ti * 16, 0, fr, fq), qf1 = frag_row(qd, GL_RS64, Ti * 16, 32, fr, fq);
        f32x4 at[4];
#pragma unroll
        for (int Tj = 0; Tj < 4; ++Tj) {
            at[Tj] = (f32x4){0.f, 0.f, 0.f, 0.f};
            if (Tj <= Ti) {
                const bf16x8 kf0 = frag_row(kd, GL_RS64, Tj * 16, 0, fr, fq), kf1 = frag_row(kd, GL_RS64, Tj * 16, 32, fr, fq);
                at[Tj] = __builtin_amdgcn_mfma_f32_16x16x32_bf16(kf0, qf0, at[Tj], 0, 0, 0);
                at[Tj] = __builtin_amdgcn_mfma_f32_16x16x32_bf16(kf1, qf1, at[Tj], 0, 0, 0);
#pragma unroll
                for (int r = 0; r < 4; ++r) if (Tj * 16 + 4 * fq + r > Ti * 16 + fr) at[Tj][r] = 0.f;
            }
        }
        bf16x8 pf[2];
#pragma unroll
        for (int kk = 0; kk < 2; ++kk) { v4u w_;
            w_.x = pg8::cvt_pk_bf16(at[2 * kk][0], at[2 * kk][1]); w_.y = pg8::cvt_pk_bf16(at[2 * kk][2], at[2 * kk][3]);
            w_.z = pg8::cvt_pk_bf16(at[2 * kk + 1][0], at[2 * kk + 1][1]); w_.w = pg8::cvt_pk_bf16(at[2 * kk + 1][2], at[2 * kk + 1][3]);
            pf[kk] = __builtin_bit_cast(bf16x8, w_); }
        const bf16x8 qbf0 = frag_row_perm(qb, GL_RS64, Ti * 16, 0, 16, fr, fq), qbf1 = frag_row_perm(qb, GL_RS64, Ti * 16, 32, 48, fr, fq);
        f32x4 o[4]; float ssq = 0.f;
#pragma unroll
        for (int et = 0; et < 4; ++et) {
            const int ecol = eh * 64 + et * 16;
            f32x4 acc = {0.f, 0.f, 0.f, 0.f};
            acc = __builtin_amdgcn_mfma_f32_16x16x32_bf16(frag_tr(vv, GL_RS128, 0, 16, ecol, fr, fq), pf[0], acc, 0, 0, 0);
            if (Ti >= 2) acc = __builtin_amdgcn_mfma_f32_16x16x32_bf16(frag_tr(vv, GL_RS128, 32, 48, ecol, fr, fq), pf[1], acc, 0, 0, 0);
            acc = __builtin_amdgcn_mfma_f32_16x16x32_bf16(frag_tr(ss, GL_RS128, 0, 16, ecol, fr, fq), qbf0, acc, 0, 0, 0);
            acc = __builtin_amdgcn_mfma_f32_16x16x32_bf16(frag_tr(ss, GL_RS128, 32, 48, ecol, fr, fq), qbf1, acc, 0, 0, 0);
            o[et] = acc;
            ssq += (acc[0] * acc[0] + acc[1] * acc[1]) + (acc[2] * acc[2] + acc[3] * acc[3]);
        }
        ssq += __shfl_xor(ssq, 16); ssq += __shfl_xor(ssq, 32);
        if (fq == 0) part[wave * 16 + fr] = ssq;
        __syncthreads();
        { const float tot = part[wave * 16 + fr] + part[(wave ^ 4) * 16 + fr];
          const float rs = __builtin_amdgcn_rsqf(tot * (1.0f / 128.0f) + 1e-6f);
          const size_t row = (size_t)(row0 + Ti * 16 + fr);
#pragma unroll
          for (int et = 0; et < 4; ++et) {
              const int e = eh * 64 + et * 16 + 4 * fq;
              const unsigned long long gw2 = *(const unsigned long long*)(gr + row * 512 + h * 128 + e);
              const f32x4 hv = *(const f32x4*)(hg + e);
              f32x4 y;
              y[0] = o[et][0] * rs * hv[0] * pg8::silu_f(__builtin_bit_cast(float, (unsigned)(gw2 << 16)));
              y[1] = o[et][1] * rs * hv[1] * pg8::silu_f(__builtin_bit_cast(float, (unsigned)gw2 & 0xffff0000u));
              y[2] = o[et][2] * rs * hv[2] * pg8::silu_f(__builtin_bit_cast(float, (unsigned)(gw2 >> 32) << 16));
              y[3] = o[et][3] * rs * hv[3] * pg8::silu_f(__builtin_bit_cast(float, (unsigned)(gw2 >> 32) & 0xffff0000u));
              pg8::st_bf16x4(ao + row * 1024 + h * 128 + e, y);
          } }
        __syncthreads();
    }
}

__device__ __forceinline__ unsigned f2key(float f) { const unsigned u = __builtin_bit_cast(unsigned, f); return (u & 0x80000000u) ? ~u : (u | 0x80000000u); }

typedef float f32x16 __attribute__((ext_vector_type(16)));
__device__ __forceinline__ int wave_sum_i(int v) {
    v += __builtin_amdgcn_update_dpp(0, v, 0xB1, 0xf, 0xf, true);
    v += __builtin_amdgcn_update_dpp(0, v, 0x4E, 0xf, 0xf, true);
    v += __builtin_amdgcn_update_dpp(0, v, 0x141, 0xf, 0xf, true);
    v += __builtin_amdgcn_update_dpp(0, v, 0x140, 0xf, 0xf, true);
    return (__builtin_amdgcn_readlane(v, 0) + __builtin_amdgcn_readlane(v, 16)) + (__builtin_amdgcn_readlane(v, 32) + __builtin_amdgcn_readlane(v, 48));
}
__device__ __forceinline__ void sel_score(unsigned* sc, const bf16* iq, const bf16* ik, const float* iw, int bb, int t0, int lane_in, int wave) {
    int lane = lane_in; asm volatile("" : "+v"(lane));
    const int r32 = lane & 31, hh = lane >> 5;
    const size_t qrow0 = (size_t)bb * SEQ + t0;
    bf16x8 af[4];
#pragma unroll
    for (int ks = 0; ks < 4; ++ks) af[ks] = *(const bf16x8*)(iq + (qrow0 + (r32 >> 2)) * 256 + (r32 & 3) * 64 + ks * 16 + hh * 8);
    f32x4 w[4];
#pragma unroll
    for (int j = 0; j < 4; ++j) w[j] = *(const f32x4*)(iw + (qrow0 + 2 * j + hh) * 4);
    const int ntile = ((t0 + 7) >> 5) + 1;
    const bf16* ikb = ik + (size_t)bb * SEQ * 64 + lane * 8;
#define SEL_LOAD(dst, tb) do { _Pragma("unroll") for (int k_ = 0; k_ < 2; ++k_) { int tl_ = (tb) + 8 * k_; tl_ = tl_ > 127 ? 127 : tl_; \
        const bf16* kr_ = ikb + (size_t)tl_ * 2048; _Pragma("unroll") for (int ks = 0; ks < 4; ++ks) dst[k_][ks] = *(const bf16x8*)(kr_ + ks * 512); } } while (0)
#define SEL_COMP(src, tb) do { _Pragma("unroll") for (int k_ = 0; k_ < 2; ++k_) { const int tile_ = (tb) + 8 * k_; if (tile_ < ntile) { const int key_ = tile_ * 32 + r32; \
        f32x16 dd; _Pragma("unroll") for (int e = 0; e < 16; ++e) dd[e] = 0.f; \
        _Pragma("unroll") for (int ks = 0; ks < 4; ++ks) dd = __builtin_amdgcn_mfma_f32_32x32x16_bf16(af[ks], src[k_][ks], dd, 0, 0, 0); \
        _Pragma("unroll") for (int j = 0; j < 4; ++j) { \
            const float s_ = (w[j][0] * fmaxf(dd[4 * j], 0.f) + w[j][1] * fmaxf(dd[4 * j + 1], 0.f)) + (w[j][2] * fmaxf(dd[4 * j + 2], 0.f) + w[j][3] * fmaxf(dd[4 * j + 3], 0.f)) + 0.0f; \
            const int q_ = 2 * j + hh; const unsigned kv_ = f2key(s_); sc[q_ * 4096 + key_] = (key_ <= t0 + q_) ? kv_ : 0u; } } } } while (0)
    bf16x8 bufA[2][4], bufB[2][4];
    int tb = wave;
    SEL_LOAD(bufA, tb);
    for (;;) {
        SEL_LOAD(bufB, tb + 16);
        SEL_COMP(bufA, tb);
        tb += 16; if (tb >= ntile) break;
        SEL_LOAD(bufA, tb + 16);
        SEL_COMP(bufB, tb);
        tb += 16; if (tb >= ntile) break;
    }
#undef SEL_LOAD
#undef SEL_COMP
}
__device__ __forceinline__ void sel_pick(const unsigned (&u)[64], int ng, int ls, int wave, unsigned char* lds, unsigned short* out) {
#define CNT_GE4(a0, a1, a2, a3, v0, v1, v2, v3, thr) do { unsigned long long m0_, m1_, m2_, m3_; \
        asm volatile("v_cmp_ge_u32_e64 %4, %8, %12\n\tv_cmp_ge_u32_e64 %5, %9, %12\n\tv_cmp_ge_u32_e64 %6, %10, %12\n\tv_cmp_ge_u32_e64 %7, %11, %12\n\t" \
                     "v_addc_co_u32_e64 %0, %4, 0, %0, %4\n\tv_addc_co_u32_e64 %1, %5, 0, %1, %5\n\tv_addc_co_u32_e64 %2, %6, 0, %2, %6\n\tv_addc_co_u32_e64 %3, %7, 0, %3, %7" \
                     : "+v"(a0), "+v"(a1), "+v"(a2), "+v"(a3), "=&s"(m0_), "=&s"(m1_), "=&s"(m2_), "=&s"(m3_) : "v"(v0), "v"(v1), "v"(v2), "v"(v3), "v"(thr)); } while (0)
    unsigned T = 0u; int cT = 4096;
#define SEL_STEP(NG, bit_) do { unsigned cand = T | (1u << (bit_)); int c0 = 0, c1 = 0, c2 = 0, c3 = 0; \
        _Pragma("unroll") for (int g8 = 0; g8 < NG; ++g8) { const int j = 8 * g8; \
            CNT_GE4(c0, c1, c2, c3, u[j], u[j + 1], u[j + 2], u[j + 3], cand); CNT_GE4(c0, c1, c2, c3, u[j + 4], u[j + 5], u[j + 6], u[j + 7], cand); } \
        int v_ = (c0 + c1) + (c2 + c3); \
        v_ += __builtin_amdgcn_update_dpp(0, v_, 0xB1, 0xf, 0xf, true); v_ += __builtin_amdgcn_update_dpp(0, v_, 0x4E, 0xf, 0xf, true); \
        v_ += __builtin_amdgcn_update_dpp(0, v_, 0x141, 0xf, 0xf, true); v_ += __builtin_amdgcn_update_dpp(0, v_, 0x140, 0xf, 0xf, true); \
        { auto s_ = __builtin_amdgcn_permlane16_swap((unsigned)v_, (unsigned)v_, false, false); v_ = (int)(s_[0] + s_[1]); \
          auto t_ = __builtin_amdgcn_permlane32_swap((unsigned)v_, (unsigned)v_, false, false); v_ = (int)(t_[0] + t_[1]); } \
        const bool ge_ = v_ >= 256; T = ge_ ? cand : T; cT = ge_ ? v_ : cT; } while (0)
#define SEL_LOOP(NG) do { _Pragma("unroll 1") for (int bit = 31; bit >= 1; bit -= 2) { SEL_STEP(NG, bit); SEL_STEP(NG, bit - 1); \
        if (__builtin_amdgcn_readfirstlane(cT) == 256) break; } } while (0)
    switch (ng) { case 1: SEL_LOOP(1); break; case 2: SEL_LOOP(2); break; case 3: SEL_LOOP(3); break; case 4: SEL_LOOP(4); break;
                  case 5: SEL_LOOP(5); break; case 6: SEL_LOOP(6); break; case 7: SEL_LOOP(7); break; default: SEL_LOOP(8); break; }
    cT = __builtin_amdgcn_readfirstlane(cT); T = __builtin_amdgcn_readfirstlane(T);
#undef SEL_LOOP
#undef SEL_STEP
#undef CNT_GE4
    unsigned short* lst = (unsigned short*)(lds + 131072) + wave * 512;
    if (cT == 256) {
        unsigned wlo = 0u, whi = 0u;
#pragma unroll
        for (int j = 0; j < 64; ++j) if ((j >> 3) < ng) { const unsigned long long m_ = __ballot(u[j] >= T);
            wlo = (ls == j) ? (unsigned)m_ : wlo; whi = (ls == j) ? (unsigned)(m_ >> 32) : whi; }
        const int cl = __popc(wlo) + __popc(whi);
        int inc = cl;
        inc += __builtin_amdgcn_update_dpp(0, inc, 0x111, 0xf, 0xf, true); inc += __builtin_amdgcn_update_dpp(0, inc, 0x112, 0xf, 0xf, true);
        inc += __builtin_amdgcn_update_dpp(0, inc, 0x114, 0xf, 0xf, true); inc += __builtin_amdgcn_update_dpp(0, inc, 0x118, 0xf, 0xf, true);
        inc += __builtin_amdgcn_update_dpp(0, inc, 0x142, 0xa, 0xf, false); inc += __builtin_amdgcn_update_dpp(0, inc, 0x143, 0xc, 0xf, false);
        int off = inc - cl;
        while (__any((wlo | whi) != 0u)) {
            const bool has = (wlo | whi) != 0u;
            const int b_ = wlo ? __builtin_ctz(wlo) : 32 + __builtin_ctz(whi | 0x80000000u * (whi == 0u));
            lst[has ? off : 256 + ls] = (unsigned short)(ls * 64 + b_);
            off += has ? 1 : 0;
            if (wlo) wlo &= wlo - 1u; else whi &= whi - 1u;
        }
    } else {
        int ngt = 0;
#pragma unroll
        for (int j = 0; j < 64; ++j) if ((j >> 3) < ng) ngt += __popcll(__ballot(u[j] > T));
        const int need = 256 - ngt;
        const unsigned long long lt = (1ull << ls) - 1ull;
        int base = 0, eqt = 0;
#pragma unroll
        for (int j = 0; j < 64; ++j) if ((j >> 3) < ng) {
            const bool eq = (u[j] == T);
            const unsigned long long me = __ballot(eq);
            const bool take = (u[j] > T) || (eq && (eqt + __popcll(me & lt) < need));
            const unsigned long long mf = __ballot(take);
            lst[take ? base + __popcll(mf & lt) : 256 + ls] = (unsigned short)(j * 64 + ls);
            base += __popcll(mf); eqt += __popcll(me);
        }
    }
    LDS_WAIT(); asm volatile("" ::: "memory");
    *(unsigned long long*)(out + 4 * ls) = *(const unsigned long long*)(lst + 4 * ls);
}
__device__ __forceinline__ void dsa_select(const Args& a, unsigned char* lds, int vcu, int G, int tid) {
    unsigned char* ws = a.ws;
    const int lane0 = tid & 63, wave = __builtin_amdgcn_readfirstlane(tid >> 6);
    unsigned* sc = (unsigned*)lds;
    const bf16* iq = (const bf16*)(ws + R_IQ); const bf16* ik = (const bf16*)(ws + R_IK); const float* iw = (const float*)(ws + R_IW);
    unsigned short* idx = (unsigned short*)(ws + R_IDX);
    const int ngrp = vcu < 1024 ? 2 * ((1024 - vcu + G - 1) / G) : 0;
#define GRP(j, bb_, t0_) const int p_ = vcu + ((j) >> 1) * G; const int bb_ = p_ >> 8, x_ = p_ & 255, t0_ = (((j) & 1) ? (511 - x_) : x_) * 8
    if (ngrp > 0) { GRP(0, bb0, t00); if (t00 >= 256) sel_score(sc, iq, ik, iw, bb0, t00, lane0, wave); }
    __syncthreads();
#pragma unroll 1
    for (int j = 0; j < ngrp; ++j) {
        GRP(j, bb, t0);
        const int t = t0 + wave;
        unsigned short* out = idx + ((size_t)bb * SEQ + t) * 256;
        int ls = lane0; asm volatile("" : "+v"(ls));
        const bool trivial = t0 < 256;
        const int ng = __builtin_amdgcn_readfirstlane(((t >> 6) + 8) >> 3);
        unsigned u[64];
        if (!trivial) {
            const unsigned* scq = sc + wave * 4096;
            const int tl = t - ls;
#pragma unroll
            for (int g8 = 0; g8 < 8; ++g8) {
                if (g8 < ng) {
#pragma unroll
                    for (int jj = 8 * g8; jj < 8 * g8 + 8; ++jj) { const unsigned v_ = scq[jj * 64 + ls]; u[jj] = (jj * 64 <= tl) ? v_ : 0u; }
                } else {
#pragma unroll
                    for (int jj = 8 * g8; jj < 8 * g8 + 8; ++jj) u[jj] = 0u;
                }
            }
        } else {
#pragma unroll
            for (int jj = 0; jj < 64; ++jj) u[jj] = 0u;
        }
        LDS_WAIT();
        __syncthreads();
#pragma unroll 1
        for (int step = 0; step < 2; ++step) {
            if ((step == 0) == (wave < 4)) {
                if (trivial) {
#pragma unroll
                    for (int q4 = 0; q4 < 4; ++q4) { const int kk = q4 * 64 + ls; out[kk] = (unsigned short)(kk <= t ? kk : 0xFFFF); }
                } else sel_pick(u, ng, ls, wave, lds, out);
            } else if (j + 1 < ngrp) {
                GRP(j + 1, bbn, t0n);
                if (t0n >= 256) sel_score(sc, iq, ik, iw, bbn, t0n, lane0, wave);
            }
        }
        __syncthreads();
    }
#undef GRP
}

__device__ __forceinline__ void dsa_attend(const Args& a, unsigned char* lds, int vcu, int G, int tid) {
    unsigned char* ws = a.ws;
    const int lane0 = tid & 63, wave = __builtin_amdgcn_readfirstlane(tid >> 6);
    unsigned char* wl = lds + wave * 12288;
    int* kl = (int*)(wl + 10240);
    const bf16* bq = (const bf16*)(ws + R_BQ); const bf16* bk = (const bf16*)(ws + R_BK); const bf16* bv = (const bf16*)(ws + R_BV);
    const unsigned short* idx = (const unsigned short*)(ws + R_IDX);
    bf16* ao = (bf16*)(ws + R_AO);
    const int gw = vcu * NWAVES + wave, NGW = G * NWAVES;
    const int nq = 2 * ((M / 2 - gw + NGW - 1) / NGW);
    unsigned long long nw4; bf16x8 nqf0, nqf1;
#define ATT_Q(i, bb_, t_) const int p_ = gw + ((i) >> 1) * NGW; const int bb_ = p_ >> 11, x_ = p_ & 2047, t_ = ((i) & 1) ? (SEQ - 1 - x_) : x_
    { ATT_Q(0, bb0, t0); const size_t q0 = (size_t)bb0 * SEQ + t0;
      nw4 = *(const unsigned long long*)(idx + q0 * 256 + 4 * lane0);
      nqf0 = *(const bf16x8*)(bq + q0 * 512 + (lane0 & 7) * 64 + (lane0 >> 4) * 8); nqf1 = *(const bf16x8*)(bq + q0 * 512 + (lane0 & 7) * 64 + 32 + (lane0 >> 4) * 8); }
#pragma unroll 1
    for (int i = 0; i < nq; ++i) {
        int lane = lane0; asm volatile("" : "+v"(lane));
        const int fr = lane & 15, fq = lane >> 4;
        ATT_Q(i, bb, t);
        const size_t q = (size_t)bb * SEQ + t;
        const int cnt = t < 255 ? t + 1 : 256;
        { const unsigned long long w4 = nw4;
          int k0 = (int)(w4 & 0xffffu), k1 = (int)((w4 >> 16) & 0xffffu), k2 = (int)((w4 >> 32) & 0xffffu), k3 = (int)(w4 >> 48);
          const int p0 = 4 * lane;
          k0 = p0 < cnt ? k0 : 0; k1 = p0 + 1 < cnt ? k1 : 0; k2 = p0 + 2 < cnt ? k2 : 0; k3 = p0 + 3 < cnt ? k3 : 0;
          *(v4u*)(kl + p0) = (v4u){(unsigned)k0, (unsigned)k1, (unsigned)k2, (unsigned)k3}; }
        const bf16x8 qf0 = nqf0, qf1 = nqf1;
        LDS_WAIT(); asm volatile("" ::: "memory");
        const bf16* bkb = bk + (size_t)bb * SEQ * 64 + fq * 8;
        const bf16* bvb = bv + (size_t)bb * SEQ * 64 + (lane & 7) * 8;
        bf16x8 kf[16][2];
#pragma unroll
        for (int T = 0; T < 16; ++T) { const bf16* kp = bkb + (size_t)kl[T * 16 + fr] * 64; kf[T][0] = *(const bf16x8*)kp; kf[T][1] = *(const bf16x8*)(kp + 32); }
        v4u vreg[8];
#pragma unroll
        for (int i2 = 0; i2 < 8; ++i2) vreg[i2] = *(const v4u*)(bvb + (size_t)kl[(lane >> 3) + 8 * i2] * 64);
        if (i + 1 < nq) { ATT_Q(i + 1, bbn, tn); const size_t qn = (size_t)bbn * SEQ + tn;
            nw4 = *(const unsigned long long*)(idx + qn * 256 + 4 * lane);
            nqf0 = *(const bf16x8*)(bq + qn * 512 + (fr & 7) * 64 + fq * 8); nqf1 = *(const bf16x8*)(bq + qn * 512 + (fr & 7) * 64 + 32 + fq * 8); }
        f32x4 s[16];
#pragma unroll
        for (int T = 0; T < 16; ++T) {
            f32x4 z = {0.f, 0.f, 0.f, 0.f};
            z = __builtin_amdgcn_mfma_f32_16x16x32_bf16(kf[T][0], qf0, z, 0, 0, 0);
            s[T] = __builtin_amdgcn_mfma_f32_16x16x32_bf16(kf[T][1], qf1, z, 0, 0, 0);
        }
        float mx = -INFINITY;
#pragma unroll
        for (int T = 0; T < 16; ++T)
#pragma unroll
            for (int r = 0; r < 4; ++r) { if (T * 16 + 4 * fq + r >= cnt) s[T][r] = -INFINITY; mx = fmaxf(mx, s[T][r]); }
        mx = fmaxf(mx, __shfl_xor(mx, 16)); mx = fmaxf(mx, __shfl_xor(mx, 32));
        float sum = 0.f;
#pragma unroll
        for (int T = 0; T < 16; ++T)
#pragma unroll
            for (int r = 0; r < 4; ++r) { const float pv = __expf(s[T][r] - mx); s[T][r] = pv; sum += pv; }
        sum += __shfl_xor(sum, 16); sum += __shfl_xor(sum, 32);
        const float inv = __builtin_amdgcn_rcpf(sum);
        bf16x8 pf[8];
#pragma unroll
        for (int kk = 0; kk < 8; ++kk) { v4u w_;
            w_.x = pg8::cvt_pk_bf16(s[2 * kk][0], s[2 * kk][1]); w_.y = pg8::cvt_pk_bf16(s[2 * kk][2], s[2 * kk][3]);
            w_.z = pg8::cvt_pk_bf16(s[2 * kk + 1][0], s[2 * kk + 1][1]); w_.w = pg8::cvt_pk_bf16(s[2 * kk + 1][2], s[2 * kk + 1][3]);
            pf[kk] = __builtin_bit_cast(bf16x8, w_); }
        f32x4 o[4];
#pragma unroll
        for (int dt = 0; dt < 4; ++dt) o[dt] = (f32x4){0.f, 0.f, 0.f, 0.f};
        const unsigned char* trb = wl + (4 * fq + (fr >> 2)) * 160 + (fr & 3) * 8;
#pragma unroll
        for (int c = 0; c < 4; ++c) {
#pragma unroll
            for (int i2 = 0; i2 < 8; ++i2) *(v4u*)(wl + ((lane >> 3) + 8 * i2) * 160 + (lane & 7) * 16) = vreg[i2];
            if (c < 3) {
#pragma unroll
                for (int i2 = 0; i2 < 8; ++i2) vreg[i2] = *(const v4u*)(bvb + (size_t)kl[64 * (c + 1) + (lane >> 3) + 8 * i2] * 64);
            }
            LDS_WAIT(); asm volatile("" ::: "memory");
#pragma unroll
            for (int k2 = 0; k2 < 2; ++k2)
#pragma unroll
                for (int dt = 0; dt < 4; ++dt) {
                    const v4i16_t a0 = tr16(trb + (2 * k2) * 16 * 160 + dt * 32), a1 = tr16(trb + (2 * k2 + 1) * 16 * 160 + dt * 32);
                    const bf16x8 vf = {a0[0], a0[1], a0[2], a0[3], a1[0], a1[1], a1[2], a1[3]};
                    o[dt] = __builtin_amdgcn_mfma_f32_16x16x32_bf16(vf, pf[2 * c + k2], o[dt], 0, 0, 0);
                }
            LDS_WAIT(); asm volatile("" ::: "memory");
        }
        if (fr < 8) {
#pragma unroll
            for (int dt = 0; dt < 4; ++dt) pg8::st_bf16x4(ao + q * 1024 + 512 + fr * 64 + dt * 16 + 4 * fq, o[dt] * inv);
        }
    }
#undef ATT_Q
}

__device__ __forceinline__ void ffn_fixup(const Args& a, int layer, int vcu, int G, int tid) {
    unsigned char* ws = a.ws;
    const float* hl = (const float*)(ws + R_HL); const float* hf = (const float*)(ws + R_HF);
    const float* cw = a.in[16] + (size_t)layer * 3 * DFF2; const float* cb = a.in[17] + (size_t)layer * DFF2;
    bf16* gt = (bf16*)(ws + R_GT);
    for (int it = vcu * NTHR + tid; it < 256 * 2 * (DFF / 4); it += G * NTHR) {
        const int cg = it % (DFF / 4), rr = (it / (DFF / 4)) & 1, blk = it / (2 * (DFF / 4));
        const int g0 = cg * 4; const bool bstart = (blk & 63) == 0;
        const f32x4 z4 = {0.f, 0.f, 0.f, 0.f};
        f32x4 a0g, a0u, a1g, a1u, a2g, a2u;
        { const float* h0 = hf + (size_t)(blk * 2 + rr) * DFF2 + g0; a0g = *(const f32x4*)h0; a0u = *(const f32x4*)(h0 + DFF); }
        if (rr == 1) {
            const float* h1 = hf + (size_t)(blk * 2) * DFF2 + g0; a1g = *(const f32x4*)h1; a1u = *(const f32x4*)(h1 + DFF);
            if (bstart) { a2g = z4; a2u = z4; } else { const float* h2 = hl + (size_t)((blk - 1) * 2 + 1) * DFF2 + g0; a2g = *(const f32x4*)h2; a2u = *(const f32x4*)(h2 + DFF); }
        } else {
            if (bstart) { a1g = z4; a1u = z4; a2g = z4; a2u = z4; }
            else { const float* h1 = hl + (size_t)((blk - 1) * 2 + 1) * DFF2 + g0; a1g = *(const f32x4*)h1; a1u = *(const f32x4*)(h1 + DFF);
                   const float* h2 = hl + (size_t)((blk - 1) * 2) * DFF2 + g0; a2g = *(const f32x4*)h2; a2u = *(const f32x4*)(h2 + DFF); }
        }
        const f32x4 cgv = *(const f32x4*)(cb + g0) + *(const f32x4*)(cw + g0) * a2g + *(const f32x4*)(cw + DFF2 + g0) * a1g + *(const f32x4*)(cw + 2 * DFF2 + g0) * a0g;
        const f32x4 cuv = *(const f32x4*)(cb + DFF + g0) + *(const f32x4*)(cw + DFF + g0) * a2u + *(const f32x4*)(cw + DFF2 + DFF + g0) * a1u + *(const f32x4*)(cw + 2 * DFF2 + DFF + g0) * a0u;
        f32x4 o; o[0] = pg8::silu_f(cgv[0]) * cuv[0]; o[1] = pg8::silu_f(cgv[1]) * cuv[1]; o[2] = pg8::silu_f(cgv[2]) * cuv[2]; o[3] = pg8::silu_f(cgv[3]) * cuv[3];
        pg8::st_bf16x4(gt + (size_t)(blk * 64 + rr) * DFF + g0, o);
    }
}

__device__ __forceinline__ void sgu_mix(const Args& a, unsigned char* lds, int vcu, int G, int tid) {
    unsigned char* ws = a.ws;
    constexpr int RSV = 288, RSW = 272;
    unsigned char* vn = lds;
    unsigned char* wl = lds + 128 * RSV;
    const bf16* z = (const bf16*)(ws + R_Z); bf16* sg = (bf16*)(ws + R_SG);
    const float* lns = (const float*)(ws + WS_SSQ) + 5 * M; const float* lnq = lns + M;
    const float* lg = a.in[9]; const float* lb = a.in[10]; const float* wsp = a.in[11]; const float* bs = a.in[12];
    const int lane = tid & 63, wave = tid >> 6, fr = lane & 15, fq = lane >> 4;
    int gcur = -1;
    for (int unit = vcu; unit < 1024; unit += G) {
        const int g = unit & 7, ci = unit >> 3, row0 = ci * 128;
        if (g != gcur) {
            gcur = g;
            const int t = tid >> 2, s0 = (tid & 3) * 32;
            const f32x4* wr = (const f32x4*)(wsp + ((size_t)g * 128 + t) * 128 + s0);
#pragma unroll
            for (int j = 0; j < 4; ++j) { const f32x4 w0 = wr[2 * j], w1 = wr[2 * j + 1]; const int s = s0 + 8 * j;
                *(v4u*)(wl + t * RSW + s * 2) = (v4u){pk2(s <= t ? w0[0] : 0.f, s + 1 <= t ? w0[1] : 0.f), pk2(s + 2 <= t ? w0[2] : 0.f, s + 3 <= t ? w0[3] : 0.f),
                                                     pk2(s + 4 <= t ? w1[0] : 0.f, s + 5 <= t ? w1[1] : 0.f), pk2(s + 6 <= t ? w1[2] : 0.f, s + 7 <= t ? w1[3] : 0.f)}; }
        }
        { const int s = tid >> 2, c0 = (tid & 3) * 32; const size_t row = (size_t)(row0 + s);
          const float mean = lns[row] * (1.0f / 1024.0f); const float var = lnq[row] * (1.0f / 1024.0f) - mean * mean; const float rstd = __builtin_amdgcn_rsqf(var + 1e-5f);
          const v4u* zr = (const v4u*)(z + row * 2048 + 1024 + g * 128 + c0);
#pragma unroll
          for (int j = 0; j < 4; ++j) { const v4u zw = zr[j]; const int c = g * 128 + c0 + 8 * j;
              const f32x4 g0 = *(const f32x4*)(lg + c), g1 = *(const f32x4*)(lg + c + 4), b0 = *(const f32x4*)(lb + c), b1 = *(const f32x4*)(lb + c + 4);
              const float v0 = (__builtin_bit_cast(float, zw.x << 16) - mean) * rstd * g0[0] + b0[0], v1 = (__builtin_bit_cast(float, zw.x & 0xffff0000u) - mean) * rstd * g0[1] + b0[1];
              const float v2 = (__builtin_bit_cast(float, zw.y << 16) - mean) * rstd * g0[2] + b0[2], v3 = (__builtin_bit_cast(float, zw.y & 0xffff0000u) - mean) * rstd * g0[3] + b0[3];
              const float v4 = (__builtin_bit_cast(float, zw.z << 16) - mean) * rstd * g1[0] + b1[0], v5 = (__builtin_bit_cast(float, zw.z & 0xffff0000u) - mean) * rstd * g1[1] + b1[1];
              const float v6 = (__builtin_bit_cast(float, zw.w << 16) - mean) * rstd * g1[2] + b1[2], v7 = (__builtin_bit_cast(float, zw.w & 0xffff0000u) - mean) * rstd * g1[3] + b1[3];
              *(v4u*)(vn + s * RSV + (c0 + 8 * j) * 2) = (v4u){pk2(v0, v1), pk2(v2, v3), pk2(v4, v5), pk2(v6, v7)}; } }
        __syncthreads();
        bf16x8 af[4];
#pragma unroll
        for (int ks = 0; ks < 4; ++ks) af[ks] = frag_tr(vn, RSV, 32 * ks, 32 * ks + 16, wave * 16, fr, fq);
#pragma unroll
        for (int Tt = 0; Tt < 8; ++Tt) {
            f32x4 acc = {0.f, 0.f, 0.f, 0.f};
#pragma unroll
            for (int ks = 0; ks <= Tt / 2; ++ks) acc = __builtin_amdgcn_mfma_f32_16x16x32_bf16(af[ks], frag_row_perm(wl, RSW, Tt * 16, 32 * ks, 32 * ks + 16, fr, fq), acc, 0, 0, 0);
            const int t = Tt * 16 + fr; const size_t row = (size_t)(row0 + t);
            const float bias = bs[g * 128 + t];
            const int col = g * 128 + wave * 16 + 4 * fq;
            const unsigned long long uw = *(const unsigned long long*)(z + row * 2048 + col);
            f32x4 o;
            o[0] = __builtin_bit_cast(float, (unsigned)(uw << 16)) * (acc[0] + bias); o[1] = __builtin_bit_cast(float, (unsigned)uw & 0xffff0000u) * (acc[1] + bias);
            o[2] = __builtin_bit_cast(float, (unsigned)(uw >> 32) << 16) * (acc[2] + bias); o[3] = __builtin_bit_cast(float, (unsigned)(uw >> 32) & 0xffff0000u) * (acc[3] + bias);
            pg8::st_bf16x4(sg + row * 1024 + col, o);
        }
        __syncthreads();
    }
}

__device__ __forceinline__ void final_norm(const Args& a, int vcu, int G, int tid) {
    const int lane = tid & 63, wave = tid >> 6;
    const float* g = a.in[19];
    const bf16* xb = (const bf16*)(a.ws + WS_XB); const float* ssq4 = (const float*)(a.ws + WS_SSQ) + 4 * M;
    for (int m = vcu * NWAVES + wave; m < M; m += G * NWAVES) {
        const float rs = __builtin_amdgcn_rsqf(ssq4[m] * (1.0f / 1024.0f) + 1e-6f);
        const v4u* xr = (const v4u*)(xb + (size_t)m * DM) + lane;
        f32x4* orow = (f32x4*)(a.out + (size_t)m * DM);
#pragma unroll
        for (int j = 0; j < 2; ++j) { const v4u w = xr[64 * j]; const int c = (lane + 64 * j) * 8;
            const f32x4 g0 = *(const f32x4*)(g + c), g1 = *(const f32x4*)(g + c + 4);
            f32x4 o0, o1;
            o0[0] = __builtin_bit_cast(float, w.x << 16) * rs * g0[0]; o0[1] = __builtin_bit_cast(float, w.x & 0xffff0000u) * rs * g0[1];
            o0[2] = __builtin_bit_cast(float, w.y << 16) * rs * g0[2]; o0[3] = __builtin_bit_cast(float, w.y & 0xffff0000u) * rs * g0[3];
            o1[0] = __builtin_bit_cast(float, w.z << 16) * rs * g1[0]; o1[1] = __builtin_bit_cast(float, w.z & 0xffff0000u) * rs * g1[1];
            o1[2] = __builtin_bit_cast(float, w.w << 16) * rs * g1[2]; o1[3] = __builtin_bit_cast(float, w.w & 0xffff0000u) * rs * g1[3];
            orow[c / 4] = o0; orow[c / 4 + 1] = o1; }
    }
}

__device__ __forceinline__ int opq(int x) { asm volatile("" : "+s"(x)); return x; }
__device__ __forceinline__ int opqv(int x) { asm volatile("" : "+v"(x)); return x; }
constexpr int NPHASE = 16;
__global__ void __launch_bounds__(NTHR, 2) fwd_megakernel(Args args) {
    extern __shared__ __attribute__((aligned(16))) unsigned char lds[];
    const int tid = threadIdx.x;
    const int G = gridDim.x; const int bx = blockIdx.x;
    const int vcu = (G % 8 == 0) ? (bx % 8) * (G / 8) + bx / 8 : bx;
    unsigned char* ws = args.ws;
    for (int u = tid; u < (LDS_BYTES - LDSCTL_OFF) / 4; u += NTHR) ((LAS unsigned*)((LAS unsigned char*)lds + LDSCTL_OFF))[u] = 0u;
    __syncthreads();
    XcdBarrier bar; bar.bar = (unsigned*)(ws + WS_CTL) + CW_BAR; bar.x = 0; bar.st = nullptr;
    const int lo = args.ph_lo, hi = args.ph_hi;
    if (hi - lo > 1) bar = xcd_barrier_post((unsigned*)(ws + WS_CTL) + CW_BAR, (volatile LAS unsigned*)((LAS unsigned char*)lds + MISC_OFF) + 8);
#ifdef PHASE_MASK
#define IN(k) (((PHASE_MASK >> (k)) & 1) && lo <= (k) && (k) < hi)
#else
#define IN(k) (lo <= (k) && (k) < hi)
#endif
#define SEAM(k) do { if (IN(k) && IN((k) + 1)) xcd_barrier(bar); } while (0)
    LAS unsigned char* ring = (LAS unsigned char*)lds;
    float* ssq = (float*)(ws + WS_SSQ);
    bf16* xb = (bf16*)(ws + WS_XB);

    if (IN(0)) { p0_prologue(args, lds, opq(vcu), G, opqv(tid)); __syncthreads(); } SEAM(0);

    if (IN(1)) {
        pg8::Gemm g{xb, (const bf16*)(ws + WS_WIN), M, NIN, DM}; pg8::StaticOrder S; S.init(M, NIN, G, opq(bx));
        pg8::EpiIn E{ssq, (const float*)(ws + WS_ROPE), (bf16*)(ws + R_GQ), (bf16*)(ws + R_GK), (bf16*)(ws + R_GV), (bf16*)(ws + R_GR), (bf16*)(ws + R_BQ), (bf16*)(ws + R_BK), (bf16*)(ws + R_BV),
                      (bf16*)(ws + R_IQ), (bf16*)(ws + R_IK), (float*)(ws + R_ALR), (float*)(ws + R_IW)};
        pg8::gemm_phase<pg8::EpiIn, pg8::StaticOrder, true, true>(ring, g, S, E);
    } SEAM(1);

    if (IN(2)) { gla_phase_a(args, lds, opq(vcu), G, opqv(tid)); dsa_select(args, lds, opq(vcu), G, opqv(tid)); __syncthreads(); } SEAM(2);
    if (IN(3)) { gla_scan(args, opq(vcu), G, opqv(tid)); dsa_attend(args, lds, opq(vcu), G, opqv(tid)); __syncthreads(); } SEAM(3);
    if (IN(4)) { gla_phase_b(args, lds, opq(vcu), G, opqv(tid)); } SEAM(4);

    if (IN(5)) {
        pg8::Gemm g{(const bf16*)(ws + R_AO), (const bf16*)(ws + WS_WO), M, DM, DM}; pg8::StaticOrder S; S.init(M, DM, G, opq(bx));
        pg8::EpiRes E{xb, ssq + M};
        pg8::gemm_phase<pg8::EpiRes, pg8::StaticOrder, true, true>(ring, g, S, E);
    } SEAM(5);

#pragma unroll 1
    for (int layer = 0; layer < 2; ++layer) {
        const int pb = layer == 0 ? 6 : 12;
        if (IN(pb)) {
            pg8::Gemm g{xb, (const bf16*)(ws + (layer == 0 ? WS_WUP0 : WS_WUP1)), M, DFF2, DM}; pg8::StaticOrder S; S.init(M, DFF2, G, opq(bx));
            pg8::EpiConv E{ssq + (layer == 0 ? 1 : 3) * M, args.in[16] + (size_t)layer * 3 * DFF2, args.in[17] + (size_t)layer * DFF2, (bf16*)(ws + R_GT), (float*)(ws + R_HL), (float*)(ws + R_HF)};
            pg8::gemm_phase<pg8::EpiConv, pg8::StaticOrder, true, true>(ring, g, S, E);
        } SEAM(pb);
        if (IN(pb + 1)) { ffn_fixup(args, layer, opq(vcu), G, opqv(tid)); } SEAM(pb + 1);
        if (IN(pb + 2)) {
            pg8::Gemm g{(const bf16*)(ws + R_GT), (const bf16*)(ws + (layer == 0 ? WS_WDN0 : WS_WDN1)), M, DM, DFF}; pg8::StaticOrder S; S.init(M, DM, G, opq(bx));
            pg8::EpiRes E{xb, ssq + (layer == 0 ? 2 : 4) * M};
            pg8::gemm_phase<pg8::EpiRes, pg8::StaticOrder, true, true>(ring, g, S, E);
        } SEAM(pb + 2);
        if (layer == 0) {
            if (IN(9)) {
                pg8::Gemm g{xb, (const bf16*)(ws + WS_WUV), M, 2048, DM}; pg8::StaticOrder S; S.init(M, 2048, G, opq(bx));
                pg8::EpiSgu E{ssq + 2 * M, (bf16*)(ws + R_Z), ssq + 5 * M, ssq + 6 * M};
                pg8::gemm_phase<pg8::EpiSgu, pg8::StaticOrder, true, true>(ring, g, S, E);
            } SEAM(9);
            if (IN(10)) { sgu_mix(args, lds, opq(vcu), G, opqv(tid)); } SEAM(10);
            if (IN(11)) {
                pg8::Gemm g{(const bf16*)(ws + R_SG), (const bf16*)(ws + WS_WOUT), M, DM, DM}; pg8::StaticOrder S; S.init(M, DM, G, opq(bx));
                pg8::EpiRes E{xb, ssq + 3 * M};
                pg8::gemm_phase<pg8::EpiRes, pg8::StaticOrder, true, true>(ring, g, S, E);
            } SEAM(11);
        }
    }
    if (IN(15)) { final_norm(args, opq(vcu), G, opqv(tid)); }
#undef IN
#undef SEAM
}

extern "C" void kernel_launch(void* const* d_in, const int* in_sizes, int n_in, void* d_out, int out_size, void* d_ws, size_t ws_size, hipStream_t stream) {
    static int grid = 0;
    if (grid == 0) {
        if (n_in != 20 || out_size != M * DM || ws_size < WS_END) { fprintf(stderr, "kernel_launch: unexpected problem (n_in %d, out %d, ws %zu)\n", n_in, out_size, ws_size); grid = -1; return; }
        int dev = 0, cus = 0, per_cu = 0;
        if (hipGetDevice(&dev) != hipSuccess || hipDeviceGetAttribute(&cus, hipDeviceAttributeMultiprocessorCount, dev) != hipSuccess) { grid = -1; return; }
        if (hipFuncSetAttribute((const void*)fwd_megakernel, hipFuncAttributeMaxDynamicSharedMemorySize, LDS_BYTES) != hipSuccess) { fprintf(stderr, "kernel_launch: hipFuncSetAttribute failed\n"); grid = -1; return; }
        if (hipOccupancyMaxActiveBlocksPerMultiprocessor(&per_cu, (const void*)fwd_megakernel, NTHR, LDS_BYTES) != hipSuccess || per_cu < 1)
            fprintf(stderr, "kernel_launch: note: occupancy query reports %d workgroups per CU\n", per_cu);
        (void)hipGetLastError();
        grid = cus;
    }
    if (grid < 0) return;
    if (hipMemsetAsync((char*)d_ws + WS_CTL, 0, CTL_ZERO_BYTES, stream) != hipSuccess) { fprintf(stderr, "kernel_launch: hipMemsetAsync failed\n"); return; }
    Args a{};
    for (int i = 0; i < 20; ++i) a.in[i] = (const float*)d_in[i];
    a.out = (float*)d_out; a.ws = (unsigned char*)d_ws;
#if MK_MULTI
    for (int p = 0; p < NPHASE; ++p) { a.ph_lo = p; a.ph_hi = p + 1; hipLaunchKernelGGL(fwd_megakernel, dim3(grid), dim3(NTHR), LDS_BYTES, stream, a); }
#else
    a.ph_lo = 0; a.ph_hi = NPHASE;
    hipLaunchKernelGGL(fwd_megakernel, dim3(grid), dim3(NTHR), LDS_BYTES, stream, a);
#endif
    const hipError_t le = hipPeekAtLastError();
    if (le != hipSuccess) fprintf(stderr, "kernel_launch: launch failed: %s\n", hipGetErrorName(le));
}
```

```cpp
#include <hip/hip_runtime.h>
#include <cstdio>
#include <cstdint>

#ifndef MK_MULTI
#define MK_MULTI 0
#endif

namespace pg8 {
#define PG8_LAS __attribute__((address_space(3)))
typedef unsigned short bf16_t;
typedef short bf16x8 __attribute__((ext_vector_type(8)));
typedef float f32x4 __attribute__((ext_vector_type(4)));
typedef unsigned u32x4 __attribute__((ext_vector_type(4)));
constexpr int BM = 256, BK = 64, HALF = 128, HTB = HALF * BK * 2  , STAGE_BYTES = 8 * HTB, NXCD = 8, WGM = 8;

__host__ __device__ __forceinline__ int lds_byte(int r, int c) { const int st = (r >> 4) * 2 + (c >> 5), rr = r & 15, cc = c & 31, ob = rr * 64 + cc * 2; return st * 1024 + (ob ^ (((ob >> 9) & 1) << 5)); }
__host__ __device__ __forceinline__ void stage_rc(int b, int& R, int& C) { const int st = b / 1024, sb = b % 1024, swz = sb ^ (((sb >> 9) & 1) << 5); R = (st >> 1) * 16 + swz / 64; C = (st & 1) * 32 + (swz % 64) / 2; }
__host__ __device__ __forceinline__ int perm32(int rho) { const int n = rho >> 4, i = rho & 15; return 8 * (i >> 2) + 4 * n + (i & 3); }

struct Unit { int pm, pn; };
struct Gemm { const bf16_t* A; const bf16_t* Bt; int M, N, K; };

struct StaticOrder {
    int nM, nN, nwg, G, c;
    __host__ __device__ void init(int M, int N, int G_, int c_) { nM = M / BM; nN = N / BM; nwg = nM * nN; G = G_; c = c_; }
    __host__ __device__ bool next(int i, Unit& u) const {
        const long L = (long)i * G + c; if (L >= nwg) return false;
        int wgid = (int)L; { const int q = nwg / NXCD, r = nwg % NXCD, xcd = wgid % NXCD, off = wgid / NXCD; wgid = (xcd < r ? xcd * (q + 1) : r * (q + 1) + (xcd - r) * q) + off; }
        const int nig = WGM * nN, gid = wgid / nig, fm = gid * WGM, gsz = (nM - fm) < WGM ? (nM - fm) : WGM;
        u.pm = fm + ((wgid % nig) % gsz); u.pn = (wgid % nig) / gsz; return true;
    }
    __device__ __forceinline__ void a_ready(const Unit&) const {}
    __device__ __forceinline__ void done(const Unit&) const {}
};

__device__ __forceinline__ unsigned cvt_pk_bf16(float lo, float hi) { unsigned r; asm volatile("v_cvt_pk_bf16_f32 %0, %1, %2" : "=v"(r) : "v"(lo), "v"(hi)); return r; }
typedef float f32x2 __attribute__((ext_vector_type(2)));
typedef unsigned u32x2 __attribute__((ext_vector_type(2)));
__device__ __forceinline__ void st_bf16x4(bf16_t* p, f32x4 v) { u32x2 w; w.x = cvt_pk_bf16(v[0], v[1]); w.y = cvt_pk_bf16(v[2], v[3]); *(u32x2*)p = w; }
__device__ __forceinline__ float sigm(float x) { return __builtin_amdgcn_rcpf(1.0f + __builtin_amdgcn_exp2f(-1.4426950408889634f * x)); }
__device__ __forceinline__ float silu_f(float x) { return x * sigm(x); }
__device__ __forceinline__ float gelu_tanh_f(float x) { const float u = 0.7978845608028654f * (x + 0.044715f * x * x * x); return x * sigm(2.0f * u); }
__device__ __forceinline__ f32x4 shfl4(f32x4 v, int src) { f32x4 r; r[0] = __shfl(v[0], src); r[1] = __shfl(v[1], src); r[2] = __shfl(v[2], src); r[3] = __shfl(v[3], src); return r; }
__device__ __forceinline__ f32x4 rope4(f32x4 v, const float* tab_t, int fq) {
    const f32x4 cs = *(const f32x4*)(tab_t + 4 * fq);
    f32x4 o; o[0] = v[0] * cs[0] - v[1] * cs[1]; o[1] = v[1] * cs[0] + v[0] * cs[1]; o[2] = v[2] * cs[2] - v[3] * cs[3]; o[3] = v[3] * cs[2] + v[2] * cs[3]; return o;
}

struct EpiIn {
    static constexpr bool PERM = false, AFTER_DRAIN = false;
    const float* ssq; const float* rope;
    bf16_t *gq, *gk, *gv, *gr, *bq, *bk, *bv, *iq, *ik; float *alr, *iw;
    __device__ __forceinline__ void operator()(const f32x4 (&acc)[2][2][4][2], const Unit& u, int wr, int wc, int fr_in, int fq_in) const {
        int fr = fr_in, fq = fq_in; asm volatile("" : "+v"(fr), "+v"(fq));
        const int pn = u.pn;
        float rsv[2][4];
#pragma unroll
        for (int ai = 0; ai < 2; ++ai)
#pragma unroll
            for (int m = 0; m < 4; ++m) rsv[ai][m] = __builtin_amdgcn_rsqf(ssq[u.pm * BM + ai * HALF + wr * 64 + m * 16 + fr] * (1.0f / 1024.0f) + 1e-6f);
#pragma unroll
        for (int ai = 0; ai < 2; ++ai)
#pragma unroll
            for (int m = 0; m < 4; ++m) {
                const int r = u.pm * BM + ai * HALF + wr * 64 + m * 16 + fr;
                const float rs = rsv[ai][m];
                const float* tab_t = rope + (size_t)(r & 4095) * 16;
#pragma unroll
                for (int bj = 0; bj < 2; ++bj)
#pragma unroll
                    for (int n = 0; n < 2; ++n) {
                        f32x4 v = acc[ai][bj][m][n] * rs;
                        const int cl = bj * HALF + wc * 32 + n * 16 + 4 * fq;
                        const bool ropecol = ((wc & 1) == 0) && (n == 0);
                        if (pn == 0) { st_bf16x4(gq + (size_t)r * 256 + cl, v * 0.125f); }
                        else if (pn == 1) { st_bf16x4(gk + (size_t)r * 256 + cl, v); }
                        else if (pn < 4) { st_bf16x4(gv + (size_t)r * 512 + (pn - 2) * 256 + cl, v); }
                        else if (pn < 6) { st_bf16x4(gr + (size_t)r * 512 + (pn - 4) * 256 + cl, v); }
                        else if (pn < 8) { if (ropecol) v = rope4(v, tab_t, fq); st_bf16x4(bq + (size_t)r * 512 + (pn - 6) * 256 + cl, v * 0.125f); }
                        else if (pn == 8) { if (ropecol) v = rope4(v, tab_t, fq); st_bf16x4(iq + (size_t)r * 256 + cl, v); }
                        else {
                            const int reg = bj * 2 + (wc >> 1);
                            const int c64 = cl & 63;
                            if (reg == 0) { if (ropecol) v = rope4(v, tab_t, fq); st_bf16x4(bk + (size_t)r * 64 + c64, v); }
                            else if (reg == 1) { st_bf16x4(bv + (size_t)r * 64 + c64, v); }
                            else if (reg == 2) { if (ropecol) v = rope4(v, tab_t, fq); const int key_ = r & 4095; st_bf16x4(ik + (size_t)(r >> 12) * (4096 * 64) + ((((key_ >> 5) * 4 + (c64 >> 4)) * 64 + ((c64 >> 3) & 1) * 32 + (key_ & 31)) * 8) + (c64 & 7), v); }
                            else if ((wc & 1) == 0) {
                                if (n == 0) *(f32x4*)(alr + (size_t)r * 16 + 4 * fq) = v;
                                else if (fq == 0) *(f32x4*)(iw + (size_t)r * 4) = v * 0.5f;
                            }
                        }
                    }
            }
    }
};

struct EpiRes {
    static constexpr bool PERM = false, AFTER_DRAIN = false;
    bf16_t* xb; float* ssq;
    __device__ __forceinline__ void operator()(const f32x4 (&acc)[2][2][4][2], const Unit& u, int wr, int wc, int fr_in, int fq_in) const {
        int fr = fr_in, fq = fq_in; asm volatile("" : "+v"(fr), "+v"(fq));
#pragma unroll
        for (int ai = 0; ai < 2; ++ai)
#pragma unroll
            for (int m = 0; m < 4; ++m) {
                const int r = u.pm * BM + ai * HALF + wr * 64 + m * 16 + fr;
                float s = 0.f;
#pragma unroll
                for (int bj = 0; bj < 2; ++bj)
#pragma unroll
                    for (int n = 0; n < 2; ++n) {
                        const size_t off = (size_t)r * 1024 + u.pn * BM + bj * HALF + wc * 32 + n * 16 + 4 * fq;
                        const u32x2 bw = *(const u32x2*)(xb + off);
                        f32x4 x = acc[ai][bj][m][n];
                        x[0] += __builtin_bit_cast(float, bw.x << 16); x[1] += __builtin_bit_cast(float, bw.x & 0xffff0000u);
                        x[2] += __builtin_bit_cast(float, bw.y << 16); x[3] += __builtin_bit_cast(float, bw.y & 0xffff0000u);
                        st_bf16x4(xb + off, x);
                        s += (x[0] * x[0] + x[1] * x[1]) + (x[2] * x[2] + x[3] * x[3]);
                    }
                s += __shfl_xor(s, 16); s += __shfl_xor(s, 32);
                if (fq == 0) atomicAdd(ssq + r, s);
            }
    }
};

struct EpiSgu {
    static constexpr bool PERM = false, AFTER_DRAIN = false;
    const float* ssq; bf16_t* z; float* lns; float* lnq;
    __device__ __forceinline__ void operator()(const f32x4 (&acc)[2][2][4][2], const Unit& u, int wr, int wc, int fr_in, int fq_in) const {
        int fr = fr_in, fq = fq_in; asm volatile("" : "+v"(fr), "+v"(fq));
        const bool vhalf = u.pn >= 4;
        float rsv[2][4];
#pragma unroll
        for (int ai = 0; ai < 2; ++ai)
#pragma unroll
            for (int m = 0; m < 4; ++m) rsv[ai][m] = __builtin_amdgcn_rsqf(ssq[u.pm * BM + ai * HALF + wr * 64 + m * 16 + fr] * (1.0f / 1024.0f) + 1e-6f);
#pragma unroll
        for (int ai = 0; ai < 2; ++ai)
#pragma unroll
            for (int m = 0; m < 4; ++m) {
                const int r = u.pm * BM + ai * HALF + wr * 64 + m * 16 + fr;
                const float rs = rsv[ai][m];
                float s = 0.f, q = 0.f;
#pragma unroll
                for (int bj = 0; bj < 2; ++bj)
#pragma unroll
                    for (int n = 0; n < 2; ++n) {
                        f32x4 v = acc[ai][bj][m][n] * rs;
                        v[0] = gelu_tanh_f(v[0]); v[1] = gelu_tanh_f(v[1]); v[2] = gelu_tanh_f(v[2]); v[3] = gelu_tanh_f(v[3]);
                        st_bf16x4(z + (size_t)r * 2048 + u.pn * BM + bj * HALF + wc * 32 + n * 16 + 4 * fq, v);
                        s += (v[0] + v[1]) + (v[2] + v[3]); q += (v[0] * v[0] + v[1] * v[1]) + (v[2] * v[2] + v[3] * v[3]);
                    }
                if (vhalf) {
                    s += __shfl_xor(s, 16); s += __shfl_xor(s, 32); q += __shfl_xor(q, 16); q += __shfl_xor(q, 32);
                    if (fq == 0) { atomicAdd(lns + r, s); atomicAdd(lnq + r, q); }
                }
            }
    }
};

struct EpiConv {
    static constexpr bool PERM = false, AFTER_DRAIN = false;
    const float* ssq; const float* cw; const float* cb; bf16_t* gt; float* hl; float* hf;
    __device__ __forceinline__ void operator()(const f32x4 (&acc)[2][2][4][2], const Unit& u, int wr, int wc, int fr_in, int fq_in) const {
        int fr = fr_in, fq = fq_in; asm volatile("" : "+v"(fr), "+v"(fq));
        const int lane = fq * 16 + fr;
        const int s1 = (lane & 48) | ((fr + 15) & 15), s2 = (lane & 48) | ((fr + 14) & 15);
        float rs[2][4];
#pragma unroll
        for (int ai = 0; ai < 2; ++ai)
#pragma unroll
            for (int m = 0; m < 4; ++m) rs[ai][m] = __builtin_amdgcn_rsqf(ssq[u.pm * BM + ai * HALF + wr * 64 + m * 16 + fr] * (1.0f / 1024.0f) + 1e-6f);
#pragma unroll
        for (int n = 0; n < 2; ++n) {
            asm volatile("" ::: "memory");
            const int g0 = u.pn * 128 + wc * 32 + n * 16 + 4 * fq;
            const f32x4 bg = *(const f32x4*)(cb + g0), wg0 = *(const f32x4*)(cw + g0), wg1 = *(const f32x4*)(cw + 5632 + g0), wg2 = *(const f32x4*)(cw + 2 * 5632 + g0);
            const f32x4 bu = *(const f32x4*)(cb + 2816 + g0), wu0 = *(const f32x4*)(cw + 2816 + g0), wu1 = *(const f32x4*)(cw + 5632 + 2816 + g0), wu2 = *(const f32x4*)(cw + 2 * 5632 + 2816 + g0);
#pragma unroll
            for (int ai = 0; ai < 2; ++ai) {
                const int blk = u.pm * 4 + ai * 2 + wr;
                f32x4 pg1 = {0.f, 0.f, 0.f, 0.f}, pg2 = pg1, pu1 = pg1, pu2 = pg1;
#pragma unroll
                for (int m = 0; m < 4; ++m) {
                    const int r = u.pm * BM + ai * HALF + wr * 64 + m * 16 + fr;
                    const f32x4 ag = acc[ai][0][m][n] * rs[ai][m], au = acc[ai][1][m][n] * rs[ai][m];
                    if (m == 3 && fr >= 14) { float* h = hl + (size_t)(blk * 2 + (fr - 14)) * 5632 + g0; *(f32x4*)h = ag; *(f32x4*)(h + 2816) = au; }
                    if (m == 0 && fr < 2) { float* h = hf + (size_t)(blk * 2 + fr) * 5632 + g0; *(f32x4*)h = ag; *(f32x4*)(h + 2816) = au; }
                    f32x4 o;
                    { const f32x4 g1 = shfl4(ag, s1), g2 = shfl4(ag, s2);
                      const f32x4 p1g = fr >= 1 ? g1 : pg1, p2g = fr >= 2 ? g2 : pg2;
                      const f32x4 cg = bg + wg0 * p2g + wg1 * p1g + wg2 * ag;
                      o[0] = silu_f(cg[0]); o[1] = silu_f(cg[1]); o[2] = silu_f(cg[2]); o[3] = silu_f(cg[3]);
                      pg1 = g1; pg2 = g2; }
                    { const f32x4 u1 = shfl4(au, s1), u2 = shfl4(au, s2);
                      const f32x4 p1u = fr >= 1 ? u1 : pu1, p2u = fr >= 2 ? u2 : pu2;
                      const f32x4 cu = bu + wu0 * p2u + wu1 * p1u + wu2 * au;
                      o = o * cu;
                      pu1 = u1; pu2 = u2; }
                    st_bf16x4(gt + (size_t)r * 2816 + g0, o);
                }
            }
        }
    }
};

template <class Epi, class Sched, bool ALIGN_EPI = false, bool SP2 = false>
__device__ __forceinline__ void gemm_phase(PG8_LAS unsigned char* lds, const Gemm g, const Sched& S, const Epi& E) {
    int tid_ = threadIdx.x; asm volatile("" : "+v"(tid_));
    const int tid = tid_, wid = __builtin_amdgcn_readfirstlane(tid >> 6), lane = tid & 63, wr = wid >> 2, wc = wid & 3, fr = lane & 15, fq = lane >> 4;
    const int K = g.K, nt = K / BK;
    unsigned voffA[2], voffB[2];
#pragma unroll
    for (int i = 0; i < 2; ++i) { int R, C; stage_rc(tid * 16 + i * 8192, R, C); const int Rb = Epi::PERM ? ((R & ~31) + perm32(R & 31)) : R;
        voffA[i] = (unsigned)(R * K + C) * 2u; voffB[i] = (unsigned)(Rb * K + C) * 2u; }
    const size_t kstep = (size_t)(BK * 2);
    const size_t hstep = (size_t)HALF * K * 2;
    const size_t tstep = 2 * hstep;
    const unsigned ldsw = (unsigned)wid * 1024u;
    const int aoff = lds_byte(wr * 64 + fr, fq * 8), boff = lds_byte(wc * 32 + fr, fq * 8);
#define PG8_SA(b, h) (((b) * 2 + (h)) * HTB)
#define PG8_SB(b, h) ((4 + (b) * 2 + (h)) * HTB)
#define PG8_STAGE(bufoff, gbase, voff) do { _Pragma("unroll") for (int _i = 0; _i < 2; ++_i) \
        __builtin_amdgcn_global_load_lds((const unsigned*)((const char*)(gbase) + (voff)[_i]), (PG8_LAS unsigned*)(lds + (bufoff) + ldsw + _i * 8192), 16, 0, 0); } while (0)
#define PG8_LDA(dst, b, h) do { _Pragma("unroll") for (int m = 0; m < 4; ++m) _Pragma("unroll") for (int k = 0; k < 2; ++k) dst[m][k] = *(const PG8_LAS bf16x8*)(lds + PG8_SA(b, h) + aoff + m * 2048 + k * 1024); } while (0)
#define PG8_LDB(dst, b, h) do { _Pragma("unroll") for (int n = 0; n < 2; ++n) _Pragma("unroll") for (int k = 0; k < 2; ++k) dst[n][k] = *(const PG8_LAS bf16x8*)(lds + PG8_SB(b, h) + boff + n * 2048 + k * 1024); } while (0)
#define PG8_MMA(ai, bj, At, Bt) do { __builtin_amdgcn_s_setprio(1); _Pragma("unroll") for (int m = 0; m < 4; ++m) _Pragma("unroll") for (int n = 0; n < 2; ++n) _Pragma("unroll") for (int k = 0; k < 2; ++k) \
        acc[ai][bj][m][n] = __builtin_amdgcn_mfma_f32_16x16x32_bf16(Bt[n][k], At[m][k], acc[ai][bj][m][n], 0, 0, 0); __builtin_amdgcn_s_setprio(0); } while (0)
#define PG8_WAIT_V(n) asm volatile("s_waitcnt vmcnt(" #n ")" ::: "memory")
#define PG8_WAIT_L(n) asm volatile("s_waitcnt lgkmcnt(" #n ")" ::: "memory")
#define PG8_BAR __builtin_amdgcn_s_barrier()
#define PG8_SCHED __builtin_amdgcn_sched_barrier(0)
    Unit cur, nxt; int ui = 0;
    if (!S.next(0, cur)) return;
    f32x4 acc[2][2][4][2];
#pragma unroll
    for (int a = 0; a < 2; ++a)
#pragma unroll
        for (int b = 0; b < 2; ++b)
#pragma unroll
            for (int m = 0; m < 4; ++m)
#pragma unroll
                for (int n = 0; n < 2; ++n) acc[a][b][m][n] = (f32x4){0.f, 0.f, 0.f, 0.f};
    bf16x8 At[4][2], B0[2][2], B1[2][2];
    const char* cA = (const char*)g.A + (size_t)cur.pm * tstep; const char* cB = (const char*)g.Bt + (size_t)cur.pn * tstep;
    S.a_ready(cur);
    if constexpr (SP2) {
        PG8_STAGE(PG8_SB(0, 0), cB, voffB); PG8_STAGE(PG8_SB(0, 1), cB + hstep, voffB); PG8_STAGE(PG8_SA(0, 0), cA, voffA); PG8_STAGE(PG8_SA(0, 1), cA + hstep, voffA);
        if (wr == 1) PG8_BAR;
        PG8_WAIT_V(2); PG8_BAR;
        PG8_STAGE(PG8_SB(1, 0), cB + kstep, voffB); PG8_STAGE(PG8_SA(1, 0), cA + kstep, voffA); PG8_STAGE(PG8_SB(1, 1), cB + hstep + kstep, voffB);
        PG8_WAIT_V(6); PG8_BAR;
    } else {
        PG8_STAGE(PG8_SB(0, 0), cB, voffB); PG8_STAGE(PG8_SA(0, 0), cA, voffA); PG8_STAGE(PG8_SB(0, 1), cB + hstep, voffB); PG8_STAGE(PG8_SA(0, 1), cA + hstep, voffA);
        if (wr == 1) PG8_BAR;
        PG8_WAIT_V(4); PG8_BAR;
        PG8_STAGE(PG8_SB(1, 0), cB + kstep, voffB); PG8_STAGE(PG8_SA(1, 0), cA + kstep, voffA); PG8_STAGE(PG8_SB(1, 1), cB + hstep + kstep, voffB);
        PG8_WAIT_V(6); PG8_BAR;
    }
    for (;;) {
        const bool has_next = S.next(ui + 1, nxt);
        const char* nA = has_next ? (const char*)g.A + (size_t)nxt.pm * tstep : cA; const char* nB = has_next ? (const char*)g.Bt + (size_t)nxt.pn * tstep : cB;
        for (int t = 0; t < nt; t += 2) {
            const bool last = (t == nt - 2);
            const char* a1 = cA + (size_t)(t + 1) * kstep;
            const char* a2 = last ? nA : cA + (size_t)(t + 2) * kstep; const char* b2 = last ? nB : cB + (size_t)(t + 2) * kstep;
            const char* a3 = a2 + kstep; const char* b3 = b2 + kstep;
            if (last && has_next) S.a_ready(nxt);
            if constexpr (SP2) {
            PG8_LDB(B0, 0, 0); PG8_LDB(B1, 0, 1); PG8_SCHED; PG8_LDA(At, 0, 0); PG8_STAGE(PG8_SA(1, 1), a1 + hstep, voffA);
            PG8_WAIT_V(8); PG8_WAIT_L(0); PG8_BAR; PG8_MMA(0, 0, At, B0); PG8_MMA(0, 1, At, B1); PG8_BAR; PG8_SCHED;
            PG8_LDA(At, 0, 1); PG8_STAGE(PG8_SB(0, 0), b2, voffB); PG8_STAGE(PG8_SB(0, 1), b2 + hstep, voffB); PG8_STAGE(PG8_SA(0, 0), a2, voffA);
            PG8_WAIT_V(8); PG8_WAIT_L(0); PG8_BAR; PG8_MMA(1, 0, At, B0); PG8_MMA(1, 1, At, B1); PG8_BAR; PG8_SCHED;
            PG8_LDB(B0, 1, 0); PG8_LDB(B1, 1, 1); PG8_SCHED; PG8_LDA(At, 1, 0); PG8_STAGE(PG8_SA(0, 1), a2 + hstep, voffA);
            PG8_WAIT_V(8); PG8_WAIT_L(0); PG8_BAR; PG8_MMA(0, 0, At, B0); PG8_MMA(0, 1, At, B1); PG8_BAR; PG8_SCHED;
            PG8_LDA(At, 1, 1); PG8_STAGE(PG8_SB(1, 0), b3, voffB); PG8_STAGE(PG8_SB(1, 1), b3 + hstep, voffB); PG8_STAGE(PG8_SA(1, 0), a3, voffA);
            PG8_WAIT_V(8); PG8_WAIT_L(0); PG8_BAR; PG8_MMA(1, 0, At, B0); PG8_MMA(1, 1, At, B1); PG8_BAR; PG8_SCHED;
            } else {
            PG8_LDB(B0, 0, 0); PG8_SCHED; PG8_LDA(At, 0, 0); PG8_STAGE(PG8_SA(1, 1), a1 + hstep, voffA);
            PG8_WAIT_L(8); PG8_BAR; PG8_WAIT_L(0); PG8_MMA(0, 0, At, B0); PG8_BAR; PG8_SCHED;
            PG8_LDB(B1, 0, 1); PG8_STAGE(PG8_SB(0, 0), b2, voffB);
            PG8_BAR; PG8_WAIT_L(0); PG8_MMA(0, 1, At, B1); PG8_BAR;
            PG8_LDA(At, 0, 1); PG8_STAGE(PG8_SA(0, 0), a2, voffA);
            PG8_BAR; PG8_WAIT_L(0); PG8_MMA(1, 0, At, B0); PG8_BAR; PG8_SCHED;
            PG8_STAGE(PG8_SB(0, 1), b2 + hstep, voffB);
            PG8_WAIT_V(6); PG8_BAR; PG8_MMA(1, 1, At, B1); PG8_BAR;
            PG8_LDB(B0, 1, 0); PG8_SCHED; PG8_LDA(At, 1, 0); PG8_STAGE(PG8_SA(0, 1), a2 + hstep, voffA);
            PG8_WAIT_L(8); PG8_BAR; PG8_WAIT_L(0); PG8_MMA(0, 0, At, B0); PG8_BAR; PG8_SCHED;
            PG8_LDB(B1, 1, 1); PG8_STAGE(PG8_SB(1, 0), b3, voffB);
            PG8_BAR; PG8_WAIT_L(0); PG8_MMA(0, 1, At, B1); PG8_BAR;
            PG8_LDA(At, 1, 1); PG8_STAGE(PG8_SA(1, 0), a3, voffA);
            PG8_BAR; PG8_WAIT_L(0); PG8_MMA(1, 0, At, B0); PG8_BAR; PG8_SCHED;
            PG8_STAGE(PG8_SB(1, 1), b3 + hstep, voffB);
            PG8_WAIT_V(6); PG8_BAR; PG8_MMA(1, 1, At, B1); PG8_BAR;
            }
        }
        if constexpr (ALIGN_EPI) { if (wr == 0) PG8_BAR; }
        if constexpr (!Epi::AFTER_DRAIN) { E(acc, cur, wr, wc, fr, fq); S.done(cur); }
        if (!has_next) break;
#pragma unroll
        for (int a = 0; a < 2; ++a)
#pragma unroll
            for (int b = 0; b < 2; ++b)
#pragma unroll
                for (int m = 0; m < 4; ++m)
#pragma unroll
                    for (int n = 0; n < 2; ++n) acc[a][b][m][n] = (f32x4){0.f, 0.f, 0.f, 0.f};
        cur = nxt; cA = nA; cB = nB; ++ui;
        if constexpr (ALIGN_EPI) { if (wr == 1) PG8_BAR; }
    }
    PG8_WAIT_V(0);
    if constexpr (!ALIGN_EPI) { if (wr == 0) PG8_BAR; }
    PG8_BAR;
    if constexpr (Epi::AFTER_DRAIN) { E.fused(acc, cur, wr, wc, fr, fq, lds, wid, lane); S.done(cur); }
#undef PG8_SA
#undef PG8_SB
#undef PG8_STAGE
#undef PG8_LDA
#undef PG8_LDB
#undef PG8_MMA
#undef PG8_WAIT_V
#undef PG8_WAIT_L
#undef PG8_BAR
#undef PG8_SCHED
}
}
#define GAS __attribute__((address_space(1)))
#define LAS __attribute__((address_space(3)))
typedef unsigned short bf16;
typedef unsigned v4u __attribute__((ext_vector_type(4)));
typedef float f32x4 __attribute__((ext_vector_type(4)));
typedef short bf16x8 __attribute__((ext_vector_type(8)));
typedef GAS unsigned gu32;
typedef GAS unsigned long long gu64;
#define RLX_AGENT __ATOMIC_RELAXED, __HIP_MEMORY_SCOPE_AGENT
#define LDS_WAIT() asm volatile("s_waitcnt lgkmcnt(0)" ::: "memory")
#define VM_WAIT() asm volatile("s_waitcnt vmcnt(0)" ::: "memory")
__device__ __forceinline__ unsigned long long rt() { return __builtin_amdgcn_s_memrealtime(); }
__device__ __forceinline__ unsigned f2bf(float f) { unsigned u = __builtin_bit_cast(unsigned, f); return (u + 0x7fffu + ((u >> 16) & 1u)) >> 16; }
__device__ __forceinline__ unsigned pk2(float lo, float hi) { return f2bf(lo) | (f2bf(hi) << 16); }

#define XB_TMO      128
#define XB_XCNT(j)  (256  + 64 * (j))
#define XB_XSUB(j)  (1280 + 64 * (j))
#define XB_XGEN(j)  (2304 + 64 * (j))
#define XB_TOP      3328
#define XB_TOPGEN   3392
#define XCD_BAR_WORDS 3456
#define XB_SPIN_CAP (1u << 18)

__device__ __forceinline__ unsigned xb_ld(unsigned* p)              { return __hip_atomic_load(p, __ATOMIC_RELAXED, __HIP_MEMORY_SCOPE_AGENT); }
__device__ __forceinline__ unsigned xb_add(unsigned* p, unsigned v) { return __hip_atomic_fetch_add(p, v, __ATOMIC_RELAXED, __HIP_MEMORY_SCOPE_AGENT); }
__device__ __forceinline__ unsigned xb_xcc_id() { return (unsigned)__builtin_amdgcn_s_getreg((3 << 11) | 20) & 0xFu; }
#define XB_SPIN(cond, bar) do { unsigned _sp = 0; while (cond) { __builtin_amdgcn_s_sleep(1); \
    if ((++_sp & 255u) == 0u) { if (xb_ld(&(bar)[XB_TMO])) break; if (_sp > XB_SPIN_CAP) { atomicAdd(&(bar)[XB_TMO], 1u); break; } } } } while (0)

struct XcdBarrier {
    unsigned* bar; unsigned x;
    volatile LAS unsigned* st;
};

__device__ __forceinline__ XcdBarrier xcd_barrier_post(unsigned* bar, volatile LAS unsigned* st) {
    XcdBarrier b; b.bar = bar; b.x = xb_xcc_id(); b.st = st;
    if (threadIdx.x == 0) (void)xb_add(&bar[XB_XCNT(b.x)], 1u);
    return b;
}
__device__ __forceinline__ void xcd_barrier_complete(unsigned* bar, unsigned x, unsigned& nloc, unsigned& nx) {
    const unsigned G = gridDim.x * gridDim.y * gridDim.z;
    unsigned sum, cnt, mine, sp = 0u;
    for (;;) {
        sum = 0u; cnt = 0u; mine = 0u;
#pragma unroll
        for (unsigned j = 0; j < 16; ++j) { const unsigned c = xb_ld(&bar[XB_XCNT(j)]); sum += c; cnt += (c > 0u) ? 1u : 0u; mine = (j == x) ? c : mine; }
        if (sum == G) break;
        __builtin_amdgcn_s_sleep(1);
        if ((++sp & 255u) == 0u) { if (xb_ld(&bar[XB_TMO])) break; if (sp > XB_SPIN_CAP) { atomicAdd(&bar[XB_TMO], 1u); break; } }
    }
    nloc = mine > 0u ? mine : 1u; nx = cnt > 0u ? cnt : 1u;
}

__device__ __forceinline__ void xcd_barrier(const XcdBarrier& b) {
    asm volatile("s_waitcnt vmcnt(0)" ::: "memory");
    __syncthreads();
    if (threadIdx.x == 0) {
        unsigned* bar = b.bar;
        __builtin_amdgcn_s_waitcnt(0);
        unsigned nloc = b.st[0], nx = b.st[1];
        if (nloc == 0u) { xcd_barrier_complete(bar, b.x, nloc, nx); b.st[0] = nloc; b.st[1] = nx; }
        const unsigned old = xb_add(&bar[XB_XSUB(b.x)], 1u);
        const unsigned gen = old / nloc;
        if (old + 1u == (gen + 1u) * nloc) {
            __builtin_amdgcn_fence(__ATOMIC_RELEASE, "agent");
            asm volatile("s_waitcnt vmcnt(0)" ::: "memory");
            const unsigned og = xb_add(&bar[XB_TOP], 1u);
            const unsigned tg = og / nx;
            if (og + 1u == (tg + 1u) * nx) xb_add(&bar[XB_TOPGEN], 1u);
            else XB_SPIN(xb_ld(&bar[XB_TOPGEN]) == tg, bar);
            __builtin_amdgcn_fence(__ATOMIC_ACQUIRE, "agent");
            xb_add(&bar[XB_XGEN(b.x)], 1u);
            asm volatile("s_waitcnt vmcnt(0)" ::: "memory");
        } else {
            XB_SPIN(xb_ld(&bar[XB_XGEN(b.x)]) == gen, bar);
            __builtin_amdgcn_fence(__ATOMIC_ACQUIRE, "agent");
            asm volatile("s_waitcnt vmcnt(0)" ::: "memory");
        }
    }
    __syncthreads();
}

constexpr int NWAVES = 8, NTHR = 512;
constexpr int NB = 4, SEQ = 4096, M = NB * SEQ, DM = 1024;
constexpr int IN_W = 2516, NIN = 2560;
constexpr int DFF = 2816, DFF2 = 5632;
constexpr int NUNIT_GLA = NB * 4 * 64;

constexpr size_t MiB = 1u << 20;
constexpr size_t WS_CTL = 0, CTL_ZERO_BYTES = 1 * MiB;
constexpr size_t WS_ROPE = 1 * MiB;
constexpr size_t WS_SSQ = 2 * MiB;
constexpr size_t WS_WIN = 4 * MiB, WS_WO = 9 * MiB, WS_WUP0 = 11 * MiB, WS_WUP1 = 22 * MiB, WS_WDN0 = 33 * MiB, WS_WDN1 = 39 * MiB, WS_WUV = 45 * MiB, WS_WOUT = 49 * MiB;
constexpr size_t WS_XB = 51 * MiB;
constexpr size_t WS_R = 83 * MiB;
constexpr size_t R_GQ = WS_R, R_GK = R_GQ + 8 * MiB, R_GV = R_GK + 8 * MiB, R_GR = R_GV + 16 * MiB, R_BQ = R_GR + 16 * MiB, R_IQ = R_BQ + 16 * MiB, R_BK = R_IQ + 16 * MiB,
                 R_BV = R_BK + 2 * MiB, R_IK = R_BV + 2 * MiB, R_ALR = R_IK + 4 * MiB, R_IW = R_ALR + 1 * MiB, R_DS = R_IW + 1 * MiB, R_DEC = R_DS + 32 * MiB, R_IDX = R_DEC + 1 * MiB,
                 R_AO = R_IDX + 8 * MiB, R_END0 = R_AO + 32 * MiB;
constexpr size_t R_GT = WS_R, R_HL = R_GT + 88 * MiB, R_HF = R_HL + 11 * MiB, R_END1 = R_HF + 11 * MiB;
constexpr size_t R_Z = WS_R, R_SG = R_Z + 64 * MiB, R_END2 = R_SG + 32 * MiB;
constexpr size_t WS_END = 256 * MiB;
static_assert(R_END0 <= WS_END && R_END1 <= WS_END && R_END2 <= WS_END, "d_ws map");
constexpr int CW_BAR = 4096;

constexpr int RING_BYTES = 131072, LDS_BYTES = 147456, LDSCTL_OFF = LDS_BYTES - 512, MISC_OFF = LDSCTL_OFF;

typedef unsigned short bf16;
__device__ __forceinline__ float bf2f(unsigned short h) { return __builtin_bit_cast(float, (unsigned)h << 16); }
__device__ __forceinline__ float wave_sum(float v) {
#pragma unroll
    for (int o = 1; o < 64; o <<= 1) v += __shfl_xor(v, o);
    return v;
}
__device__ __forceinline__ float wave_max(float v) {
#pragma unroll
    for (int o = 1; o < 64; o <<= 1) v = fmaxf(v, __shfl_xor(v, o));
    return v;
}

struct Args { const float* in[20]; float* out; unsigned char* ws; int ph_lo, ph_hi; };

__device__ __forceinline__ int ropeperm(int p) { return p < 16 ? ((p >> 1) + 8 * (p & 1)) : p; }
__device__ __forceinline__ int win_src(int n) {
    if (n < 1536) return n;
    if (n < 2048) { const int c = n - 1536; return 1552 + (c & ~63) + ropeperm(c & 63); }
    if (n < 2304) { const int c = n - 2048; return 2192 + (c & ~63) + ropeperm(c & 63); }
    const int c = n - 2304;
    if (c < 64) return 2064 + ropeperm(c);
    if (c < 128) return 2128 + (c - 64);
    if (c < 192) return 2448 + ropeperm(c - 128);
    if (c < 208) return 1536 + (c - 192);
    if (c < 212) return 2512 + (c - 208);
    return -1;
}
__device__ __forceinline__ int up_src(int r) { const int pn = r >> 8, w = r & 255; return (w >> 7) * DFF + pn * 128 + (w & 127); }

__device__ __forceinline__ int ropeinv(int d) { return d < 16 ? (d < 8 ? 2 * d : 2 * (d - 8) + 1) : d; }
__device__ __forceinline__ int win_dst(int s) {
    if (s < 1536) return s;
    if (s < 1552) return 2304 + 192 + (s - 1536);
    if (s < 2064) { const int c = s - 1552; return 1536 + (c & ~63) + ropeinv(c & 63); }
    if (s < 2128) return 2304 + ropeinv(s - 2064);
    if (s < 2192) return 2304 + 64 + (s - 2128);
    if (s < 2448) { const int c = s - 2192; return 2048 + (c & ~63) + ropeinv(c & 63); }
    if (s < 2512) return 2304 + 128 + ropeinv(s - 2448);
    return 2304 + 208 + (s - 2512);
}
__device__ __forceinline__ int up_dst(int s) { const int bj = s >= DFF ? 1 : 0, rem = s - bj * DFF; return (rem >> 7) * 256 + bj * 128 + (rem & 127); }

typedef short v4i16p_t __attribute__((ext_vector_type(4)));
template <int MAP  >
__device__ __forceinline__ void transpose_item(const float* W, int K, int Nsrc, const float* g, bf16* WT, unsigned char* scr, int item, int lane) {
    const int nsb = (Nsrc + 63) >> 6, kb = item / nsb, sb = item % nsb, k0 = 64 * kb, s0 = 64 * sb;
    const int lr = lane >> 4, s4 = 4 * (lane & 15);
    const bool inb = s0 + s4 < Nsrc;
    f32x4 vv[16]; float gg[16];
    const float* wp = W + (size_t)(k0 + lr) * Nsrc + (inb ? s0 + s4 : 0);
#pragma unroll
    for (int i = 0; i < 16; ++i) { vv[i] = *(const f32x4*)(wp + (size_t)(4 * i) * Nsrc); gg[i] = g ? g[k0 + 4 * i + lr] : 1.0f; }
#pragma unroll
    for (int i = 0; i < 16; ++i) { const int kk = 4 * i + lr;
        const f32x4 v = inb ? vv[i] * gg[i] : (f32x4){0.f, 0.f, 0.f, 0.f};
        *(unsigned long long*)(scr + kk * 144 + s4 * 2) = (unsigned long long)pg8::cvt_pk_bf16(v[0], v[1]) | ((unsigned long long)pg8::cvt_pk_bf16(v[2], v[3]) << 32); }
    LDS_WAIT(); asm volatile("" ::: "memory");
    const int grp = lane >> 4, li = lane & 15;
#pragma unroll
    for (int j = 0; j < 8; ++j) { const int c = j, sblk = grp;
        const unsigned char* b = scr + (8 * c + (li >> 2)) * 144 + (16 * sblk + 4 * (li & 3)) * 2;
        const v4i16p_t a0 = __builtin_amdgcn_ds_read_tr16_b64_v4i16((LAS v4i16p_t*)(LAS unsigned char*)b), a1 = __builtin_amdgcn_ds_read_tr16_b64_v4i16((LAS v4i16p_t*)(LAS unsigned char*)(b + 4 * 144));
        const int s = s0 + 16 * sblk + li;
        if (s < Nsrc) { const int dst = MAP == 0 ? s : (MAP == 1 ? win_dst(s) : up_dst(s));
            v4u o; o.x = (unsigned)(unsigned short)a0[0] | ((unsigned)(unsigned short)a0[1] << 16); o.y = (unsigned)(unsigned short)a0[2] | ((unsigned)(unsigned short)a0[3] << 16);
            o.z = (unsigned)(unsigned short)a1[0] | ((unsigned)(unsigned short)a1[1] << 16); o.w = (unsigned)(unsigned short)a1[2] | ((unsigned)(unsigned short)a1[3] << 16);
            *(v4u*)(WT + (size_t)dst * K + k0 + 8 * c) = o; } }
    LDS_WAIT(); asm volatile("" ::: "memory");
}

__device__ __forceinline__ void sincos_d(double a, float& c, float& s) {
    const double k = __builtin_rint(a * 0.15915494309189535);
    double r = a - k * 6.283185307179586; r -= k * 2.4492935982947064e-16;
    const double r2 = r * r;
    double sp = -1.0 / 51090942171709440000.0, cp = 1.0 / 1124000727777607680000.0;
    sp = sp * r2 + 1.0 / 121645100408832000.0;  cp = cp * r2 - 1.0 / 2432902008176640000.0;
    sp = sp * r2 - 1.0 / 355687428096000.0;     cp = cp * r2 + 1.0 / 6402373705728000.0;
    sp = sp * r2 + 1.0 / 1307674368000.0;       cp = cp * r2 - 1.0 / 20922789888000.0;
    sp = sp * r2 - 1.0 / 6227020800.0;          cp = cp * r2 + 1.0 / 87178291200.0;
    sp = sp * r2 + 1.0 / 39916800.0;            cp = cp * r2 - 1.0 / 479001600.0;
    sp = sp * r2 - 1.0 / 362880.0;              cp = cp * r2 + 1.0 / 3628800.0;
    sp = sp * r2 + 1.0 / 5040.0;                cp = cp * r2 - 1.0 / 40320.0;
    sp = sp * r2 - 1.0 / 120.0;                 cp = cp * r2 + 1.0 / 720.0;
    sp = sp * r2 + 1.0 / 6.0;                   cp = cp * r2 - 1.0 / 24.0;
    cp = cp * r2 + 0.5;
    s = (float)(r - r * r2 * sp); c = (float)(1.0 - r2 * cp);
}

constexpr int CW_WIN = 16 * ((IN_W + 63) / 64), CW_WO = 16 * 16, CW_WUP = 16 * (DFF2 / 64), CW_WDN = (DFF / 64) * 16, CW_WUV = 16 * 32, CW_WOUT = 16 * 16;
constexpr int CW_E0 = CW_WIN, CW_E1 = CW_E0 + CW_WO, CW_E2 = CW_E1 + CW_WUP, CW_E3 = CW_E2 + CW_WDN, CW_E4 = CW_E3 + CW_WUV, CW_E5 = CW_E4 + CW_WOUT, CW_E6 = CW_E5 + CW_WUP, CW_E7 = CW_E6 + CW_WDN;
__device__ __forceinline__ void convert_weights(const Args& a, unsigned char* lds, int rank, int nrank, int tid, int lo, int hi) {
    unsigned char* ws = a.ws;
    const int lane = tid & 63, wave = tid >> 6;
    unsigned char* scr = lds + wave * 9216;
    const int gw = rank * NWAVES + wave, NGW = nrank * NWAVES;
    for (int it = lo + gw; it < hi; it += NGW) {
        if (it < CW_E0) { transpose_item<1>(a.in[2], 1024, IN_W, a.in[1], (bf16*)(ws + WS_WIN), scr, it, lane); }
        else if (it < CW_E1) { transpose_item<0>(a.in[6], 1024, 1024, nullptr, (bf16*)(ws + WS_WO), scr, it - CW_E0, lane); }
        else if (it < CW_E2) { transpose_item<2>(a.in[15], 1024, DFF2, a.in[14], (bf16*)(ws + WS_WUP0), scr, it - CW_E1, lane); }
        else if (it < CW_E3) { transpose_item<0>(a.in[18], DFF, 1024, nullptr, (bf16*)(ws + WS_WDN0), scr, it - CW_E2, lane); }
        else if (it < CW_E4) { transpose_item<0>(a.in[8], 1024, 2048, a.in[7], (bf16*)(ws + WS_WUV), scr, it - CW_E3, lane); }
        else if (it < CW_E5) { transpose_item<0>(a.in[13], 1024, 1024, nullptr, (bf16*)(ws + WS_WOUT), scr, it - CW_E4, lane); }
        else if (it < CW_E6) { transpose_item<2>(a.in[15] + (size_t)1024 * DFF2, 1024, DFF2, a.in[14] + 1024, (bf16*)(ws + WS_WUP1), scr, it - CW_E5, lane); }
        else { transpose_item<0>(a.in[18] + (size_t)DFF * 1024, DFF, 1024, nullptr, (bf16*)(ws + WS_WDN1), scr, it - CW_E6, lane); }
    }
}
__device__ __forceinline__ void p0_prologue(const Args& a, unsigned char* lds, int vcu, int G, int tid) {
    unsigned char* ws = a.ws;
    const int lane = tid & 63, wave = tid >> 6;
    const int gw = vcu * NWAVES + wave, NGW = G * NWAVES;
    convert_weights(a, lds, vcu, G, tid, 0, CW_E0);
    convert_weights(a, lds, vcu, G, tid, CW_E5, CW_E7);
    { const int gt0 = vcu * NTHR + tid; v4u* zp = (v4u*)((bf16*)(ws + WS_WIN) + (size_t)(2304 + 212) * 1024);
      for (int i = gt0; i < 44 * 1024 / 8; i += G * NTHR) zp[i] = (v4u){0u, 0u, 0u, 0u}; }
    float* ssq = (float*)(ws + WS_SSQ);
    bf16* xb = (bf16*)(ws + WS_XB);
    for (int m = gw; m < M; m += NGW) {
        const f32x4* xr = (const f32x4*)(a.in[0] + (size_t)m * DM) + lane;
        unsigned long long* o8 = (unsigned long long*)(xb + (size_t)m * DM) + lane;
        float s = 0.f;
#pragma unroll
        for (int j = 0; j < 4; ++j) { const f32x4 v = xr[64 * j]; s += (v.x * v.x + v.y * v.y) + (v.z * v.z + v.w * v.w);
            o8[64 * j] = (unsigned long long)pk2(v.x, v.y) | ((unsigned long long)pk2(v.z, v.w) << 32); }
        s = wave_sum(s);
        if (lane == 0) ssq[m] = s;
    }
    const int gt = vcu * NTHR + tid, NGT = G * NTHR;
    for (int i = gt; i < 6 * M; i += NGT) ssq[M + i] = 0.f;
    float* rope = (float*)(ws + WS_ROPE);
    for (int i = gt; i < SEQ * 8; i += NGT) {
        const int t = i >> 3, j = i & 7;
        const double inv = j == 0 ? 1.0 : j == 1 ? 0.19392274474868576 : j == 2 ? 0.03760603093086393 : j == 3 ? 0.007292664737217109 : j == 4 ? 0.001414213562373095
                         : j == 5 ? 0.0002742481756762073 : j == 6 ? 5.318295896944988e-05 : 1.031338537721246e-05;
        float c, s; sincos_d((double)t * inv, c, s);
        rope[2 * i] = c; rope[2 * i + 1] = s;
    }
}

__device__ __forceinline__ float logsigmoid_f(float z) { return fminf(z, 0.f) - 0.6931471805599453f * __builtin_amdgcn_logf(1.0f + __builtin_amdgcn_exp2f(-1.4426950408889634f * fabsf(z))); }
typedef short v4i16_t __attribute__((ext_vector_type(4)));
__device__ __forceinline__ v4i16_t tr16(const unsigned char* p) { return __builtin_amdgcn_ds_read_tr16_b64_v4i16((LAS v4i16_t*)(LAS unsigned char*)p); }
__device__ __forceinline__ bf16x8 frag_tr(const unsigned char* X, int RS, int rowA, int rowB, int col0, int fr, int fq) {
    const unsigned char* b = X + (4 * fq + (fr >> 2)) * RS + (col0 + 4 * (fr & 3)) * 2;
    const v4i16_t a0 = tr16(b + rowA * RS), a1 = tr16(b + rowB * RS);
    return (bf16x8){a0[0], a0[1], a0[2], a0[3], a1[0], a1[1], a1[2], a1[3]};
}
__device__ __forceinline__ bf16x8 frag_row_perm(const unsigned char* X, int RS, int row0, int colA, int colB, int fr, int fq) {
    const unsigned char* b = X + (row0 + fr) * RS + 8 * fq;
    const v4i16_t a0 = *(const v4i16_t*)(b + colA * 2), a1 = *(const v4i16_t*)(b + colB * 2);
    return (bf16x8){a0[0], a0[1], a0[2], a0[3], a1[0], a1[1], a1[2], a1[3]};
}
__device__ __forceinline__ bf16x8 frag_row(const unsigned char* X, int RS, int row0, int col0, int fr, int fq) { return *(const bf16x8*)(X + (row0 + fr) * RS + (col0 + 8 * fq) * 2); }

__device__ __forceinline__ void gla_cumdecay(float* bl, float* gt, const f32x4 (&ar)[4], const float* wt, int tid) {
    { const int c = tid >> 3, d0 = (tid & 7) * 8;
      f32x4 z0 = *(const f32x4*)(wt + 1024 + d0), z1 = *(const f32x4*)(wt + 1024 + d0 + 4);
#pragma unroll
      for (int r = 0; r < 16; ++r) { const float x = ar[r >> 2][r & 3];
          z0 += x * *(const f32x4*)(wt + r * 64 + d0); z1 += x * *(const f32x4*)(wt + r * 64 + d0 + 4); }
      f32x4 o0, o1;
#pragma unroll
      for (int j = 0; j < 4; ++j) { o0[j] = logsigmoid_f(z0[j]) * (1.0f / 16.0f); o1[j] = logsigmoid_f(z1[j]) * (1.0f / 16.0f); }
      *(f32x4*)(bl + c * 64 + d0) = o0; *(f32x4*)(bl + c * 64 + d0 + 4) = o1; }
    __syncthreads();
    const int d = tid & 63, g = tid >> 6;
    float v[8]; float s = 0.f;
#pragma unroll
    for (int j = 0; j < 8; ++j) { s += bl[(8 * g + j) * 64 + d]; v[j] = s; }
    gt[g * 64 + d] = s;
    __syncthreads();
    float off = 0.f;
#pragma unroll
    for (int g2 = 0; g2 < 7; ++g2) off += (g2 < g) ? gt[g2 * 64 + d] : 0.f;
#pragma unroll
    for (int j = 0; j < 8; ++j) bl[(8 * g + j) * 64 + d] = v[j] + off;
    __syncthreads();
}
__device__ __forceinline__ void gla_stage_gate(float* wt, const float* wa2, const float* ba, int h, int tid) {
    for (int i = tid; i < 1024; i += NTHR) wt[i] = wa2[(i >> 6) * 256 + h * 64 + (i & 63)];
    if (tid < 64) wt[1024 + tid] = ba[h * 64 + tid];
}

constexpr int GL_BL = 0, GL_GT = 16384, GL_QD = 18432, GL_KD = 27648, GL_QB = 36864, GL_VV = 46080, GL_SS = 64512, GL_PART = 82944, GL_WT = 83456;
constexpr int GL_RS64 = 144, GL_RS128 = 288, GL_RSKL = 160;

__device__ __forceinline__ void gla_phase_a(const Args& a, unsigned char* lds, int vcu, int G, int tid) {
    unsigned char* ws = a.ws;
    float* bl = (float*)(lds + GL_BL); float* gt = (float*)(lds + GL_GT); float* wt = (float*)(lds + GL_WT);
    unsigned char* kl = lds + GL_QD; unsigned char* vv = lds + GL_VV;
    const bf16* gk = (const bf16*)(ws + R_GK); const bf16* gv = (const bf16*)(ws + R_GV);
    const float* alr = (const float*)(ws + R_ALR);
    float* ds = (float*)(ws + R_DS); float* dec = (float*)(ws + R_DEC);
    const int lane = tid & 63, wave = tid >> 6, fr = lane & 15, fq = lane >> 4;
    const int c = tid >> 3, sub = tid & 7, d0 = sub * 8, e0 = sub * 16;
    f32x4 ar[4]; v4u kw, vw0, vw1;
#define GLA_LOAD_A(unit_) do { const int bb_ = (unit_) >> 8, h_ = ((unit_) >> 6) & 3, n_ = (unit_) & 63; const size_t row_ = (size_t)bb_ * SEQ + n_ * 64 + c; \
        const f32x4* ap_ = (const f32x4*)(alr + row_ * 16); ar[0] = ap_[0]; ar[1] = ap_[1]; ar[2] = ap_[2]; ar[3] = ap_[3]; \
        kw = *(const v4u*)(gk + row_ * 256 + h_ * 64 + d0); const v4u* vs_ = (const v4u*)(gv + row_ * 512 + h_ * 128 + e0); vw0 = vs_[0]; vw1 = vs_[1]; } while (0)
    int hcur = -1;
    if (vcu < NUNIT_GLA) GLA_LOAD_A(vcu);
    for (int unit = vcu; unit < NUNIT_GLA; unit += G) {
        const int h = (unit >> 6) & 3;
        if (h != hcur) { hcur = h; gla_stage_gate(wt, a.in[3], a.in[4], h, tid); __syncthreads(); }
        gla_cumdecay(bl, gt, ar, wt, tid);
        { float kf[8] = {__builtin_bit_cast(float, kw.x << 16), __builtin_bit_cast(float, kw.x & 0xffff0000u), __builtin_bit_cast(float, kw.y << 16), __builtin_bit_cast(float, kw.y & 0xffff0000u),
                         __builtin_bit_cast(float, kw.z << 16), __builtin_bit_cast(float, kw.z & 0xffff0000u), __builtin_bit_cast(float, kw.w << 16), __builtin_bit_cast(float, kw.w & 0xffff0000u)};
#pragma unroll
          for (int j = 0; j < 8; ++j) kf[j] *= __expf(bl[63 * 64 + d0 + j] - bl[c * 64 + d0 + j]);
          *(v4u*)(kl + c * GL_RSKL + d0 * 2) = (v4u){pk2(kf[0], kf[1]), pk2(kf[2], kf[3]), pk2(kf[4], kf[5]), pk2(kf[6], kf[7])};
          *(v4u*)(vv + c * GL_RS128 + e0 * 2) = vw0; *(v4u*)(vv + c * GL_RS128 + e0 * 2 + 16) = vw1; }
        if (tid < 64) dec[unit * 64 + tid] = __expf(bl[63 * 64 + tid]);
        if (unit + G < NUNIT_GLA) GLA_LOAD_A(unit + G);
        __syncthreads();
        { const bf16x8 va0 = frag_tr(vv, GL_RS128, 0, 16, wave * 16, fr, fq), va1 = frag_tr(vv, GL_RS128, 32, 48, wave * 16, fr, fq);
#pragma unroll
          for (int dtile = 0; dtile < 4; ++dtile) {
              const bf16x8 kb0 = frag_tr(kl, GL_RSKL, 0, 16, dtile * 16, fr, fq), kb1 = frag_tr(kl, GL_RSKL, 32, 48, dtile * 16, fr, fq);
              f32x4 acc = {0.f, 0.f, 0.f, 0.f};
              acc = __builtin_amdgcn_mfma_f32_16x16x32_bf16(va0, kb0, acc, 0, 0, 0);
              acc = __builtin_amdgcn_mfma_f32_16x16x32_bf16(va1, kb1, acc, 0, 0, 0);
              *(f32x4*)(ds + (size_t)unit * 8192 + (dtile * 16 + fr) * 128 + wave * 16 + 4 * fq) = acc;
          } }
        __syncthreads();
    }
#undef GLA_LOAD_A
}

__device__ __forceinline__ void gla_scan(const Args& a, int vcu, int G, int tid) {
    float* ds = (float*)(a.ws + R_DS); const float* dec = (const float*)(a.ws + R_DEC);
    for (int e = vcu * NTHR + tid; e < 16 * 8192; e += G * NTHR) {
        const int bh = e >> 13, de = e & 8191, d = de >> 7;
        float S = 0.f;
#pragma unroll 8
        for (int n = 0; n < 64; ++n) { const int unit = bh * 64 + n; float* p = ds + (size_t)unit * 8192 + de;
            const float t = *p; const float dc = dec[unit * 64 + d]; *p = S; S = dc * S + t; }
    }
}

__device__ __forceinline__ void gla_phase_b(const Args& a, unsigned char* lds, int vcu, int G, int tid) {
    unsigned char* ws = a.ws;
    float* bl = (float*)(lds + GL_BL); float* gt = (float*)(lds + GL_GT); float* part = (float*)(lds + GL_PART); float* wt = (float*)(lds + GL_WT);
    unsigned char* qd = lds + GL_QD; unsigned char* kd = lds + GL_KD; unsigned char* qb = lds + GL_QB; unsigned char* vv = lds + GL_VV; unsigned char* ss = lds + GL_SS;
    const bf16* gq = (const bf16*)(ws + R_GQ); const bf16* gk = (const bf16*)(ws + R_GK); const bf16* gv = (const bf16*)(ws + R_GV); const bf16* gr = (const bf16*)(ws + R_GR);
    const float* alr = (const float*)(ws + R_ALR); const float* sp = (const float*)(ws + R_DS);
    bf16* ao = (bf16*)(ws + R_AO); const float* hg = a.in[5];
    const int lane = tid & 63, wave = tid >> 6, fr = lane & 15, fq = lane >> 4;
    const int Ti = wave & 3, eh = wave >> 2;
    const int c = tid >> 3, sub = tid & 7, d0 = sub * 8, e0 = sub * 16;
    f32x4 ar[4]; v4u qw, kw, vw0, vw1; f32x4 s0, s1, s2, s3;
#define GLA_LOAD_B(unit_) do { const int bb_ = (unit_) >> 8, h_ = ((unit_) >> 6) & 3, n_ = (unit_) & 63; const size_t row_ = (size_t)bb_ * SEQ + n_ * 64 + c; \
        const f32x4* ap_ = (const f32x4*)(alr + row_ * 16); ar[0] = ap_[0]; ar[1] = ap_[1]; ar[2] = ap_[2]; ar[3] = ap_[3]; \
        qw = *(const v4u*)(gq + row_ * 256 + h_ * 64 + d0); kw = *(const v4u*)(gk + row_ * 256 + h_ * 64 + d0); \
        const v4u* vs_ = (const v4u*)(gv + row_ * 512 + h_ * 128 + e0); vw0 = vs_[0]; vw1 = vs_[1]; \
        const f32x4* sr_ = (const f32x4*)(sp + (size_t)(unit_) * 8192 + c * 128 + e0); s0 = sr_[0]; s1 = sr_[1]; s2 = sr_[2]; s3 = sr_[3]; } while (0)
    int hcur = -1;
    if (vcu < NUNIT_GLA) GLA_LOAD_B(vcu);
    for (int unit = vcu; unit < NUNIT_GLA; unit += G) {
        const int bb = unit >> 8, h = (unit >> 6) & 3, n = unit & 63, row0 = bb * SEQ + n * 64;
        if (h != hcur) { hcur = h; gla_stage_gate(wt, a.in[3], a.in[4], h, tid); __syncthreads(); }
        gla_cumdecay(bl, gt, ar, wt, tid);
        { const unsigned qa[4] = {qw.x, qw.y, qw.z, qw.w}, ka[4] = {kw.x, kw.y, kw.z, kw.w};
          unsigned oqd[4], okd[4], oqb[4];
#pragma unroll
          for (int j = 0; j < 4; ++j) {
              const int d = d0 + 2 * j;
              const float b0 = bl[c * 64 + d], b1 = bl[c * 64 + d + 1], m0 = bl[32 * 64 + d], m1 = bl[32 * 64 + d + 1];
              const float q0 = __builtin_bit_cast(float, qa[j] << 16), q1 = __builtin_bit_cast(float, qa[j] & 0xffff0000u), k0 = __builtin_bit_cast(float, ka[j] << 16), k1 = __builtin_bit_cast(float, ka[j] & 0xffff0000u);
              oqd[j] = pk2(q0 * __expf(b0 - m0), q1 * __expf(b1 - m1)); okd[j] = pk2(k0 * __expf(m0 - b0), k1 * __expf(m1 - b1)); oqb[j] = pk2(q0 * __expf(b0), q1 * __expf(b1)); }
          *(v4u*)(qd + c * GL_RS64 + d0 * 2) = (v4u){oqd[0], oqd[1], oqd[2], oqd[3]};
          *(v4u*)(kd + c * GL_RS64 + d0 * 2) = (v4u){okd[0], okd[1], okd[2], okd[3]};
          *(v4u*)(qb + c * GL_RS64 + d0 * 2) = (v4u){oqb[0], oqb[1], oqb[2], oqb[3]};
          *(v4u*)(vv + c * GL_RS128 + e0 * 2) = vw0; *(v4u*)(vv + c * GL_RS128 + e0 * 2 + 16) = vw1;
          *(v4u*)(ss + c * GL_RS128 + e0 * 2) = (v4u){pk2(s0[0], s0[1]), pk2(s0[2], s0[3]), pk2(s1[0], s1[1]), pk2(s1[2], s1[3])};
          *(v4u*)(ss + c * GL_RS128 + e0 * 2 + 16) = (v4u){pk2(s2[0], s2[1]), pk2(s2[2], s2[3]), pk2(s3[0], s3[1]), pk2(s3[2], s3[3])}; }
        if (unit + G < NUNIT_GLA) GLA_LOAD_B(unit + G);
        const size_t orow = (size_t)(row0 + Ti * 16 + fr);
        unsigned long long gw2[4];
#pragma unroll
        for (int et = 0; et < 4; ++et) gw2[et] = *(const unsigned long long*)(gr + orow * 512 + h * 128 + eh * 64 + et * 16 + 4 * fq);
        __syncthreads();
        const bf16x8 qf0 = frag_row(qd, GL_RS64, Ti * 16, 0, fr, fq), qf1 = frag_row(qd, GL_RS64, Ti * 16, 32, fr, fq);
        f32x4 at[4];
#pragma unroll
        for (int Tj = 0; Tj < 4; ++Tj) {
            at[Tj] = (f32x4){0.f, 0.f, 0.f, 0.f};
            if (Tj <= Ti) {
                const bf16x8 kf0 = frag_row(kd, GL_RS64, Tj * 16, 0, fr, fq), kf1 = frag_row(kd, GL_RS64, Tj * 16, 32, fr, fq);
                at[Tj] = __builtin_amdgcn_mfma_f32_16x16x32_bf16(kf0, qf0, at[Tj], 0, 0, 0);
                at[Tj] = __builtin_amdgcn_mfma_f32_16x16x32_bf16(kf1, qf1, at[Tj], 0, 0, 0);
#pragma unroll
                for (int r = 0; r < 4; ++r) if (Tj * 16 + 4 * fq + r > Ti * 16 + fr) at[Tj][r] = 0.f;
            }
        }
        bf16x8 pf[2];
#pragma unroll
        for (int kk = 0; kk < 2; ++kk) { v4u w_;
            w_.x = pg8::cvt_pk_bf16(at[2 * kk][0], at[2 * kk][1]); w_.y = pg8::cvt_pk_bf16(at[2 * kk][2], at[2 * kk][3]);
            w_.z = pg8::cvt_pk_bf16(at[2 * kk + 1][0], at[2 * kk + 1][1]); w_.w = pg8::cvt_pk_bf16(at[2 * kk + 1][2], at[2 * kk + 1][3]);
            pf[kk] = __builtin_bit_cast(bf16x8, w_); }
        const bf16x8 qbf0 = frag_row_perm(qb, GL_RS64, Ti * 16, 0, 16, fr, fq), qbf1 = frag_row_perm(qb, GL_RS64, Ti * 16, 32, 48, fr, fq);
        f32x4 o[4]; float ssq = 0.f;
#pragma unroll
        for (int et = 0; et < 4; ++et) {
            const int ecol = eh * 64 + et * 16;
            f32x4 acc = {0.f, 0.f, 0.f, 0.f};
            acc = __builtin_amdgcn_mfma_f32_16x16x32_bf16(frag_tr(vv, GL_RS128, 0, 16, ecol, fr, fq), pf[0], acc, 0, 0, 0);
            if (Ti >= 2) acc = __builtin_amdgcn_mfma_f32_16x16x32_bf16(frag_tr(vv, GL_RS128, 32, 48, ecol, fr, fq), pf[1], acc, 0, 0, 0);
            acc = __builtin_amdgcn_mfma_f32_16x16x32_bf16(frag_tr(ss, GL_RS128, 0, 16, ecol, fr, fq), qbf0, acc, 0, 0, 0);
            acc = __builtin_amdgcn_mfma_f32_16x16x32_bf16(frag_tr(ss, GL_RS128, 32, 48, ecol, fr, fq), qbf1, acc, 0, 0, 0);
            o[et] = acc;
            ssq += (acc[0] * acc[0] + acc[1] * acc[1]) + (acc[2] * acc[2] + acc[3] * acc[3]);
        }
        ssq += __shfl_xor(ssq, 16); ssq += __shfl_xor(ssq, 32);
        if (fq == 0) part[wave * 16 + fr] = ssq;
        __syncthreads();
        { const float tot = part[wave * 16 + fr] + part[(wave ^ 4) * 16 + fr];
          const float rs = __builtin_amdgcn_rsqf(tot * (1.0f / 128.0f) + 1e-6f);
#pragma unroll
          for (int et = 0; et < 4; ++et) {
              const int e = eh * 64 + et * 16 + 4 * fq;
              const unsigned long long g2 = gw2[et];
              const f32x4 hv = *(const f32x4*)(hg + e);
              f32x4 y;
              y[0] = o[et][0] * rs * hv[0] * pg8::silu_f(__builtin_bit_cast(float, (unsigned)(g2 << 16)));
              y[1] = o[et][1] * rs * hv[1] * pg8::silu_f(__builtin_bit_cast(float, (unsigned)g2 & 0xffff0000u));
              y[2] = o[et][2] * rs * hv[2] * pg8::silu_f(__builtin_bit_cast(float, (unsigned)(g2 >> 32) << 16));
              y[3] = o[et][3] * rs * hv[3] * pg8::silu_f(__builtin_bit_cast(float, (unsigned)(g2 >> 32) & 0xffff0000u));
              pg8::st_bf16x4(ao + orow * 1024 + h * 128 + e, y);
          } }
        __syncthreads();
    }
#undef GLA_LOAD_B
}

__device__ __forceinline__ unsigned f2key(float f) { const unsigned u = __builtin_bit_cast(unsigned, f); return (u & 0x80000000u) ? ~u : (u | 0x80000000u); }

typedef float f32x16 __attribute__((ext_vector_type(16)));
__device__ __forceinline__ int wave_sum_i(int v) {
    v += __builtin_amdgcn_update_dpp(0, v, 0xB1, 0xf, 0xf, true);
    v += __builtin_amdgcn_update_dpp(0, v, 0x4E, 0xf, 0xf, true);
    v += __builtin_amdgcn_update_dpp(0, v, 0x141, 0xf, 0xf, true);
    v += __builtin_amdgcn_update_dpp(0, v, 0x140, 0xf, 0xf, true);
    return (__builtin_amdgcn_readlane(v, 0) + __builtin_amdgcn_readlane(v, 16)) + (__builtin_amdgcn_readlane(v, 32) + __builtin_amdgcn_readlane(v, 48));
}
__device__ __forceinline__ void sel_score(unsigned* sc, const bf16* iq, const bf16* ik, const float* iw, int bb, int t0, int lane_in, int wave) {
    int lane = lane_in; asm volatile("" : "+v"(lane));
    const int r32 = lane & 31, hh = lane >> 5;
    const size_t qrow0 = (size_t)bb * SEQ + t0;
    bf16x8 af[4];
#pragma unroll
    for (int ks = 0; ks < 4; ++ks) af[ks] = *(const bf16x8*)(iq + (qrow0 + (r32 >> 2)) * 256 + (r32 & 3) * 64 + ks * 16 + hh * 8);
    f32x4 w[4];
#pragma unroll
    for (int j = 0; j < 4; ++j) w[j] = *(const f32x4*)(iw + (qrow0 + 2 * j + hh) * 4);
    const int ntile = ((t0 + 7) >> 5) + 1;
    const bf16* ikb = ik + (size_t)bb * SEQ * 64 + lane * 8;
#define SEL_LOAD(dst, tb) do { _Pragma("unroll") for (int k_ = 0; k_ < 2; ++k_) { int tl_ = (tb) + 8 * k_; tl_ = tl_ > 127 ? 127 : tl_; \
        const bf16* kr_ = ikb + (size_t)tl_ * 2048; _Pragma("unroll") for (int ks = 0; ks < 4; ++ks) dst[k_][ks] = *(const bf16x8*)(kr_ + ks * 512); } } while (0)
#define SEL_COMP(src, tb) do { _Pragma("unroll") for (int k_ = 0; k_ < 2; ++k_) { const int tile_ = (tb) + 8 * k_; if (tile_ < ntile) { const int key_ = tile_ * 32 + r32; \
        f32x16 dd; _Pragma("unroll") for (int e = 0; e < 16; ++e) dd[e] = 0.f; \
        _Pragma("unroll") for (int ks = 0; ks < 4; ++ks) dd = __builtin_amdgcn_mfma_f32_32x32x16_bf16(af[ks], src[k_][ks], dd, 0, 0, 0); \
        _Pragma("unroll") for (int j = 0; j < 4; ++j) { \
            const float s_ = (w[j][0] * fmaxf(dd[4 * j], 0.f) + w[j][1] * fmaxf(dd[4 * j + 1], 0.f)) + (w[j][2] * fmaxf(dd[4 * j + 2], 0.f) + w[j][3] * fmaxf(dd[4 * j + 3], 0.f)) + 0.0f; \
            const int q_ = 2 * j + hh; const unsigned kv_ = f2key(s_); sc[q_ * 4096 + key_] = (key_ <= t0 + q_) ? kv_ : 0u; } } } } while (0)
    bf16x8 bufA[2][4], bufB[2][4];
    int tb = wave;
    SEL_LOAD(bufA, tb);
    for (;;) {
        SEL_LOAD(bufB, tb + 16);
        SEL_COMP(bufA, tb);
        tb += 16; if (tb >= ntile) break;
        SEL_LOAD(bufA, tb + 16);
        SEL_COMP(bufB, tb);
        tb += 16; if (tb >= ntile) break;
    }
#undef SEL_LOAD
#undef SEL_COMP
}
__device__ __forceinline__ void sel_pick(const unsigned (&u)[64], int ng, int ls, int wave, unsigned char* lds, unsigned short* out) {
#define CNT_GE4(a0, a1, a2, a3, v0, v1, v2, v3, thr) do { unsigned long long m0_, m1_, m2_, m3_; \
        asm volatile("v_cmp_ge_u32_e64 %4, %8, %12\n\tv_cmp_ge_u32_e64 %5, %9, %12\n\tv_cmp_ge_u32_e64 %6, %10, %12\n\tv_cmp_ge_u32_e64 %7, %11, %12\n\t" \
                     "v_addc_co_u32_e64 %0, %4, 0, %0, %4\n\tv_addc_co_u32_e64 %1, %5, 0, %1, %5\n\tv_addc_co_u32_e64 %2, %6, 0, %2, %6\n\tv_addc_co_u32_e64 %3, %7, 0, %3, %7" \
                     : "+v"(a0), "+v"(a1), "+v"(a2), "+v"(a3), "=&s"(m0_), "=&s"(m1_), "=&s"(m2_), "=&s"(m3_) : "v"(v0), "v"(v1), "v"(v2), "v"(v3), "v"(thr)); } while (0)
    unsigned T = 0u; int cT = 4096;
#define SEL_STEP(NG, bit_) do { unsigned cand = T | (1u << (bit_)); int c0 = 0, c1 = 0, c2 = 0, c3 = 0; \
        _Pragma("unroll") for (int g8 = 0; g8 < NG; ++g8) { const int j = 8 * g8; \
            CNT_GE4(c0, c1, c2, c3, u[j], u[j + 1], u[j + 2], u[j + 3], cand); CNT_GE4(c0, c1, c2, c3, u[j + 4], u[j + 5], u[j + 6], u[j + 7], cand); } \
        int v_ = (c0 + c1) + (c2 + c3); \
        v_ += __builtin_amdgcn_update_dpp(0, v_, 0xB1, 0xf, 0xf, true); v_ += __builtin_amdgcn_update_dpp(0, v_, 0x4E, 0xf, 0xf, true); \
        v_ += __builtin_amdgcn_update_dpp(0, v_, 0x141, 0xf, 0xf, true); v_ += __builtin_amdgcn_update_dpp(0, v_, 0x140, 0xf, 0xf, true); \
        { auto s_ = __builtin_amdgcn_permlane16_swap((unsigned)v_, (unsigned)v_, false, false); v_ = (int)(s_[0] + s_[1]); \
          auto t_ = __builtin_amdgcn_permlane32_swap((unsigned)v_, (unsigned)v_, false, false); v_ = (int)(t_[0] + t_[1]); } \
        const bool ge_ = v_ >= 256; T = ge_ ? cand : T; cT = ge_ ? v_ : cT; } while (0)
#define SEL_LOOP(NG) do { _Pragma("unroll 1") for (int bit = 31; bit >= 1; bit -= 2) { SEL_STEP(NG, bit); SEL_STEP(NG, bit - 1); \
        if (__builtin_amdgcn_readfirstlane(cT) == 256) break; } } while (0)
    switch (ng) { case 1: SEL_LOOP(1); break; case 2: SEL_LOOP(2); break; case 3: SEL_LOOP(3); break; case 4: SEL_LOOP(4); break;
                  case 5: SEL_LOOP(5); break; case 6: SEL_LOOP(6); break; case 7: SEL_LOOP(7); break; default: SEL_LOOP(8); break; }
    cT = __builtin_amdgcn_readfirstlane(cT); T = __builtin_amdgcn_readfirstlane(T);
#undef SEL_LOOP
#undef SEL_STEP
#undef CNT_GE4
    unsigned short* lst = (unsigned short*)(lds + 131072) + wave * 512;
    if (cT == 256) {
        unsigned wlo = 0u, whi = 0u;
#pragma unroll
        for (int j = 0; j < 64; ++j) if ((j >> 3) < ng) { const unsigned long long m_ = __ballot(u[j] >= T);
            wlo = (ls == j) ? (unsigned)m_ : wlo; whi = (ls == j) ? (unsigned)(m_ >> 32) : whi; }
        const int cl = __popc(wlo) + __popc(whi);
        int inc = cl;
        inc += __builtin_amdgcn_update_dpp(0, inc, 0x111, 0xf, 0xf, true); inc += __builtin_amdgcn_update_dpp(0, inc, 0x112, 0xf, 0xf, true);
        inc += __builtin_amdgcn_update_dpp(0, inc, 0x114, 0xf, 0xf, true); inc += __builtin_amdgcn_update_dpp(0, inc, 0x118, 0xf, 0xf, true);
        inc += __builtin_amdgcn_update_dpp(0, inc, 0x142, 0xa, 0xf, false); inc += __builtin_amdgcn_update_dpp(0, inc, 0x143, 0xc, 0xf, false);
        int off = inc - cl;
        while (__any((wlo | whi) != 0u)) {
            const bool has = (wlo | whi) != 0u;
            const int b_ = wlo ? __builtin_ctz(wlo) : 32 + __builtin_ctz(whi | 0x80000000u * (whi == 0u));
            lst[has ? off : 256 + ls] = (unsigned short)(ls * 64 + b_);
            off += has ? 1 : 0;
            if (wlo) wlo &= wlo - 1u; else whi &= whi - 1u;
        }
    } else {
        int ngt = 0;
#pragma unroll
        for (int j = 0; j < 64; ++j) if ((j >> 3) < ng) ngt += __popcll(__ballot(u[j] > T));
        const int need = 256 - ngt;
        const unsigned long long lt = (1ull << ls) - 1ull;
        int base = 0, eqt = 0;
#pragma unroll
        for (int j = 0; j < 64; ++j) if ((j >> 3) < ng) {
            const bool eq = (u[j] == T);
            const unsigned long long me = __ballot(eq);
            const bool take = (u[j] > T) || (eq && (eqt + __popcll(me & lt) < need));
            const unsigned long long mf = __ballot(take);
            lst[take ? base + __popcll(mf & lt) : 256 + ls] = (unsigned short)(j * 64 + ls);
            base += __popcll(mf); eqt += __popcll(me);
        }
    }
    LDS_WAIT(); asm volatile("" ::: "memory");
    *(unsigned long long*)(out + 4 * ls) = *(const unsigned long long*)(lst + 4 * ls);
}
__device__ __forceinline__ void dsa_select(const Args& a, unsigned char* lds, int vcu, int G, int tid) {
    unsigned char* ws = a.ws;
    const int lane0 = tid & 63, wave = __builtin_amdgcn_readfirstlane(tid >> 6);
    unsigned* sc = (unsigned*)lds;
    const bf16* iq = (const bf16*)(ws + R_IQ); const bf16* ik = (const bf16*)(ws + R_IK); const float* iw = (const float*)(ws + R_IW);
    unsigned short* idx = (unsigned short*)(ws + R_IDX);
    const int ngrp = vcu < 1024 ? 2 * ((1024 - vcu + G - 1) / G) : 0;
#define GRP(j, bb_, t0_) const int p_ = vcu + ((j) >> 1) * G; const int bb_ = p_ >> 8, x_ = p_ & 255, t0_ = (((j) & 1) ? (511 - x_) : x_) * 8
    if (ngrp > 0) { GRP(0, bb0, t00); if (t00 >= 256) sel_score(sc, iq, ik, iw, bb0, t00, lane0, wave); }
    __syncthreads();
#pragma unroll 1
    for (int j = 0; j < ngrp; ++j) {
        GRP(j, bb, t0);
        const int t = t0 + wave;
        unsigned short* out = idx + ((size_t)bb * SEQ + t) * 256;
        int ls = lane0; asm volatile("" : "+v"(ls));
        const bool trivial = t0 < 256;
        const int ng = __builtin_amdgcn_readfirstlane(((t >> 6) + 8) >> 3);
        unsigned u[64];
        if (!trivial) {
            const unsigned* scq = sc + wave * 4096;
            const int tl = t - ls;
#pragma unroll
            for (int g8 = 0; g8 < 8; ++g8) {
                if (g8 < ng) {
#pragma unroll
                    for (int jj = 8 * g8; jj < 8 * g8 + 8; ++jj) { const unsigned v_ = scq[jj * 64 + ls]; u[jj] = (jj * 64 <= tl) ? v_ : 0u; }
                } else {
#pragma unroll
                    for (int jj = 8 * g8; jj < 8 * g8 + 8; ++jj) u[jj] = 0u;
                }
            }
        } else {
#pragma unroll
            for (int jj = 0; jj < 64; ++jj) u[jj] = 0u;
        }
        LDS_WAIT();
        __syncthreads();
#pragma unroll 1
        for (int step = 0; step < 2; ++step) {
            if ((step == 0) == (wave < 4)) {
                if (trivial) {
#pragma unroll
                    for (int q4 = 0; q4 < 4; ++q4) { const int kk = q4 * 64 + ls; out[kk] = (unsigned short)(kk <= t ? kk : 0xFFFF); }
                } else sel_pick(u, ng, ls, wave, lds, out);
            } else if (j + 1 < ngrp) {
                GRP(j + 1, bbn, t0n);
                if (t0n >= 256) sel_score(sc, iq, ik, iw, bbn, t0n, lane0, wave);
            }
        }
        __syncthreads();
    }
#undef GRP
}

__device__ __forceinline__ void dsa_attend(const Args& a, unsigned char* lds, int vcu, int G, int tid) {
    unsigned char* ws = a.ws;
    const int lane0 = tid & 63, wave = __builtin_amdgcn_readfirstlane(tid >> 6);
    unsigned char* wl = lds + wave * 12288;
    int* kl = (int*)(wl + 10240);
    const bf16* bq = (const bf16*)(ws + R_BQ); const bf16* bk = (const bf16*)(ws + R_BK); const bf16* bv = (const bf16*)(ws + R_BV);
    const unsigned short* idx = (const unsigned short*)(ws + R_IDX);
    bf16* ao = (bf16*)(ws + R_AO);
    const int gw = vcu * NWAVES + wave, NGW = G * NWAVES;
    const int nq = 2 * ((M / 2 - gw + NGW - 1) / NGW);
    unsigned long long nw4; bf16x8 nqf0, nqf1;
#define ATT_Q(i, bb_, t_) const int p_ = gw + ((i) >> 1) * NGW; const int bb_ = p_ >> 11, x_ = p_ & 2047, t_ = ((i) & 1) ? (SEQ - 1 - x_) : x_
    { ATT_Q(0, bb0, t0); const size_t q0 = (size_t)bb0 * SEQ + t0;
      nw4 = *(const unsigned long long*)(idx + q0 * 256 + 4 * lane0);
      nqf0 = *(const bf16x8*)(bq + q0 * 512 + (lane0 & 7) * 64 + (lane0 >> 4) * 8); nqf1 = *(const bf16x8*)(bq + q0 * 512 + (lane0 & 7) * 64 + 32 + (lane0 >> 4) * 8); }
#pragma unroll 1
    for (int i = 0; i < nq; ++i) {
        int lane = lane0; asm volatile("" : "+v"(lane));
        const int fr = lane & 15, fq = lane >> 4;
        ATT_Q(i, bb, t);
        const size_t q = (size_t)bb * SEQ + t;
        const int cnt = t < 255 ? t + 1 : 256;
        { const unsigned long long w4 = nw4;
          int k0 = (int)(w4 & 0xffffu), k1 = (int)((w4 >> 16) & 0xffffu), k2 = (int)((w4 >> 32) & 0xffffu), k3 = (int)(w4 >> 48);
          const int p0 = 4 * lane;
          k0 = p0 < cnt ? k0 : 0; k1 = p0 + 1 < cnt ? k1 : 0; k2 = p0 + 2 < cnt ? k2 : 0; k3 = p0 + 3 < cnt ? k3 : 0;
          *(v4u*)(kl + p0) = (v4u){(unsigned)k0, (unsigned)k1, (unsigned)k2, (unsigned)k3}; }
        const bf16x8 qf0 = nqf0, qf1 = nqf1;
        LDS_WAIT(); asm volatile("" ::: "memory");
        const bf16* bkb = bk + (size_t)bb * SEQ * 64 + fq * 8;
        const bf16* bvb = bv + (size_t)bb * SEQ * 64 + (lane & 7) * 8;
        bf16x8 kf[16][2];
#pragma unroll
        for (int T = 0; T < 16; ++T) { const bf16* kp = bkb + (size_t)kl[T * 16 + fr] * 64; kf[T][0] = *(const bf16x8*)kp; kf[T][1] = *(const bf16x8*)(kp + 32); }
        v4u vreg[8];
#pragma unroll
        for (int i2 = 0; i2 < 8; ++i2) vreg[i2] = *(const v4u*)(bvb + (size_t)kl[(lane >> 3) + 8 * i2] * 64);
        if (i + 1 < nq) { ATT_Q(i + 1, bbn, tn); const size_t qn = (size_t)bbn * SEQ + tn;
            nw4 = *(const unsigned long long*)(idx + qn * 256 + 4 * lane);
            nqf0 = *(const bf16x8*)(bq + qn * 512 + (fr & 7) * 64 + fq * 8); nqf1 = *(const bf16x8*)(bq + qn * 512 + (fr & 7) * 64 + 32 + fq * 8); }
        f32x4 s[16];
#pragma unroll
        for (int T = 0; T < 16; ++T) {
            f32x4 z = {0.f, 0.f, 0.f, 0.f};
            z = __builtin_amdgcn_mfma_f32_16x16x32_bf16(kf[T][0], qf0, z, 0, 0, 0);
            s[T] = __builtin_amdgcn_mfma_f32_16x16x32_bf16(kf[T][1], qf1, z, 0, 0, 0);
        }
        float mx = -INFINITY;
#pragma unroll
        for (int T = 0; T < 16; ++T)
#pragma unroll
            for (int r = 0; r < 4; ++r) { if (T * 16 + 4 * fq + r >= cnt) s[T][r] = -INFINITY; mx = fmaxf(mx, s[T][r]); }
        mx = fmaxf(mx, __shfl_xor(mx, 16)); mx = fmaxf(mx, __shfl_xor(mx, 32));
        float sum = 0.f;
#pragma unroll
        for (int T = 0; T < 16; ++T)
#pragma unroll
            for (int r = 0; r < 4; ++r) { const float pv = __expf(s[T][r] - mx); s[T][r] = pv; sum += pv; }
        sum += __shfl_xor(sum, 16); sum += __shfl_xor(sum, 32);
        const float inv = __builtin_amdgcn_rcpf(sum);
        bf16x8 pf[8];
#pragma unroll
        for (int kk = 0; kk < 8; ++kk) { v4u w_;
            w_.x = pg8::cvt_pk_bf16(s[2 * kk][0], s[2 * kk][1]); w_.y = pg8::cvt_pk_bf16(s[2 * kk][2], s[2 * kk][3]);
            w_.z = pg8::cvt_pk_bf16(s[2 * kk + 1][0], s[2 * kk + 1][1]); w_.w = pg8::cvt_pk_bf16(s[2 * kk + 1][2], s[2 * kk + 1][3]);
            pf[kk] = __builtin_bit_cast(bf16x8, w_); }
        f32x4 o[4];
#pragma unroll
        for (int dt = 0; dt < 4; ++dt) o[dt] = (f32x4){0.f, 0.f, 0.f, 0.f};
        const unsigned char* trb = wl + (4 * fq + (fr >> 2)) * 160 + (fr & 3) * 8;
#pragma unroll
        for (int c = 0; c < 4; ++c) {
#pragma unroll
            for (int i2 = 0; i2 < 8; ++i2) *(v4u*)(wl + ((lane >> 3) + 8 * i2) * 160 + (lane & 7) * 16) = vreg[i2];
            if (c < 3) {
#pragma unroll
                for (int i2 = 0; i2 < 8; ++i2) vreg[i2] = *(const v4u*)(bvb + (size_t)kl[64 * (c + 1) + (lane >> 3) + 8 * i2] * 64);
            }
            LDS_WAIT(); asm volatile("" ::: "memory");
#pragma unroll
            for (int k2 = 0; k2 < 2; ++k2)
#pragma unroll
                for (int dt = 0; dt < 4; ++dt) {
                    const v4i16_t a0 = tr16(trb + (2 * k2) * 16 * 160 + dt * 32), a1 = tr16(trb + (2 * k2 + 1) * 16 * 160 + dt * 32);
                    const bf16x8 vf = {a0[0], a0[1], a0[2], a0[3], a1[0], a1[1], a1[2], a1[3]};
                    o[dt] = __builtin_amdgcn_mfma_f32_16x16x32_bf16(vf, pf[2 * c + k2], o[dt], 0, 0, 0);
                }
            LDS_WAIT(); asm volatile("" ::: "memory");
        }
        if (fr < 8) {
#pragma unroll
            for (int dt = 0; dt < 4; ++dt) pg8::st_bf16x4(ao + q * 1024 + 512 + fr * 64 + dt * 16 + 4 * fq, o[dt] * inv);
        }
    }
#undef ATT_Q
}

__device__ __forceinline__ void ffn_fixup(const Args& a, int layer, int vcu, int G, int tid) {
    unsigned char* ws = a.ws;
    const float* hl = (const float*)(ws + R_HL); const float* hf = (const float*)(ws + R_HF);
    const float* cw = a.in[16] + (size_t)layer * 3 * DFF2; const float* cb = a.in[17] + (size_t)layer * DFF2;
    bf16* gt = (bf16*)(ws + R_GT);
    for (int it = vcu * NTHR + tid; it < 256 * 2 * (DFF / 4); it += G * NTHR) {
        const int cg = it % (DFF / 4), rr = (it / (DFF / 4)) & 1, blk = it / (2 * (DFF / 4));
        const int g0 = cg * 4; const bool bstart = (blk & 63) == 0;
        const f32x4 z4 = {0.f, 0.f, 0.f, 0.f};
        f32x4 a0g, a0u, a1g, a1u, a2g, a2u;
        { const float* h0 = hf + (size_t)(blk * 2 + rr) * DFF2 + g0; a0g = *(const f32x4*)h0; a0u = *(const f32x4*)(h0 + DFF); }
        if (rr == 1) {
            const float* h1 = hf + (size_t)(blk * 2) * DFF2 + g0; a1g = *(const f32x4*)h1; a1u = *(const f32x4*)(h1 + DFF);
            if (bstart) { a2g = z4; a2u = z4; } else { const float* h2 = hl + (size_t)((blk - 1) * 2 + 1) * DFF2 + g0; a2g = *(const f32x4*)h2; a2u = *(const f32x4*)(h2 + DFF); }
        } else {
            if (bstart) { a1g = z4; a1u = z4; a2g = z4; a2u = z4; }
            else { const float* h1 = hl + (size_t)((blk - 1) * 2 + 1) * DFF2 + g0; a1g = *(const f32x4*)h1; a1u = *(const f32x4*)(h1 + DFF);
                   const float* h2 = hl + (size_t)((blk - 1) * 2) * DFF2 + g0; a2g = *(const f32x4*)h2; a2u = *(const f32x4*)(h2 + DFF); }
        }
        const f32x4 cgv = *(const f32x4*)(cb + g0) + *(const f32x4*)(cw + g0) * a2g + *(const f32x4*)(cw + DFF2 + g0) * a1g + *(const f32x4*)(cw + 2 * DFF2 + g0) * a0g;
        const f32x4 cuv = *(const f32x4*)(cb + DFF + g0) + *(const f32x4*)(cw + DFF + g0) * a2u + *(const f32x4*)(cw + DFF2 + DFF + g0) * a1u + *(const f32x4*)(cw + 2 * DFF2 + DFF + g0) * a0u;
        f32x4 o; o[0] = pg8::silu_f(cgv[0]) * cuv[0]; o[1] = pg8::silu_f(cgv[1]) * cuv[1]; o[2] = pg8::silu_f(cgv[2]) * cuv[2]; o[3] = pg8::silu_f(cgv[3]) * cuv[3];
        pg8::st_bf16x4(gt + (size_t)(blk * 64 + rr) * DFF + g0, o);
    }
}

__device__ __forceinline__ void sgu_mix(const Args& a, unsigned char* lds, int vcu, int G, int tid) {
    unsigned char* ws = a.ws;
    constexpr int RSV = 288, RSW = 272;
    unsigned char* vn = lds;
    unsigned char* wl = lds + 128 * RSV;
    const bf16* z = (const bf16*)(ws + R_Z); bf16* sg = (bf16*)(ws + R_SG);
    const float* lns = (const float*)(ws + WS_SSQ) + 5 * M; const float* lnq = lns + M;
    const float* lg = a.in[9]; const float* lb = a.in[10]; const float* wsp = a.in[11]; const float* bs = a.in[12];
    const int lane = tid & 63, wave = tid >> 6, fr = lane & 15, fq = lane >> 4;
    int gcur = -1;
    for (int unit = vcu; unit < 1024; unit += G) {
        const int g = unit & 7, ci = unit >> 3, row0 = ci * 128;
        if (g != gcur) {
            gcur = g;
            const int t = tid >> 2, s0 = (tid & 3) * 32;
            const f32x4* wr = (const f32x4*)(wsp + ((size_t)g * 128 + t) * 128 + s0);
#pragma unroll
            for (int j = 0; j < 4; ++j) { const f32x4 w0 = wr[2 * j], w1 = wr[2 * j + 1]; const int s = s0 + 8 * j;
                *(v4u*)(wl + t * RSW + s * 2) = (v4u){pk2(s <= t ? w0[0] : 0.f, s + 1 <= t ? w0[1] : 0.f), pk2(s + 2 <= t ? w0[2] : 0.f, s + 3 <= t ? w0[3] : 0.f),
                                                     pk2(s + 4 <= t ? w1[0] : 0.f, s + 5 <= t ? w1[1] : 0.f), pk2(s + 6 <= t ? w1[2] : 0.f, s + 7 <= t ? w1[3] : 0.f)}; }
        }
        { const int s = tid >> 2, c0 = (tid & 3) * 32; const size_t row = (size_t)(row0 + s);
          const float mean = lns[row] * (1.0f / 1024.0f); const float var = lnq[row] * (1.0f / 1024.0f) - mean * mean; const float rstd = __builtin_amdgcn_rsqf(var + 1e-5f);
          const v4u* zr = (const v4u*)(z + row * 2048 + 1024 + g * 128 + c0);
#pragma unroll
          for (int j = 0; j < 4; ++j) { const v4u zw = zr[j]; const int c = g * 128 + c0 + 8 * j;
              const f32x4 g0 = *(const f32x4*)(lg + c), g1 = *(const f32x4*)(lg + c + 4), b0 = *(const f32x4*)(lb + c), b1 = *(const f32x4*)(lb + c + 4);
              const float v0 = (__builtin_bit_cast(float, zw.x << 16) - mean) * rstd * g0[0] + b0[0], v1 = (__builtin_bit_cast(float, zw.x & 0xffff0000u) - mean) * rstd * g0[1] + b0[1];
              const float v2 = (__builtin_bit_cast(float, zw.y << 16) - mean) * rstd * g0[2] + b0[2], v3 = (__builtin_bit_cast(float, zw.y & 0xffff0000u) - mean) * rstd * g0[3] + b0[3];
              const float v4 = (__builtin_bit_cast(float, zw.z << 16) - mean) * rstd * g1[0] + b1[0], v5 = (__builtin_bit_cast(float, zw.z & 0xffff0000u) - mean) * rstd * g1[1] + b1[1];
              const float v6 = (__builtin_bit_cast(float, zw.w << 16) - mean) * rstd * g1[2] + b1[2], v7 = (__builtin_bit_cast(float, zw.w & 0xffff0000u) - mean) * rstd * g1[3] + b1[3];
              *(v4u*)(vn + s * RSV + (c0 + 8 * j) * 2) = (v4u){pk2(v0, v1), pk2(v2, v3), pk2(v4, v5), pk2(v6, v7)}; } }
        __syncthreads();
        bf16x8 af[4];
#pragma unroll
        for (int ks = 0; ks < 4; ++ks) af[ks] = frag_tr(vn, RSV, 32 * ks, 32 * ks + 16, wave * 16, fr, fq);
#pragma unroll
        for (int Tt = 0; Tt < 8; ++Tt) {
            f32x4 acc = {0.f, 0.f, 0.f, 0.f};
#pragma unroll
            for (int ks = 0; ks <= Tt / 2; ++ks) acc = __builtin_amdgcn_mfma_f32_16x16x32_bf16(af[ks], frag_row_perm(wl, RSW, Tt * 16, 32 * ks, 32 * ks + 16, fr, fq), acc, 0, 0, 0);
            const int t = Tt * 16 + fr; const size_t row = (size_t)(row0 + t);
            const float bias = bs[g * 128 + t];
            const int col = g * 128 + wave * 16 + 4 * fq;
            const unsigned long long uw = *(const unsigned long long*)(z + row * 2048 + col);
            f32x4 o;
            o[0] = __builtin_bit_cast(float, (unsigned)(uw << 16)) * (acc[0] + bias); o[1] = __builtin_bit_cast(float, (unsigned)uw & 0xffff0000u) * (acc[1] + bias);
            o[2] = __builtin_bit_cast(float, (unsigned)(uw >> 32) << 16) * (acc[2] + bias); o[3] = __builtin_bit_cast(float, (unsigned)(uw >> 32) & 0xffff0000u) * (acc[3] + bias);
            pg8::st_bf16x4(sg + row * 1024 + col, o);
        }
        __syncthreads();
    }
}

__device__ __forceinline__ void final_norm(const Args& a, int vcu, int G, int tid) {
    const int lane = tid & 63, wave = tid >> 6;
    const float* g = a.in[19];
    const bf16* xb = (const bf16*)(a.ws + WS_XB); const float* ssq4 = (const float*)(a.ws + WS_SSQ) + 4 * M;
    for (int m = vcu * NWAVES + wave; m < M; m += G * NWAVES) {
        const float rs = __builtin_amdgcn_rsqf(ssq4[m] * (1.0f / 1024.0f) + 1e-6f);
        const v4u* xr = (const v4u*)(xb + (size_t)m * DM) + lane;
        f32x4* orow = (f32x4*)(a.out + (size_t)m * DM);
#pragma unroll
        for (int j = 0; j < 2; ++j) { const v4u w = xr[64 * j]; const int c = (lane + 64 * j) * 8;
            const f32x4 g0 = *(const f32x4*)(g + c), g1 = *(const f32x4*)(g + c + 4);
            f32x4 o0, o1;
            o0[0] = __builtin_bit_cast(float, w.x << 16) * rs * g0[0]; o0[1] = __builtin_bit_cast(float, w.x & 0xffff0000u) * rs * g0[1];
            o0[2] = __builtin_bit_cast(float, w.y << 16) * rs * g0[2]; o0[3] = __builtin_bit_cast(float, w.y & 0xffff0000u) * rs * g0[3];
            o1[0] = __builtin_bit_cast(float, w.z << 16) * rs * g1[0]; o1[1] = __builtin_bit_cast(float, w.z & 0xffff0000u) * rs * g1[1];
            o1[2] = __builtin_bit_cast(float, w.w << 16) * rs * g1[2]; o1[3] = __builtin_bit_cast(float, w.w & 0xffff0000u) * rs * g1[3];
            orow[c / 4] = o0; orow[c / 4 + 1] = o1; }
    }
}

__device__ __forceinline__ int opq(int x) { asm volatile("" : "+s"(x)); return x; }
__device__ __forceinline__ int opqv(int x) { asm volatile("" : "+v"(x)); return x; }
constexpr int NPHASE = 16;
__global__ void __launch_bounds__(NTHR, 2) fwd_megakernel(Args args) {
    extern __shared__ __attribute__((aligned(16))) unsigned char lds[];
    const int tid = threadIdx.x;
    const int G = gridDim.x; const int bx = blockIdx.x;
    const int vcu = (G % 8 == 0) ? (bx % 8) * (G / 8) + bx / 8 : bx;
    unsigned char* ws = args.ws;
    for (int u = tid; u < (LDS_BYTES - LDSCTL_OFF) / 4; u += NTHR) ((LAS unsigned*)((LAS unsigned char*)lds + LDSCTL_OFF))[u] = 0u;
    __syncthreads();
    XcdBarrier bar; bar.bar = (unsigned*)(ws + WS_CTL) + CW_BAR; bar.x = 0; bar.st = nullptr;
    const int lo = args.ph_lo, hi = args.ph_hi;
    if (hi - lo > 1) bar = xcd_barrier_post((unsigned*)(ws + WS_CTL) + CW_BAR, (volatile LAS unsigned*)((LAS unsigned char*)lds + MISC_OFF) + 8);
#ifdef PHASE_MASK
#define IN(k) (((PHASE_MASK >> (k)) & 1) && lo <= (k) && (k) < hi)
#else
#define IN(k) (lo <= (k) && (k) < hi)
#endif
#define SEAM(k) do { if (IN(k) && IN((k) + 1)) xcd_barrier(bar); } while (0)
    LAS unsigned char* ring = (LAS unsigned char*)lds;
    float* ssq = (float*)(ws + WS_SSQ);
    bf16* xb = (bf16*)(ws + WS_XB);

    if (IN(0)) { p0_prologue(args, lds, opq(vcu), G, opqv(tid)); __syncthreads(); } SEAM(0);

    if (IN(1)) {
        pg8::Gemm g{xb, (const bf16*)(ws + WS_WIN), M, NIN, DM}; pg8::StaticOrder S; S.init(M, NIN, G, opq(bx));
        pg8::EpiIn E{ssq, (const float*)(ws + WS_ROPE), (bf16*)(ws + R_GQ), (bf16*)(ws + R_GK), (bf16*)(ws + R_GV), (bf16*)(ws + R_GR), (bf16*)(ws + R_BQ), (bf16*)(ws + R_BK), (bf16*)(ws + R_BV),
                      (bf16*)(ws + R_IQ), (bf16*)(ws + R_IK), (float*)(ws + R_ALR), (float*)(ws + R_IW)};
        pg8::gemm_phase<pg8::EpiIn, pg8::StaticOrder, true, true>(ring, g, S, E);
        { const int rem = S.nwg % G;
          if (rem == 0) convert_weights(args, lds, bx, G, opqv(tid), CW_E0, CW_E2); else if (bx >= rem) convert_weights(args, lds, bx - rem, G - rem, opqv(tid), CW_E0, CW_E2); }
    } SEAM(1);

    if (IN(2)) { gla_phase_a(args, lds, opq(vcu), G, opqv(tid)); dsa_select(args, lds, opq(vcu), G, opqv(tid)); __syncthreads(); } SEAM(2);
    if (IN(3)) { gla_scan(args, opq(vcu), G, opqv(tid)); dsa_attend(args, lds, opq(vcu), G, opqv(tid)); __syncthreads(); } SEAM(3);
    if (IN(4)) { gla_phase_b(args, lds, opq(vcu), G, opqv(tid)); } SEAM(4);

    if (IN(5)) {
        pg8::Gemm g{(const bf16*)(ws + R_AO), (const bf16*)(ws + WS_WO), M, DM, DM}; pg8::StaticOrder S; S.init(M, DM, G, opq(bx));
        pg8::EpiRes E{xb, ssq + M};
        pg8::gemm_phase<pg8::EpiRes, pg8::StaticOrder, true, true>(ring, g, S, E);
    } SEAM(5);

#pragma unroll 1
    for (int layer = 0; layer < 2; ++layer) {
        const int pb = layer == 0 ? 6 : 12;
        if (IN(pb)) {
            pg8::Gemm g{xb, (const bf16*)(ws + (layer == 0 ? WS_WUP0 : WS_WUP1)), M, DFF2, DM}; pg8::StaticOrder S; S.init(M, DFF2, G, opq(bx));
            pg8::EpiConv E{ssq + (layer == 0 ? 1 : 3) * M, args.in[16] + (size_t)layer * 3 * DFF2, args.in[17] + (size_t)layer * DFF2, (bf16*)(ws + R_GT), (float*)(ws + R_HL), (float*)(ws + R_HF)};
            pg8::gemm_phase<pg8::EpiConv, pg8::StaticOrder, true, true>(ring, g, S, E);
            if (layer == 0) { const int rem = S.nwg % G;
                if (rem == 0) convert_weights(args, lds, bx, G, opqv(tid), CW_E2, CW_E5); else if (bx >= rem) convert_weights(args, lds, bx - rem, G - rem, opqv(tid), CW_E2, CW_E5); }
        } SEAM(pb);
        if (IN(pb + 1)) { ffn_fixup(args, layer, opq(vcu), G, opqv(tid)); } SEAM(pb + 1);
        if (IN(pb + 2)) {
            pg8::Gemm g{(const bf16*)(ws + R_GT), (const bf16*)(ws + (layer == 0 ? WS_WDN0 : WS_WDN1)), M, DM, DFF}; pg8::StaticOrder S; S.init(M, DM, G, opq(bx));
            pg8::EpiRes E{xb, ssq + (layer == 0 ? 2 : 4) * M};
            pg8::gemm_phase<pg8::EpiRes, pg8::StaticOrder, true, true>(ring, g, S, E);
        } SEAM(pb + 2);
        if (layer == 0) {
            if (IN(9)) {
                pg8::Gemm g{xb, (const bf16*)(ws + WS_WUV), M, 2048, DM}; pg8::StaticOrder S; S.init(M, 2048, G, opq(bx));
                pg8::EpiSgu E{ssq + 2 * M, (bf16*)(ws + R_Z), ssq + 5 * M, ssq + 6 * M};
                pg8::gemm_phase<pg8::EpiSgu, pg8::StaticOrder, true, true>(ring, g, S, E);
            } SEAM(9);
            if (IN(10)) { sgu_mix(args, lds, opq(vcu), G, opqv(tid)); } SEAM(10);
            if (IN(11)) {
                pg8::Gemm g{(const bf16*)(ws + R_SG), (const bf16*)(ws + WS_WOUT), M, DM, DM}; pg8::StaticOrder S; S.init(M, DM, G, opq(bx));
                pg8::EpiRes E{xb, ssq + 3 * M};
                pg8::gemm_phase<pg8::EpiRes, pg8::StaticOrder, true, true>(ring, g, S, E);
            } SEAM(11);
        }
    }
    if (IN(15)) { final_norm(args, opq(vcu), G, opqv(tid)); }
#undef IN
#undef SEAM
}

extern "C" void kernel_launch(void* const* d_in, const int* in_sizes, int n_in, void* d_out, int out_size, void* d_ws, size_t ws_size, hipStream_t stream) {
    static int grid = 0;
    if (grid == 0) {
        if (n_in != 20 || out_size != M * DM || ws_size < WS_END) { fprintf(stderr, "kernel_launch: unexpected problem (n_in %d, out %d, ws %zu)\n", n_in, out_size, ws_size); grid = -1; return; }
        int dev = 0, cus = 0, per_cu = 0;
        if (hipGetDevice(&dev) != hipSuccess || hipDeviceGetAttribute(&cus, hipDeviceAttributeMultiprocessorCount, dev) != hipSuccess) { grid = -1; return; }
        if (hipFuncSetAttribute((const void*)fwd_megakernel, hipFuncAttributeMaxDynamicSharedMemorySize, LDS_BYTES) != hipSuccess) { fprintf(stderr, "kernel_launch: hipFuncSetAttribute failed\n"); grid = -1; return; }
        if (hipOccupancyMaxActiveBlocksPerMultiprocessor(&per_cu, (const void*)fwd_megakernel, NTHR, LDS_BYTES) != hipSuccess || per_cu < 1)
            fprintf(stderr, "kernel_launch: note: occupancy query reports %d workgroups per CU\n", per_cu);
        (void)hipGetLastError();
        grid = cus;
    }
    if (grid < 0) return;
    if (hipMemsetAsync((char*)d_ws + WS_CTL, 0, CTL_ZERO_BYTES, stream) != hipSuccess) { fprintf(stderr, "kernel_launch: hipMemsetAsync failed\n"); return; }
    Args a{};
    for (int i = 0; i < 20; ++i) a.in[i] = (const float*)d_in[i];
    a.out = (float*)d_out; a.ws = (unsigned char*)d_ws;
#if MK_MULTI
    for (int p = 0; p < NPHASE; ++p) { a.ph_lo = p; a.ph_hi = p + 1; hipLaunchKernelGGL(fwd_megakernel, dim3(grid), dim3(NTHR), LDS_BYTES, stream, a); }
#else
    a.ph_lo = 0; a.ph_hi = NPHASE;
    hipLaunchKernelGGL(fwd_megakernel, dim3(grid), dim3(NTHR), LDS_BYTES, stream, a);
#endif
    const hipError_t le = hipPeekAtLastError();
    if (le != hipSuccess) fprintf(stderr, "kernel_launch: launch failed: %s\n", hipGetErrorName(le));
}
```

```cpp
#include <hip/hip_runtime.h>
#include <cstdio>
#include <cstdint>

#ifndef MK_MULTI
#define MK_MULTI 0
#endif

namespace pg8 {
#define PG8_LAS __attribute__((address_space(3)))
typedef unsigned short bf16_t;
typedef short bf16x8 __attribute__((ext_vector_type(8)));
typedef float f32x4 __attribute__((ext_vector_type(4)));
typedef unsigned u32x4 __attribute__((ext_vector_type(4)));
constexpr int BM = 256, BK = 64, HALF = 128, HTB = HALF * BK * 2  , STAGE_BYTES = 8 * HTB, NXCD = 8, WGM = 8;

__host__ __device__ __forceinline__ int lds_byte(int r, int c) { const int st = (r >> 4) * 2 + (c >> 5), rr = r & 15, cc = c & 31, ob = rr * 64 + cc * 2; return st * 1024 + (ob ^ (((ob >> 9) & 1) << 5)); }
__host__ __device__ __forceinline__ void stage_rc(int b, int& R, int& C) { const int st = b / 1024, sb = b % 1024, swz = sb ^ (((sb >> 9) & 1) << 5); R = (st >> 1) * 16 + swz / 64; C = (st & 1) * 32 + (swz % 64) / 2; }
__host__ __device__ __forceinline__ int perm32(int rho) { const int n = rho >> 4, i = rho & 15; return 8 * (i >> 2) + 4 * n + (i & 3); }

struct Unit { int pm, pn; };
struct Gemm { const bf16_t* A; const bf16_t* Bt; int M, N, K; };

struct StaticOrder {
    int nM, nN, nwg, G, c;
    __host__ __device__ void init(int M, int N, int G_, int c_) { nM = M / BM; nN = N / BM; nwg = nM * nN; G = G_; c = c_; }
    __host__ __device__ bool next(int i, Unit& u) const {
        const long L = (long)i * G + c; if (L >= nwg) return false;
        int wgid = (int)L; { const int q = nwg / NXCD, r = nwg % NXCD, xcd = wgid % NXCD, off = wgid / NXCD; wgid = (xcd < r ? xcd * (q + 1) : r * (q + 1) + (xcd - r) * q) + off; }
        const int nig = WGM * nN, gid = wgid / nig, fm = gid * WGM, gsz = (nM - fm) < WGM ? (nM - fm) : WGM;
        u.pm = fm + ((wgid % nig) % gsz); u.pn = (wgid % nig) / gsz; return true;
    }
    __device__ __forceinline__ void a_ready(const Unit&) const {}
    __device__ __forceinline__ void done(const Unit&) const {}
};

__device__ __forceinline__ unsigned cvt_pk_bf16(float lo, float hi) { unsigned r; asm volatile("v_cvt_pk_bf16_f32 %0, %1, %2" : "=v"(r) : "v"(lo), "v"(hi)); return r; }
typedef float f32x2 __attribute__((ext_vector_type(2)));
typedef unsigned u32x2 __attribute__((ext_vector_type(2)));
__device__ __forceinline__ void st_bf16x4(bf16_t* p, f32x4 v) { u32x2 w; w.x = cvt_pk_bf16(v[0], v[1]); w.y = cvt_pk_bf16(v[2], v[3]); *(u32x2*)p = w; }
__device__ __forceinline__ float sigm(float x) { return __builtin_amdgcn_rcpf(1.0f + __builtin_amdgcn_exp2f(-1.4426950408889634f * x)); }
__device__ __forceinline__ float silu_f(float x) { return x * sigm(x); }
__device__ __forceinline__ float gelu_tanh_f(float x) { const float u = 0.7978845608028654f * (x + 0.044715f * x * x * x); return x * sigm(2.0f * u); }
__device__ __forceinline__ f32x4 shfl4(f32x4 v, int src) { f32x4 r; r[0] = __shfl(v[0], src); r[1] = __shfl(v[1], src); r[2] = __shfl(v[2], src); r[3] = __shfl(v[3], src); return r; }
__device__ __forceinline__ f32x4 rope4(f32x4 v, const float* tab_t, int fq) {
    const f32x4 cs = *(const f32x4*)(tab_t + 4 * fq);
    f32x4 o; o[0] = v[0] * cs[0] - v[1] * cs[1]; o[1] = v[1] * cs[0] + v[0] * cs[1]; o[2] = v[2] * cs[2] - v[3] * cs[3]; o[3] = v[3] * cs[2] + v[2] * cs[3]; return o;
}

struct EpiIn {
    static constexpr bool PERM = false, AFTER_DRAIN = false;
    const float* ssq; const float* rope;
    bf16_t *gq, *gk, *gv, *gr, *bq, *bk, *bv, *iq, *ik; float *alr, *iw;
    __device__ __forceinline__ void operator()(const f32x4 (&acc)[2][2][4][2], const Unit& u, int wr, int wc, int fr_in, int fq_in) const {
        int fr = fr_in, fq = fq_in; asm volatile("" : "+v"(fr), "+v"(fq));
        const int pn = u.pn;
        float rsv[2][4];
#pragma unroll
        for (int ai = 0; ai < 2; ++ai)
#pragma unroll
            for (int m = 0; m < 4; ++m) rsv[ai][m] = __builtin_amdgcn_rsqf(ssq[u.pm * BM + ai * HALF + wr * 64 + m * 16 + fr] * (1.0f / 1024.0f) + 1e-6f);
#pragma unroll
        for (int ai = 0; ai < 2; ++ai)
#pragma unroll
            for (int m = 0; m < 4; ++m) {
                const int r = u.pm * BM + ai * HALF + wr * 64 + m * 16 + fr;
                const float rs = rsv[ai][m];
                const float* tab_t = rope + (size_t)(r & 4095) * 16;
#pragma unroll
                for (int bj = 0; bj < 2; ++bj)
#pragma unroll
                    for (int n = 0; n < 2; ++n) {
                        f32x4 v = acc[ai][bj][m][n] * rs;
                        const int cl = bj * HALF + wc * 32 + n * 16 + 4 * fq;
                        const bool ropecol = ((wc & 1) == 0) && (n == 0);
                        if (pn == 0) { st_bf16x4(gq + (size_t)r * 256 + cl, v * 0.125f); }
                        else if (pn == 1) { st_bf16x4(gk + (size_t)r * 256 + cl, v); }
                        else if (pn < 4) { st_bf16x4(gv + (size_t)r * 512 + (pn - 2) * 256 + cl, v); }
                        else if (pn < 6) { st_bf16x4(gr + (size_t)r * 512 + (pn - 4) * 256 + cl, v); }
                        else if (pn < 8) { if (ropecol) v = rope4(v, tab_t, fq); st_bf16x4(bq + (size_t)r * 512 + (pn - 6) * 256 + cl, v * 0.125f); }
                        else if (pn == 8) { if (ropecol) v = rope4(v, tab_t, fq); st_bf16x4(iq + (size_t)r * 256 + cl, v); }
                        else {
                            const int reg = bj * 2 + (wc >> 1);
                            const int c64 = cl & 63;
                            if (reg == 0) { if (ropecol) v = rope4(v, tab_t, fq); st_bf16x4(bk + (size_t)r * 64 + c64, v); }
                            else if (reg == 1) { st_bf16x4(bv + (size_t)r * 64 + c64, v); }
                            else if (reg == 2) { if (ropecol) v = rope4(v, tab_t, fq); const int key_ = r & 4095; st_bf16x4(ik + (size_t)(r >> 12) * (4096 * 64) + ((((key_ >> 5) * 4 + (c64 >> 4)) * 64 + ((c64 >> 3) & 1) * 32 + (key_ & 31)) * 8) + (c64 & 7), v); }
                            else if ((wc & 1) == 0) {
                                if (n == 0) *(f32x4*)(alr + (size_t)r * 16 + 4 * fq) = v;
                                else if (fq == 0) *(f32x4*)(iw + (size_t)r * 4) = v * 0.5f;
                            }
                        }
                    }
            }
    }
};

struct EpiRes {
    static constexpr bool PERM = true, AFTER_DRAIN = false;
    bf16_t* xb; float* ssq;
    __device__ __forceinline__ void operator()(const f32x4 (&acc)[2][2][4][2], const Unit& u, int wr, int wc, int fr_in, int fq_in) const {
        int fr = fr_in, fq = fq_in; asm volatile("" : "+v"(fr), "+v"(fq));
#pragma unroll
        for (int ai = 0; ai < 2; ++ai)
#pragma unroll
            for (int m = 0; m < 4; ++m) {
                const int r = u.pm * BM + ai * HALF + wr * 64 + m * 16 + fr;
                float s = 0.f;
#pragma unroll
                for (int bj = 0; bj < 2; ++bj) {
                    const size_t off = (size_t)r * 1024 + u.pn * BM + bj * HALF + wc * 32 + 8 * fq;
                    const u32x4 bw = *(const u32x4*)(xb + off);
                    f32x4 x0 = acc[ai][bj][m][0], x1 = acc[ai][bj][m][1];
                    x0[0] += __builtin_bit_cast(float, bw.x << 16); x0[1] += __builtin_bit_cast(float, bw.x & 0xffff0000u);
                    x0[2] += __builtin_bit_cast(float, bw.y << 16); x0[3] += __builtin_bit_cast(float, bw.y & 0xffff0000u);
                    x1[0] += __builtin_bit_cast(float, bw.z << 16); x1[1] += __builtin_bit_cast(float, bw.z & 0xffff0000u);
                    x1[2] += __builtin_bit_cast(float, bw.w << 16); x1[3] += __builtin_bit_cast(float, bw.w & 0xffff0000u);
                    u32x4 w; w.x = cvt_pk_bf16(x0[0], x0[1]); w.y = cvt_pk_bf16(x0[2], x0[3]); w.z = cvt_pk_bf16(x1[0], x1[1]); w.w = cvt_pk_bf16(x1[2], x1[3]);
                    *(u32x4*)(xb + off) = w;
                    s += ((x0[0] * x0[0] + x0[1] * x0[1]) + (x0[2] * x0[2] + x0[3] * x0[3])) + ((x1[0] * x1[0] + x1[1] * x1[1]) + (x1[2] * x1[2] + x1[3] * x1[3]));
                }
                s += __shfl_xor(s, 16); s += __shfl_xor(s, 32);
                if (fq == 0) atomicAdd(ssq + r, s);
            }
    }
};

struct EpiSgu {
    static constexpr bool PERM = true, AFTER_DRAIN = false;
    const float* ssq; bf16_t* z; float* lns; float* lnq;
    __device__ __forceinline__ void operator()(const f32x4 (&acc)[2][2][4][2], const Unit& u, int wr, int wc, int fr_in, int fq_in) const {
        int fr = fr_in, fq = fq_in; asm volatile("" : "+v"(fr), "+v"(fq));
        const bool vhalf = u.pn >= 4;
        float rsv[2][4];
#pragma unroll
        for (int ai = 0; ai < 2; ++ai)
#pragma unroll
            for (int m = 0; m < 4; ++m) rsv[ai][m] = __builtin_amdgcn_rsqf(ssq[u.pm * BM + ai * HALF + wr * 64 + m * 16 + fr] * (1.0f / 1024.0f) + 1e-6f);
#pragma unroll
        for (int ai = 0; ai < 2; ++ai)
#pragma unroll
            for (int m = 0; m < 4; ++m) {
                const int r = u.pm * BM + ai * HALF + wr * 64 + m * 16 + fr;
                const float rs = rsv[ai][m];
                float s = 0.f, q = 0.f;
#pragma unroll
                for (int bj = 0; bj < 2; ++bj) {
                    f32x4 v0 = acc[ai][bj][m][0] * rs, v1 = acc[ai][bj][m][1] * rs;
#pragma unroll
                    for (int e2 = 0; e2 < 4; ++e2) { v0[e2] = gelu_tanh_f(v0[e2]); v1[e2] = gelu_tanh_f(v1[e2]); }
                    u32x4 w; w.x = cvt_pk_bf16(v0[0], v0[1]); w.y = cvt_pk_bf16(v0[2], v0[3]); w.z = cvt_pk_bf16(v1[0], v1[1]); w.w = cvt_pk_bf16(v1[2], v1[3]);
                    *(u32x4*)(z + (size_t)r * 2048 + u.pn * BM + bj * HALF + wc * 32 + 8 * fq) = w;
                    s += ((v0[0] + v0[1]) + (v0[2] + v0[3])) + ((v1[0] + v1[1]) + (v1[2] + v1[3]));
                    q += ((v0[0] * v0[0] + v0[1] * v0[1]) + (v0[2] * v0[2] + v0[3] * v0[3])) + ((v1[0] * v1[0] + v1[1] * v1[1]) + (v1[2] * v1[2] + v1[3] * v1[3]));
                }
                if (vhalf) {
                    s += __shfl_xor(s, 16); s += __shfl_xor(s, 32); q += __shfl_xor(q, 16); q += __shfl_xor(q, 32);
                    if (fq == 0) { atomicAdd(lns + r, s); atomicAdd(lnq + r, q); }
                }
            }
    }
};

struct EpiConv {
    static constexpr bool PERM = true, AFTER_DRAIN = false;
    const float* ssq; const float* cw; const float* cb; bf16_t* gt; float* hl; float* hf;
    __device__ __forceinline__ void operator()(const f32x4 (&acc)[2][2][4][2], const Unit& u, int wr, int wc, int fr_in, int fq_in) const {
        int fr = fr_in, fq = fq_in; asm volatile("" : "+v"(fr), "+v"(fq));
        const int lane = fq * 16 + fr;
        const int s1 = (lane & 48) | ((fr + 15) & 15), s2 = (lane & 48) | ((fr + 14) & 15);
        float rs[2][4];
#pragma unroll
        for (int ai = 0; ai < 2; ++ai)
#pragma unroll
            for (int m = 0; m < 4; ++m) rs[ai][m] = __builtin_amdgcn_rsqf(ssq[u.pm * BM + ai * HALF + wr * 64 + m * 16 + fr] * (1.0f / 1024.0f) + 1e-6f);
        u32x2 keep[2][4];
#pragma unroll
        for (int n = 0; n < 2; ++n) {
            asm volatile("" ::: "memory");
            const int g0 = u.pn * 128 + wc * 32 + 8 * fq + 4 * n;
            const f32x4 bg = *(const f32x4*)(cb + g0), wg0 = *(const f32x4*)(cw + g0), wg1 = *(const f32x4*)(cw + 5632 + g0), wg2 = *(const f32x4*)(cw + 2 * 5632 + g0);
            const f32x4 bu = *(const f32x4*)(cb + 2816 + g0), wu0 = *(const f32x4*)(cw + 2816 + g0), wu1 = *(const f32x4*)(cw + 5632 + 2816 + g0), wu2 = *(const f32x4*)(cw + 2 * 5632 + 2816 + g0);
#pragma unroll
            for (int ai = 0; ai < 2; ++ai) {
                const int blk = u.pm * 4 + ai * 2 + wr;
                f32x4 pg1 = {0.f, 0.f, 0.f, 0.f}, pg2 = pg1, pu1 = pg1, pu2 = pg1;
#pragma unroll
                for (int m = 0; m < 4; ++m) {
                    const int r = u.pm * BM + ai * HALF + wr * 64 + m * 16 + fr;
                    const f32x4 ag = acc[ai][0][m][n] * rs[ai][m], au = acc[ai][1][m][n] * rs[ai][m];
                    if (m == 3 && fr >= 14) { float* h = hl + (size_t)(blk * 2 + (fr - 14)) * 5632 + g0; *(f32x4*)h = ag; *(f32x4*)(h + 2816) = au; }
                    if (m == 0 && fr < 2) { float* h = hf + (size_t)(blk * 2 + fr) * 5632 + g0; *(f32x4*)h = ag; *(f32x4*)(h + 2816) = au; }
                    f32x4 o;
                    { const f32x4 g1 = shfl4(ag, s1), g2 = shfl4(ag, s2);
                      const f32x4 p1g = fr >= 1 ? g1 : pg1, p2g = fr >= 2 ? g2 : pg2;
                      const f32x4 cg = bg + wg0 * p2g + wg1 * p1g + wg2 * ag;
                      o[0] = silu_f(cg[0]); o[1] = silu_f(cg[1]); o[2] = silu_f(cg[2]); o[3] = silu_f(cg[3]);
                      pg1 = g1; pg2 = g2; }
                    { const f32x4 u1 = shfl4(au, s1), u2 = shfl4(au, s2);
                      const f32x4 p1u = fr >= 1 ? u1 : pu1, p2u = fr >= 2 ? u2 : pu2;
                      const f32x4 cu = bu + wu0 * p2u + wu1 * p1u + wu2 * au;
                      o = o * cu;
                      pu1 = u1; pu2 = u2; }
                    u32x2 w; w.x = cvt_pk_bf16(o[0], o[1]); w.y = cvt_pk_bf16(o[2], o[3]);
                    if (n == 0) keep[ai][m] = w;
                    else { u32x4 w4; w4.x = keep[ai][m].x; w4.y = keep[ai][m].y; w4.z = w.x; w4.w = w.y; *(u32x4*)(gt + (size_t)r * 2816 + g0 - 4) = w4; }
                }
            }
        }
    }
};

template <class Epi, class Sched, bool ALIGN_EPI = false, bool SP2 = false>
__device__ __forceinline__ void gemm_phase(PG8_LAS unsigned char* lds, const Gemm g, const Sched& S, const Epi& E) {
    int tid_ = threadIdx.x; asm volatile("" : "+v"(tid_));
    const int tid = tid_, wid = __builtin_amdgcn_readfirstlane(tid >> 6), lane = tid & 63, wr = wid >> 2, wc = wid & 3, fr = lane & 15, fq = lane >> 4;
    const int K = g.K, nt = K / BK;
    unsigned voffA[2], voffB[2];
#pragma unroll
    for (int i = 0; i < 2; ++i) { int R, C; stage_rc(tid * 16 + i * 8192, R, C); const int Rb = Epi::PERM ? ((R & ~31) + perm32(R & 31)) : R;
        voffA[i] = (unsigned)(R * K + C) * 2u; voffB[i] = (unsigned)(Rb * K + C) * 2u; }
    const size_t kstep = (size_t)(BK * 2);
    const size_t hstep = (size_t)HALF * K * 2;
    const size_t tstep = 2 * hstep;
    const unsigned ldsw = (unsigned)wid * 1024u;
    const int aoff = lds_byte(wr * 64 + fr, fq * 8), boff = lds_byte(wc * 32 + fr, fq * 8);
#define PG8_SA(b, h) (((b) * 2 + (h)) * HTB)
#define PG8_SB(b, h) ((4 + (b) * 2 + (h)) * HTB)
#define PG8_STAGE(bufoff, gbase, voff) do { _Pragma("unroll") for (int _i = 0; _i < 2; ++_i) \
        __builtin_amdgcn_global_load_lds((const unsigned*)((const char*)(gbase) + (voff)[_i]), (PG8_LAS unsigned*)(lds + (bufoff) + ldsw + _i * 8192), 16, 0, 0); } while (0)
#define PG8_LDA(dst, b, h) do { _Pragma("unroll") for (int m = 0; m < 4; ++m) _Pragma("unroll") for (int k = 0; k < 2; ++k) dst[m][k] = *(const PG8_LAS bf16x8*)(lds + PG8_SA(b, h) + aoff + m * 2048 + k * 1024); } while (0)
#define PG8_LDB(dst, b, h) do { _Pragma("unroll") for (int n = 0; n < 2; ++n) _Pragma("unroll") for (int k = 0; k < 2; ++k) dst[n][k] = *(const PG8_LAS bf16x8*)(lds + PG8_SB(b, h) + boff + n * 2048 + k * 1024); } while (0)
#define PG8_MMA(ai, bj, At, Bt) do { __builtin_amdgcn_s_setprio(1); _Pragma("unroll") for (int m = 0; m < 4; ++m) _Pragma("unroll") for (int n = 0; n < 2; ++n) _Pragma("unroll") for (int k = 0; k < 2; ++k) \
        acc[ai][bj][m][n] = __builtin_amdgcn_mfma_f32_16x16x32_bf16(Bt[n][k], At[m][k], acc[ai][bj][m][n], 0, 0, 0); __builtin_amdgcn_s_setprio(0); } while (0)
#define PG8_WAIT_V(n) asm volatile("s_waitcnt vmcnt(" #n ")" ::: "memory")
#define PG8_WAIT_L(n) asm volatile("s_waitcnt lgkmcnt(" #n ")" ::: "memory")
#define PG8_BAR __builtin_amdgcn_s_barrier()
#define PG8_SCHED __builtin_amdgcn_sched_barrier(0)
    Unit cur, nxt; int ui = 0;
    if (!S.next(0, cur)) return;
    f32x4 acc[2][2][4][2];
#pragma unroll
    for (int a = 0; a < 2; ++a)
#pragma unroll
        for (int b = 0; b < 2; ++b)
#pragma unroll
            for (int m = 0; m < 4; ++m)
#pragma unroll
                for (int n = 0; n < 2; ++n) acc[a][b][m][n] = (f32x4){0.f, 0.f, 0.f, 0.f};
    bf16x8 At[4][2], B0[2][2], B1[2][2];
    const char* cA = (const char*)g.A + (size_t)cur.pm * tstep; const char* cB = (const char*)g.Bt + (size_t)cur.pn * tstep;
    S.a_ready(cur);
    if constexpr (SP2) {
        PG8_STAGE(PG8_SB(0, 0), cB, voffB); PG8_STAGE(PG8_SB(0, 1), cB + hstep, voffB); PG8_STAGE(PG8_SA(0, 0), cA, voffA); PG8_STAGE(PG8_SA(0, 1), cA + hstep, voffA);
        if (wr == 1) PG8_BAR;
        PG8_WAIT_V(2); PG8_BAR;
        PG8_STAGE(PG8_SB(1, 0), cB + kstep, voffB); PG8_STAGE(PG8_SA(1, 0), cA + kstep, voffA); PG8_STAGE(PG8_SB(1, 1), cB + hstep + kstep, voffB);
        PG8_WAIT_V(6); PG8_BAR;
    } else {
        PG8_STAGE(PG8_SB(0, 0), cB, voffB); PG8_STAGE(PG8_SA(0, 0), cA, voffA); PG8_STAGE(PG8_SB(0, 1), cB + hstep, voffB); PG8_STAGE(PG8_SA(0, 1), cA + hstep, voffA);
        if (wr == 1) PG8_BAR;
        PG8_WAIT_V(4); PG8_BAR;
        PG8_STAGE(PG8_SB(1, 0), cB + kstep, voffB); PG8_STAGE(PG8_SA(1, 0), cA + kstep, voffA); PG8_STAGE(PG8_SB(1, 1), cB + hstep + kstep, voffB);
        PG8_WAIT_V(6); PG8_BAR;
    }
    for (;;) {
        const bool has_next = S.next(ui + 1, nxt);
        const char* nA = has_next ? (const char*)g.A + (size_t)nxt.pm * tstep : cA; const char* nB = has_next ? (const char*)g.Bt + (size_t)nxt.pn * tstep : cB;
        for (int t = 0; t < nt; t += 2) {
            const bool last = (t == nt - 2);
            const char* a1 = cA + (size_t)(t + 1) * kstep;
            const char* a2 = last ? nA : cA + (size_t)(t + 2) * kstep; const char* b2 = last ? nB : cB + (size_t)(t + 2) * kstep;
            const char* a3 = a2 + kstep; const char* b3 = b2 + kstep;
            if (last && has_next) S.a_ready(nxt);
            if constexpr (SP2) {
            PG8_LDB(B0, 0, 0); PG8_LDB(B1, 0, 1); PG8_SCHED; PG8_LDA(At, 0, 0); PG8_STAGE(PG8_SA(1, 1), a1 + hstep, voffA);
            PG8_WAIT_V(8); PG8_WAIT_L(0); PG8_BAR; PG8_MMA(0, 0, At, B0); PG8_MMA(0, 1, At, B1); PG8_BAR; PG8_SCHED;
            PG8_LDA(At, 0, 1); PG8_STAGE(PG8_SB(0, 0), b2, voffB); PG8_STAGE(PG8_SB(0, 1), b2 + hstep, voffB); PG8_STAGE(PG8_SA(0, 0), a2, voffA);
            PG8_WAIT_V(8); PG8_WAIT_L(0); PG8_BAR; PG8_MMA(1, 0, At, B0); PG8_MMA(1, 1, At, B1); PG8_BAR; PG8_SCHED;
            PG8_LDB(B0, 1, 0); PG8_LDB(B1, 1, 1); PG8_SCHED; PG8_LDA(At, 1, 0); PG8_STAGE(PG8_SA(0, 1), a2 + hstep, voffA);
            PG8_WAIT_V(8); PG8_WAIT_L(0); PG8_BAR; PG8_MMA(0, 0, At, B0); PG8_MMA(0, 1, At, B1); PG8_BAR; PG8_SCHED;
            PG8_LDA(At, 1, 1); PG8_STAGE(PG8_SB(1, 0), b3, voffB); PG8_STAGE(PG8_SB(1, 1), b3 + hstep, voffB); PG8_STAGE(PG8_SA(1, 0), a3, voffA);
            PG8_WAIT_V(8); PG8_WAIT_L(0); PG8_BAR; PG8_MMA(1, 0, At, B0); PG8_MMA(1, 1, At, B1); PG8_BAR; PG8_SCHED;
            } else {
            PG8_LDB(B0, 0, 0); PG8_SCHED; PG8_LDA(At, 0, 0); PG8_STAGE(PG8_SA(1, 1), a1 + hstep, voffA);
            PG8_WAIT_L(8); PG8_BAR; PG8_WAIT_L(0); PG8_MMA(0, 0, At, B0); PG8_BAR; PG8_SCHED;
            PG8_LDB(B1, 0, 1); PG8_STAGE(PG8_SB(0, 0), b2, voffB);
            PG8_BAR; PG8_WAIT_L(0); PG8_MMA(0, 1, At, B1); PG8_BAR;
            PG8_LDA(At, 0, 1); PG8_STAGE(PG8_SA(0, 0), a2, voffA);
            PG8_BAR; PG8_WAIT_L(0); PG8_MMA(1, 0, At, B0); PG8_BAR; PG8_SCHED;
            PG8_STAGE(PG8_SB(0, 1), b2 + hstep, voffB);
            PG8_WAIT_V(6); PG8_BAR; PG8_MMA(1, 1, At, B1); PG8_BAR;
            PG8_LDB(B0, 1, 0); PG8_SCHED; PG8_LDA(At, 1, 0); PG8_STAGE(PG8_SA(0, 1), a2 + hstep, voffA);
            PG8_WAIT_L(8); PG8_BAR; PG8_WAIT_L(0); PG8_MMA(0, 0, At, B0); PG8_BAR; PG8_SCHED;
            PG8_LDB(B1, 1, 1); PG8_STAGE(PG8_SB(1, 0), b3, voffB);
            PG8_BAR; PG8_WAIT_L(0); PG8_MMA(0, 1, At, B1); PG8_BAR;
            PG8_LDA(At, 1, 1); PG8_STAGE(PG8_SA(1, 0), a3, voffA);
            PG8_BAR; PG8_WAIT_L(0); PG8_MMA(1, 0, At, B0); PG8_BAR; PG8_SCHED;
            PG8_STAGE(PG8_SB(1, 1), b3 + hstep, voffB);
            PG8_WAIT_V(6); PG8_BAR; PG8_MMA(1, 1, At, B1); PG8_BAR;
            }
        }
        if constexpr (ALIGN_EPI) { if (wr == 0) PG8_BAR; }
        if constexpr (!Epi::AFTER_DRAIN) { E(acc, cur, wr, wc, fr, fq); S.done(cur); }
        if (!has_next) break;
#pragma unroll
        for (int a = 0; a < 2; ++a)
#pragma unroll
            for (int b = 0; b < 2; ++b)
#pragma unroll
                for (int m = 0; m < 4; ++m)
#pragma unroll
                    for (int n = 0; n < 2; ++n) acc[a][b][m][n] = (f32x4){0.f, 0.f, 0.f, 0.f};
        cur = nxt; cA = nA; cB = nB; ++ui;
        if constexpr (ALIGN_EPI) { if (wr == 1) PG8_BAR; }
    }
    PG8_WAIT_V(0);
    if constexpr (!ALIGN_EPI) { if (wr == 0) PG8_BAR; }
    PG8_BAR;
    if constexpr (Epi::AFTER_DRAIN) { E.fused(acc, cur, wr, wc, fr, fq, lds, wid, lane); S.done(cur); }
#undef PG8_SA
#undef PG8_SB
#undef PG8_STAGE
#undef PG8_LDA
#undef PG8_LDB
#undef PG8_MMA
#undef PG8_WAIT_V
#undef PG8_WAIT_L
#undef PG8_BAR
#undef PG8_SCHED
}
}
#define GAS __attribute__((address_space(1)))
#define LAS __attribute__((address_space(3)))
typedef unsigned short bf16;
typedef unsigned v4u __attribute__((ext_vector_type(4)));
typedef float f32x4 __attribute__((ext_vector_type(4)));
typedef short bf16x8 __attribute__((ext_vector_type(8)));
typedef GAS unsigned gu32;
typedef GAS unsigned long long gu64;
#define RLX_AGENT __ATOMIC_RELAXED, __HIP_MEMORY_SCOPE_AGENT
#define LDS_WAIT() asm volatile("s_waitcnt lgkmcnt(0)" ::: "memory")
#define VM_WAIT() asm volatile("s_waitcnt vmcnt(0)" ::: "memory")
__device__ __forceinline__ unsigned long long rt() { return __builtin_amdgcn_s_memrealtime(); }
__device__ __forceinline__ unsigned f2bf(float f) { unsigned u = __builtin_bit_cast(unsigned, f); return (u + 0x7fffu + ((u >> 16) & 1u)) >> 16; }
__device__ __forceinline__ unsigned pk2(float lo, float hi) { return f2bf(lo) | (f2bf(hi) << 16); }

#define XB_TMO      128
#define XB_XCNT(j)  (256  + 64 * (j))
#define XB_XSUB(j)  (1280 + 64 * (j))
#define XB_XGEN(j)  (2304 + 64 * (j))
#define XB_TOP      3328
#define XB_TOPGEN   3392
#define XCD_BAR_WORDS 3456
#define XB_SPIN_CAP (1u << 18)

__device__ __forceinline__ unsigned xb_ld(unsigned* p)              { return __hip_atomic_load(p, __ATOMIC_RELAXED, __HIP_MEMORY_SCOPE_AGENT); }
__device__ __forceinline__ unsigned xb_add(unsigned* p, unsigned v) { return __hip_atomic_fetch_add(p, v, __ATOMIC_RELAXED, __HIP_MEMORY_SCOPE_AGENT); }
__device__ __forceinline__ unsigned xb_xcc_id() { return (unsigned)__builtin_amdgcn_s_getreg((3 << 11) | 20) & 0xFu; }
#define XB_SPIN(cond, bar) do { unsigned _sp = 0; while (cond) { __builtin_amdgcn_s_sleep(1); \
    if ((++_sp & 255u) == 0u) { if (xb_ld(&(bar)[XB_TMO])) break; if (_sp > XB_SPIN_CAP) { atomicAdd(&(bar)[XB_TMO], 1u); break; } } } } while (0)

struct XcdBarrier {
    unsigned* bar; unsigned x;
    volatile LAS unsigned* st;
};

__device__ __forceinline__ XcdBarrier xcd_barrier_post(unsigned* bar, volatile LAS unsigned* st) {
    XcdBarrier b; b.bar = bar; b.x = xb_xcc_id(); b.st = st;
    if (threadIdx.x == 0) (void)xb_add(&bar[XB_XCNT(b.x)], 1u);
    return b;
}
__device__ __forceinline__ void xcd_barrier_complete(unsigned* bar, unsigned x, unsigned& nloc, unsigned& nx) {
    const unsigned G = gridDim.x * gridDim.y * gridDim.z;
    unsigned sum, cnt, mine, sp = 0u;
    for (;;) {
        sum = 0u; cnt = 0u; mine = 0u;
#pragma unroll
        for (unsigned j = 0; j < 16; ++j) { const unsigned c = xb_ld(&bar[XB_XCNT(j)]); sum += c; cnt += (c > 0u) ? 1u : 0u; mine = (j == x) ? c : mine; }
        if (sum == G) break;
        __builtin_amdgcn_s_sleep(1);
        if ((++sp & 255u) == 0u) { if (xb_ld(&bar[XB_TMO])) break; if (sp > XB_SPIN_CAP) { atomicAdd(&bar[XB_TMO], 1u); break; } }
    }
    nloc = mine > 0u ? mine : 1u; nx = cnt > 0u ? cnt : 1u;
}

__device__ __forceinline__ void xcd_barrier(const XcdBarrier& b) {
    asm volatile("s_waitcnt vmcnt(0)" ::: "memory");
    __syncthreads();
    if (threadIdx.x == 0) {
        unsigned* bar = b.bar;
        __builtin_amdgcn_s_waitcnt(0);
        unsigned nloc = b.st[0], nx = b.st[1];
        if (nloc == 0u) { xcd_barrier_complete(bar, b.x, nloc, nx); b.st[0] = nloc; b.st[1] = nx; }
        const unsigned old = xb_add(&bar[XB_XSUB(b.x)], 1u);
        const unsigned gen = old / nloc;
        if (old + 1u == (gen + 1u) * nloc) {
            __builtin_amdgcn_fence(__ATOMIC_RELEASE, "agent");
            asm volatile("s_waitcnt vmcnt(0)" ::: "memory");
            const unsigned og = xb_add(&bar[XB_TOP], 1u);
            const unsigned tg = og / nx;
            if (og + 1u == (tg + 1u) * nx) xb_add(&bar[XB_TOPGEN], 1u);
            else XB_SPIN(xb_ld(&bar[XB_TOPGEN]) == tg, bar);
            __builtin_amdgcn_fence(__ATOMIC_ACQUIRE, "agent");
            xb_add(&bar[XB_XGEN(b.x)], 1u);
            asm volatile("s_waitcnt vmcnt(0)" ::: "memory");
        } else {
            XB_SPIN(xb_ld(&bar[XB_XGEN(b.x)]) == gen, bar);
            __builtin_amdgcn_fence(__ATOMIC_ACQUIRE, "agent");
            asm volatile("s_waitcnt vmcnt(0)" ::: "memory");
        }
    }
    __syncthreads();
}

constexpr int NWAVES = 8, NTHR = 512;
constexpr int NB = 4, SEQ = 4096, M = NB * SEQ, DM = 1024;
constexpr int IN_W = 2516, NIN = 2560;
constexpr int DFF = 2816, DFF2 = 5632;
constexpr int NUNIT_GLA = NB * 4 * 64;

constexpr size_t MiB = 1u << 20;
constexpr size_t WS_CTL = 0, CTL_ZERO_BYTES = 1 * MiB;
constexpr size_t WS_ROPE = 1 * MiB;
constexpr size_t WS_SSQ = 2 * MiB;
constexpr size_t WS_WIN = 4 * MiB, WS_WO = 9 * MiB, WS_WUP0 = 11 * MiB, WS_WUP1 = 22 * MiB, WS_WDN0 = 33 * MiB, WS_WDN1 = 39 * MiB, WS_WUV = 45 * MiB, WS_WOUT = 49 * MiB;
constexpr size_t WS_XB = 51 * MiB;
constexpr size_t WS_R = 83 * MiB;
constexpr size_t R_GQ = WS_R, R_GK = R_GQ + 8 * MiB, R_GV = R_GK + 8 * MiB, R_GR = R_GV + 16 * MiB, R_BQ = R_GR + 16 * MiB, R_IQ = R_BQ + 16 * MiB, R_BK = R_IQ + 16 * MiB,
                 R_BV = R_BK + 2 * MiB, R_IK = R_BV + 2 * MiB, R_ALR = R_IK + 4 * MiB, R_IW = R_ALR + 1 * MiB, R_DS = R_IW + 1 * MiB, R_DEC = R_DS + 32 * MiB, R_IDX = R_DEC + 1 * MiB,
                 R_AO = R_IDX + 8 * MiB, R_END0 = R_AO + 32 * MiB;
constexpr size_t R_GT = WS_R, R_HL = R_GT + 88 * MiB, R_HF = R_HL + 11 * MiB, R_END1 = R_HF + 11 * MiB;
constexpr size_t R_Z = WS_R, R_SG = R_Z + 64 * MiB, R_END2 = R_SG + 32 * MiB;
constexpr size_t WS_END = 256 * MiB;
static_assert(R_END0 <= WS_END && R_END1 <= WS_END && R_END2 <= WS_END, "d_ws map");
constexpr int CW_BAR = 4096;

constexpr int RING_BYTES = 131072, LDS_BYTES = 147456, LDSCTL_OFF = LDS_BYTES - 512, MISC_OFF = LDSCTL_OFF;

typedef unsigned short bf16;
__device__ __forceinline__ float bf2f(unsigned short h) { return __builtin_bit_cast(float, (unsigned)h << 16); }
__device__ __forceinline__ float wave_sum(float v) {
#pragma unroll
    for (int o = 1; o < 64; o <<= 1) v += __shfl_xor(v, o);
    return v;
}
__device__ __forceinline__ float wave_max(float v) {
#pragma unroll
    for (int o = 1; o < 64; o <<= 1) v = fmaxf(v, __shfl_xor(v, o));
    return v;
}

struct Args { const float* in[20]; float* out; unsigned char* ws; int ph_lo, ph_hi; };

__device__ __forceinline__ int ropeperm(int p) { return p < 16 ? ((p >> 1) + 8 * (p & 1)) : p; }
__device__ __forceinline__ int win_src(int n) {
    if (n < 1536) return n;
    if (n < 2048) { const int c = n - 1536; return 1552 + (c & ~63) + ropeperm(c & 63); }
    if (n < 2304) { const int c = n - 2048; return 2192 + (c & ~63) + ropeperm(c & 63); }
    const int c = n - 2304;
    if (c < 64) return 2064 + ropeperm(c);
    if (c < 128) return 2128 + (c - 64);
    if (c < 192) return 2448 + ropeperm(c - 128);
    if (c < 208) return 1536 + (c - 192);
    if (c < 212) return 2512 + (c - 208);
    return -1;
}
__device__ __forceinline__ int up_src(int r) { const int pn = r >> 8, w = r & 255; return (w >> 7) * DFF + pn * 128 + (w & 127); }

__device__ __forceinline__ int ropeinv(int d) { return d < 16 ? (d < 8 ? 2 * d : 2 * (d - 8) + 1) : d; }
__device__ __forceinline__ int win_dst(int s) {
    if (s < 1536) return s;
    if (s < 1552) return 2304 + 192 + (s - 1536);
    if (s < 2064) { const int c = s - 1552; return 1536 + (c & ~63) + ropeinv(c & 63); }
    if (s < 2128) return 2304 + ropeinv(s - 2064);
    if (s < 2192) return 2304 + 64 + (s - 2128);
    if (s < 2448) { const int c = s - 2192; return 2048 + (c & ~63) + ropeinv(c & 63); }
    if (s < 2512) return 2304 + 128 + ropeinv(s - 2448);
    return 2304 + 208 + (s - 2512);
}
__device__ __forceinline__ int up_dst(int s) { const int bj = s >= DFF ? 1 : 0, rem = s - bj * DFF; return (rem >> 7) * 256 + bj * 128 + (rem & 127); }

template <int MAP  >
__device__ __forceinline__ void transpose_item(const float* W, int K, int Nsrc, const float* g, bf16* WT, unsigned char* scr, int item, int lane) {
    const int nsb = (Nsrc + 63) >> 6, kb = item / nsb, sb = item % nsb, k0 = 64 * kb, s0 = 64 * sb;
    const int lr = lane >> 4, s4 = 4 * (lane & 15);
    const bool inb = s0 + s4 < Nsrc;
    f32x4 vv[16]; float gg[16];
    const float* wp = W + (size_t)(k0 + lr) * Nsrc + (inb ? s0 + s4 : 0);
#pragma unroll
    for (int i = 0; i < 16; ++i) { vv[i] = *(const f32x4*)(wp + (size_t)(4 * i) * Nsrc); gg[i] = g ? g[k0 + 4 * i + lr] : 1.0f; }
    unsigned short* tl = (unsigned short*)scr;
#pragma unroll
    for (int i = 0; i < 16; ++i) { const int kk = 4 * i + lr;
        const f32x4 v = vv[i] * gg[i];
        const unsigned p01 = pg8::cvt_pk_bf16(v[0], v[1]), p23 = pg8::cvt_pk_bf16(v[2], v[3]);
        tl[(s4 + 0) * 68 + kk] = (unsigned short)p01; tl[(s4 + 1) * 68 + kk] = (unsigned short)(p01 >> 16);
        tl[(s4 + 2) * 68 + kk] = (unsigned short)p23; tl[(s4 + 3) * 68 + kk] = (unsigned short)(p23 >> 16); }
    LDS_WAIT(); asm volatile("" ::: "memory");
    const int c = lane & 7;
#pragma unroll
    for (int j = 0; j < 8; ++j) { const int sl = (lane >> 3) + 8 * j, s = s0 + sl;
        const unsigned long long lo = *(const unsigned long long*)(scr + sl * 136 + c * 16), hi = *(const unsigned long long*)(scr + sl * 136 + c * 16 + 8);
        if (s < Nsrc) { const int dst = MAP == 0 ? s : (MAP == 1 ? win_dst(s) : up_dst(s));
            *(v4u*)(WT + (size_t)dst * K + k0 + 8 * c) = (v4u){(unsigned)lo, (unsigned)(lo >> 32), (unsigned)hi, (unsigned)(hi >> 32)}; } }
    LDS_WAIT(); asm volatile("" ::: "memory");
}

__device__ __forceinline__ void sincos_d(double a, float& c, float& s) {
    const double k = __builtin_rint(a * 0.15915494309189535);
    double r = a - k * 6.283185307179586; r -= k * 2.4492935982947064e-16;
    const double r2 = r * r;
    double sp = -1.0 / 51090942171709440000.0, cp = 1.0 / 1124000727777607680000.0;
    sp = sp * r2 + 1.0 / 121645100408832000.0;  cp = cp * r2 - 1.0 / 2432902008176640000.0;
    sp = sp * r2 - 1.0 / 355687428096000.0;     cp = cp * r2 + 1.0 / 6402373705728000.0;
    sp = sp * r2 + 1.0 / 1307674368000.0;       cp = cp * r2 - 1.0 / 20922789888000.0;
    sp = sp * r2 - 1.0 / 6227020800.0;          cp = cp * r2 + 1.0 / 87178291200.0;
    sp = sp * r2 + 1.0 / 39916800.0;            cp = cp * r2 - 1.0 / 479001600.0;
    sp = sp * r2 - 1.0 / 362880.0;              cp = cp * r2 + 1.0 / 3628800.0;
    sp = sp * r2 + 1.0 / 5040.0;                cp = cp * r2 - 1.0 / 40320.0;
    sp = sp * r2 - 1.0 / 120.0;                 cp = cp * r2 + 1.0 / 720.0;
    sp = sp * r2 + 1.0 / 6.0;                   cp = cp * r2 - 1.0 / 24.0;
    cp = cp * r2 + 0.5;
    s = (float)(r - r * r2 * sp); c = (float)(1.0 - r2 * cp);
}

constexpr int CW_WIN = 16 * ((IN_W + 63) / 64), CW_WO = 16 * 16, CW_WUP = 16 * (DFF2 / 64), CW_WDN = (DFF / 64) * 16, CW_WUV = 16 * 32, CW_WOUT = 16 * 16;
constexpr int CW_E0 = CW_WIN, CW_E1 = CW_E0 + CW_WO, CW_E2 = CW_E1 + CW_WUP, CW_E3 = CW_E2 + CW_WDN, CW_E4 = CW_E3 + CW_WUV, CW_E5 = CW_E4 + CW_WOUT, CW_E6 = CW_E5 + CW_WUP, CW_E7 = CW_E6 + CW_WDN;
__device__ __forceinline__ void convert_weights(const Args& a, unsigned char* lds, int rank, int nrank, int tid, int lo, int hi) {
    unsigned char* ws = a.ws;
    const int lane = tid & 63, wave = tid >> 6;
    unsigned char* scr = lds + wave * 9216;
    const int gw = rank * NWAVES + wave, NGW = nrank * NWAVES;
    for (int it = lo + gw; it < hi; it += NGW) {
        if (it < CW_E0) { transpose_item<1>(a.in[2], 1024, IN_W, a.in[1], (bf16*)(ws + WS_WIN), scr, it, lane); }
        else if (it < CW_E1) { transpose_item<0>(a.in[6], 1024, 1024, nullptr, (bf16*)(ws + WS_WO), scr, it - CW_E0, lane); }
        else if (it < CW_E2) { transpose_item<2>(a.in[15], 1024, DFF2, a.in[14], (bf16*)(ws + WS_WUP0), scr, it - CW_E1, lane); }
        else if (it < CW_E3) { transpose_item<0>(a.in[18], DFF, 1024, nullptr, (bf16*)(ws + WS_WDN0), scr, it - CW_E2, lane); }
        else if (it < CW_E4) { transpose_item<0>(a.in[8], 1024, 2048, a.in[7], (bf16*)(ws + WS_WUV), scr, it - CW_E3, lane); }
        else if (it < CW_E5) { transpose_item<0>(a.in[13], 1024, 1024, nullptr, (bf16*)(ws + WS_WOUT), scr, it - CW_E4, lane); }
        else if (it < CW_E6) { transpose_item<2>(a.in[15] + (size_t)1024 * DFF2, 1024, DFF2, a.in[14] + 1024, (bf16*)(ws + WS_WUP1), scr, it - CW_E5, lane); }
        else { transpose_item<0>(a.in[18] + (size_t)DFF * 1024, DFF, 1024, nullptr, (bf16*)(ws + WS_WDN1), scr, it - CW_E6, lane); }
    }
}
__device__ __forceinline__ void p0_prologue(const Args& a, unsigned char* lds, int vcu, int G, int tid) {
    unsigned char* ws = a.ws;
    const int lane = tid & 63, wave = tid >> 6;
    const int gw = vcu * NWAVES + wave, NGW = G * NWAVES;
    convert_weights(a, lds, vcu, G, tid, 0, CW_E0);
    convert_weights(a, lds, vcu, G, tid, CW_E5, CW_E7);
    { const int gt0 = vcu * NTHR + tid; v4u* zp = (v4u*)((bf16*)(ws + WS_WIN) + (size_t)(2304 + 212) * 1024);
      for (int i = gt0; i < 44 * 1024 / 8; i += G * NTHR) zp[i] = (v4u){0u, 0u, 0u, 0u}; }
    float* ssq = (float*)(ws + WS_SSQ);
    bf16* xb = (bf16*)(ws + WS_XB);
    for (int m = gw; m < M; m += NGW) {
        const f32x4* xr = (const f32x4*)(a.in[0] + (size_t)m * DM) + lane;
        unsigned long long* o8 = (unsigned long long*)(xb + (size_t)m * DM) + lane;
        float s = 0.f;
#pragma unroll
        for (int j = 0; j < 4; ++j) { const f32x4 v = xr[64 * j]; s += (v.x * v.x + v.y * v.y) + (v.z * v.z + v.w * v.w);
            o8[64 * j] = (unsigned long long)pk2(v.x, v.y) | ((unsigned long long)pk2(v.z, v.w) << 32); }
        s = wave_sum(s);
        if (lane == 0) ssq[m] = s;
    }
    const int gt = vcu * NTHR + tid, NGT = G * NTHR;
    for (int i = gt; i < 6 * M; i += NGT) ssq[M + i] = 0.f;
    float* rope = (float*)(ws + WS_ROPE);
    for (int i = gt; i < SEQ * 8; i += NGT) {
        const int t = i >> 3, j = i & 7;
        const double inv = j == 0 ? 1.0 : j == 1 ? 0.19392274474868576 : j == 2 ? 0.03760603093086393 : j == 3 ? 0.007292664737217109 : j == 4 ? 0.001414213562373095
                         : j == 5 ? 0.0002742481756762073 : j == 6 ? 5.318295896944988e-05 : 1.031338537721246e-05;
        float c, s; sincos_d((double)t * inv, c, s);
        rope[2 * i] = c; rope[2 * i + 1] = s;
    }
}

__device__ __forceinline__ float logsigmoid_f(float z) { return fminf(z, 0.f) - 0.6931471805599453f * __builtin_amdgcn_logf(1.0f + __builtin_amdgcn_exp2f(-1.4426950408889634f * fabsf(z))); }
typedef short v4i16_t __attribute__((ext_vector_type(4)));
__device__ __forceinline__ v4i16_t tr16(const unsigned char* p) { return __builtin_amdgcn_ds_read_tr16_b64_v4i16((LAS v4i16_t*)(LAS unsigned char*)p); }
__device__ __forceinline__ bf16x8 frag_tr(const unsigned char* X, int RS, int rowA, int rowB, int col0, int fr, int fq) {
    const unsigned char* b = X + (4 * fq + (fr >> 2)) * RS + (col0 + 4 * (fr & 3)) * 2;
    const v4i16_t a0 = tr16(b + rowA * RS), a1 = tr16(b + rowB * RS);
    return (bf16x8){a0[0], a0[1], a0[2], a0[3], a1[0], a1[1], a1[2], a1[3]};
}
__device__ __forceinline__ bf16x8 frag_row_perm(const unsigned char* X, int RS, int row0, int colA, int colB, int fr, int fq) {
    const unsigned char* b = X + (row0 + fr) * RS + 8 * fq;
    const v4i16_t a0 = *(const v4i16_t*)(b + colA * 2), a1 = *(const v4i16_t*)(b + colB * 2);
    return (bf16x8){a0[0], a0[1], a0[2], a0[3], a1[0], a1[1], a1[2], a1[3]};
}
__device__ __forceinline__ bf16x8 frag_row(const unsigned char* X, int RS, int row0, int col0, int fr, int fq) { return *(const bf16x8*)(X + (row0 + fr) * RS + (col0 + 8 * fq) * 2); }

__device__ __forceinline__ void gla_cumdecay(float* bl, float* gt, const f32x4 (&ar)[4], const float* wt, int tid) {
    { const int c = tid >> 3, d0 = (tid & 7) * 8;
      f32x4 z0 = *(const f32x4*)(wt + 1024 + d0), z1 = *(const f32x4*)(wt + 1024 + d0 + 4);
#pragma unroll
      for (int r = 0; r < 16; ++r) { const float x = ar[r >> 2][r & 3];
          z0 += x * *(const f32x4*)(wt + r * 64 + d0); z1 += x * *(const f32x4*)(wt + r * 64 + d0 + 4); }
      f32x4 o0, o1;
#pragma unroll
      for (int j = 0; j < 4; ++j) { o0[j] = logsigmoid_f(z0[j]) * (1.0f / 16.0f); o1[j] = logsigmoid_f(z1[j]) * (1.0f / 16.0f); }
      *(f32x4*)(bl + c * 64 + d0) = o0; *(f32x4*)(bl + c * 64 + d0 + 4) = o1; }
    __syncthreads();
    const int d = tid & 63, g = tid >> 6;
    float v[8]; float s = 0.f;
#pragma unroll
    for (int j = 0; j < 8; ++j) { s += bl[(8 * g + j) * 64 + d]; v[j] = s; }
    gt[g * 64 + d] = s;
    __syncthreads();
    float off = 0.f;
#pragma unroll
    for (int g2 = 0; g2 < 7; ++g2) off += (g2 < g) ? gt[g2 * 64 + d] : 0.f;
#pragma unroll
    for (int j = 0; j < 8; ++j) bl[(8 * g + j) * 64 + d] = v[j] + off;
    __syncthreads();
}
__device__ __forceinline__ void gla_stage_gate(float* wt, const float* wa2, const float* ba, int h, int tid) {
    for (int i = tid; i < 1024; i += NTHR) wt[i] = wa2[(i >> 6) * 256 + h * 64 + (i & 63)];
    if (tid < 64) wt[1024 + tid] = ba[h * 64 + tid];
}

constexpr int GL_BL = 0, GL_GT = 16384, GL_QD = 18432, GL_KD = 27648, GL_QB = 36864, GL_VV = 46080, GL_SS = 64512, GL_PART = 82944, GL_WT = 83456;
constexpr int GL_RS64 = 144, GL_RS128 = 288, GL_RSKL = 160;

__device__ __forceinline__ void gla_phase_a(const Args& a, unsigned char* lds, int vcu, int G, int tid) {
    unsigned char* ws = a.ws;
    float* bl = (float*)(lds + GL_BL); float* gt = (float*)(lds + GL_GT); float* wt = (float*)(lds + GL_WT);
    unsigned char* kl = lds + GL_QD; unsigned char* vv = lds + GL_VV;
    const bf16* gk = (const bf16*)(ws + R_GK); const bf16* gv = (const bf16*)(ws + R_GV);
    const float* alr = (const float*)(ws + R_ALR);
    float* ds = (float*)(ws + R_DS); float* dec = (float*)(ws + R_DEC);
    const int lane = tid & 63, wave = tid >> 6, fr = lane & 15, fq = lane >> 4;
    const int c = tid >> 3, sub = tid & 7, d0 = sub * 8, e0 = sub * 16;
    f32x4 ar[4]; v4u kw, vw0, vw1;
#define GLA_LOAD_A(unit_) do { const int bb_ = (unit_) >> 8, h_ = ((unit_) >> 6) & 3, n_ = (unit_) & 63; const size_t row_ = (size_t)bb_ * SEQ + n_ * 64 + c; \
        const f32x4* ap_ = (const f32x4*)(alr + row_ * 16); ar[0] = ap_[0]; ar[1] = ap_[1]; ar[2] = ap_[2]; ar[3] = ap_[3]; \
        kw = *(const v4u*)(gk + row_ * 256 + h_ * 64 + d0); const v4u* vs_ = (const v4u*)(gv + row_ * 512 + h_ * 128 + e0); vw0 = vs_[0]; vw1 = vs_[1]; } while (0)
    int hcur = -1;
    if (vcu < NUNIT_GLA) GLA_LOAD_A(vcu);
    for (int unit = vcu; unit < NUNIT_GLA; unit += G) {
        const int h = (unit >> 6) & 3;
        if (h != hcur) { hcur = h; gla_stage_gate(wt, a.in[3], a.in[4], h, tid); __syncthreads(); }
        gla_cumdecay(bl, gt, ar, wt, tid);
        { float kf[8] = {__builtin_bit_cast(float, kw.x << 16), __builtin_bit_cast(float, kw.x & 0xffff0000u), __builtin_bit_cast(float, kw.y << 16), __builtin_bit_cast(float, kw.y & 0xffff0000u),
                         __builtin_bit_cast(float, kw.z << 16), __builtin_bit_cast(float, kw.z & 0xffff0000u), __builtin_bit_cast(float, kw.w << 16), __builtin_bit_cast(float, kw.w & 0xffff0000u)};
#pragma unroll
          for (int j = 0; j < 8; ++j) kf[j] *= __expf(bl[63 * 64 + d0 + j] - bl[c * 64 + d0 + j]);
          *(v4u*)(kl + c * GL_RSKL + d0 * 2) = (v4u){pk2(kf[0], kf[1]), pk2(kf[2], kf[3]), pk2(kf[4], kf[5]), pk2(kf[6], kf[7])};
          *(v4u*)(vv + c * GL_RS128 + e0 * 2) = vw0; *(v4u*)(vv + c * GL_RS128 + e0 * 2 + 16) = vw1; }
        if (tid < 64) dec[unit * 64 + tid] = __expf(bl[63 * 64 + tid]);
        if (unit + G < NUNIT_GLA) GLA_LOAD_A(unit + G);
        __syncthreads();
        { const bf16x8 va0 = frag_tr(vv, GL_RS128, 0, 16, wave * 16, fr, fq), va1 = frag_tr(vv, GL_RS128, 32, 48, wave * 16, fr, fq);
#pragma unroll
          for (int dtile = 0; dtile < 4; ++dtile) {
              const bf16x8 kb0 = frag_tr(kl, GL_RSKL, 0, 16, dtile * 16, fr, fq), kb1 = frag_tr(kl, GL_RSKL, 32, 48, dtile * 16, fr, fq);
              f32x4 acc = {0.f, 0.f, 0.f, 0.f};
              acc = __builtin_amdgcn_mfma_f32_16x16x32_bf16(va0, kb0, acc, 0, 0, 0);
              acc = __builtin_amdgcn_mfma_f32_16x16x32_bf16(va1, kb1, acc, 0, 0, 0);
              *(f32x4*)(ds + (size_t)unit * 8192 + (dtile * 16 + fr) * 128 + wave * 16 + 4 * fq) = acc;
          } }
        __syncthreads();
    }
#undef GLA_LOAD_A
}

__device__ __forceinline__ void gla_scan(const Args& a, int vcu, int G, int tid) {
    float* ds = (float*)(a.ws + R_DS); const float* dec = (const float*)(a.ws + R_DEC);
    for (int e = vcu * NTHR + tid; e < 16 * 8192; e += G * NTHR) {
        const int bh = e >> 13, de = e & 8191, d = de >> 7;
        float S = 0.f;
#pragma unroll 8
        for (int n = 0; n < 64; ++n) { const int unit = bh * 64 + n; float* p = ds + (size_t)unit * 8192 + de;
            const float t = *p; const float dc = dec[unit * 64 + d]; *p = S; S = dc * S + t; }
    }
}

__device__ __forceinline__ void gla_phase_b(const Args& a, unsigned char* lds, int vcu, int G, int tid) {
    unsigned char* ws = a.ws;
    float* bl = (float*)(lds + GL_BL); float* gt = (float*)(lds + GL_GT); float* part = (float*)(lds + GL_PART); float* wt = (float*)(lds + GL_WT);
    unsigned char* qd = lds + GL_QD; unsigned char* kd = lds + GL_KD; unsigned char* qb = lds + GL_QB; unsigned char* vv = lds + GL_VV; unsigned char* ss = lds + GL_SS;
    const bf16* gq = (const bf16*)(ws + R_GQ); const bf16* gk = (const bf16*)(ws + R_GK); const bf16* gv = (const bf16*)(ws + R_GV); const bf16* gr = (const bf16*)(ws + R_GR);
    const float* alr = (const float*)(ws + R_ALR); const float* sp = (const float*)(ws + R_DS);
    bf16* ao = (bf16*)(ws + R_AO); const float* hg = a.in[5];
    const int lane = tid & 63, wave = tid >> 6, fr = lane & 15, fq = lane >> 4;
    const int Ti = wave & 3, eh = wave >> 2;
    const int c = tid >> 3, sub = tid & 7, d0 = sub * 8, e0 = sub * 16;
    f32x4 ar[4]; v4u qw, kw, vw0, vw1; f32x4 s0, s1, s2, s3;
#define GLA_LOAD_B(unit_) do { const int bb_ = (unit_) >> 8, h_ = ((unit_) >> 6) & 3, n_ = (unit_) & 63; const size_t row_ = (size_t)bb_ * SEQ + n_ * 64 + c; \
        const f32x4* ap_ = (const f32x4*)(alr + row_ * 16); ar[0] = ap_[0]; ar[1] = ap_[1]; ar[2] = ap_[2]; ar[3] = ap_[3]; \
        qw = *(const v4u*)(gq + row_ * 256 + h_ * 64 + d0); kw = *(const v4u*)(gk + row_ * 256 + h_ * 64 + d0); \
        const v4u* vs_ = (const v4u*)(gv + row_ * 512 + h_ * 128 + e0); vw0 = vs_[0]; vw1 = vs_[1]; \
        const f32x4* sr_ = (const f32x4*)(sp + (size_t)(unit_) * 8192 + c * 128 + e0); s0 = sr_[0]; s1 = sr_[1]; s2 = sr_[2]; s3 = sr_[3]; } while (0)
    int hcur = -1;
    if (vcu < NUNIT_GLA) GLA_LOAD_B(vcu);
    for (int unit = vcu; unit < NUNIT_GLA; unit += G) {
        const int bb = unit >> 8, h = (unit >> 6) & 3, n = unit & 63, row0 = bb * SEQ + n * 64;
        if (h != hcur) { hcur = h; gla_stage_gate(wt, a.in[3], a.in[4], h, tid); __syncthreads(); }
        gla_cumdecay(bl, gt, ar, wt, tid);
        { const unsigned qa[4] = {qw.x, qw.y, qw.z, qw.w}, ka[4] = {kw.x, kw.y, kw.z, kw.w};
          unsigned oqd[4], okd[4], oqb[4];
#pragma unroll
          for (int j = 0; j < 4; ++j) {
              const int d = d0 + 2 * j;
              const float b0 = bl[c * 64 + d], b1 = bl[c * 64 + d + 1], m0 = bl[32 * 64 + d], m1 = bl[32 * 64 + d + 1];
              const float q0 = __builtin_bit_cast(float, qa[j] << 16), q1 = __builtin_bit_cast(float, qa[j] & 0xffff0000u), k0 = __builtin_bit_cast(float, ka[j] << 16), k1 = __builtin_bit_cast(float, ka[j] & 0xffff0000u);
              oqd[j] = pk2(q0 * __expf(b0 - m0), q1 * __expf(b1 - m1)); okd[j] = pk2(k0 * __expf(m0 - b0), k1 * __expf(m1 - b1)); oqb[j] = pk2(q0 * __expf(b0), q1 * __expf(b1)); }
          *(v4u*)(qd + c * GL_RS64 + d0 * 2) = (v4u){oqd[0], oqd[1], oqd[2], oqd[3]};
          *(v4u*)(kd + c * GL_RS64 + d0 * 2) = (v4u){okd[0], okd[1], okd[2], okd[3]};
          *(v4u*)(qb + c * GL_RS64 + d0 * 2) = (v4u){oqb[0], oqb[1], oqb[2], oqb[3]};
          *(v4u*)(vv + c * GL_RS128 + e0 * 2) = vw0; *(v4u*)(vv + c * GL_RS128 + e0 * 2 + 16) = vw1;
          *(v4u*)(ss + c * GL_RS128 + e0 * 2) = (v4u){pk2(s0[0], s0[1]), pk2(s0[2], s0[3]), pk2(s1[0], s1[1]), pk2(s1[2], s1[3])};
          *(v4u*)(ss + c * GL_RS128 + e0 * 2 + 16) = (v4u){pk2(s2[0], s2[1]), pk2(s2[2], s2[3]), pk2(s3[0], s3[1]), pk2(s3[2], s3[3])}; }
        if (unit + G < NUNIT_GLA) GLA_LOAD_B(unit + G);
        const size_t orow = (size_t)(row0 + Ti * 16 + fr);
        unsigned long long gw2[4];
#pragma unroll
        for (int et = 0; et < 4; ++et) gw2[et] = *(const unsigned long long*)(gr + orow * 512 + h * 128 + eh * 64 + et * 16 + 4 * fq);
        __syncthreads();
        const bf16x8 qf0 = frag_row(qd, GL_RS64, Ti * 16, 0, fr, fq), qf1 = frag_row(qd, GL_RS64, Ti * 16, 32, fr, fq);
        f32x4 at[4];
#pragma unroll
        for (int Tj = 0; Tj < 4; ++Tj) {
            at[Tj] = (f32x4){0.f, 0.f, 0.f, 0.f};
            if (Tj <= Ti) {
                const bf16x8 kf0 = frag_row(kd, GL_RS64, Tj * 16, 0, fr, fq), kf1 = frag_row(kd, GL_RS64, Tj * 16, 32, fr, fq);
                at[Tj] = __builtin_amdgcn_mfma_f32_16x16x32_bf16(kf0, qf0, at[Tj], 0, 0, 0);
                at[Tj] = __builtin_amdgcn_mfma_f32_16x16x32_bf16(kf1, qf1, at[Tj], 0, 0, 0);
#pragma unroll
                for (int r = 0; r < 4; ++r) if (Tj * 16 + 4 * fq + r > Ti * 16 + fr) at[Tj][r] = 0.f;
            }
        }
        bf16x8 pf[2];
#pragma unroll
        for (int kk = 0; kk < 2; ++kk) { v4u w_;
            w_.x = pg8::cvt_pk_bf16(at[2 * kk][0], at[2 * kk][1]); w_.y = pg8::cvt_pk_bf16(at[2 * kk][2], at[2 * kk][3]);
            w_.z = pg8::cvt_pk_bf16(at[2 * kk + 1][0], at[2 * kk + 1][1]); w_.w = pg8::cvt_pk_bf16(at[2 * kk + 1][2], at[2 * kk + 1][3]);
            pf[kk] = __builtin_bit_cast(bf16x8, w_); }
        const bf16x8 qbf0 = frag_row_perm(qb, GL_RS64, Ti * 16, 0, 16, fr, fq), qbf1 = frag_row_perm(qb, GL_RS64, Ti * 16, 32, 48, fr, fq);
        f32x4 o[4]; float ssq = 0.f;
#pragma unroll
        for (int et = 0; et < 4; ++et) {
            const int ecol = eh * 64 + et * 16;
            f32x4 acc = {0.f, 0.f, 0.f, 0.f};
            acc = __builtin_amdgcn_mfma_f32_16x16x32_bf16(frag_tr(vv, GL_RS128, 0, 16, ecol, fr, fq), pf[0], acc, 0, 0, 0);
            if (Ti >= 2) acc = __builtin_amdgcn_mfma_f32_16x16x32_bf16(frag_tr(vv, GL_RS128, 32, 48, ecol, fr, fq), pf[1], acc, 0, 0, 0);
            acc = __builtin_amdgcn_mfma_f32_16x16x32_bf16(frag_tr(ss, GL_RS128, 0, 16, ecol, fr, fq), qbf0, acc, 0, 0, 0);
            acc = __builtin_amdgcn_mfma_f32_16x16x32_bf16(frag_tr(ss, GL_RS128, 32, 48, ecol, fr, fq), qbf1, acc, 0, 0, 0);
            o[et] = acc;
            ssq += (acc[0] * acc[0] + acc[1] * acc[1]) + (acc[2] * acc[2] + acc[3] * acc[3]);
        }
        ssq += __shfl_xor(ssq, 16); ssq += __shfl_xor(ssq, 32);
        if (fq == 0) part[wave * 16 + fr] = ssq;
        __syncthreads();
        { const float tot = part[wave * 16 + fr] + part[(wave ^ 4) * 16 + fr];
          const float rs = __builtin_amdgcn_rsqf(tot * (1.0f / 128.0f) + 1e-6f);
#pragma unroll
          for (int et = 0; et < 4; ++et) {
              const int e = eh * 64 + et * 16 + 4 * fq;
              const unsigned long long g2 = gw2[et];
              const f32x4 hv = *(const f32x4*)(hg + e);
              f32x4 y;
              y[0] = o[et][0] * rs * hv[0] * pg8::silu_f(__builtin_bit_cast(float, (unsigned)(g2 << 16)));
              y[1] = o[et][1] * rs * hv[1] * pg8::silu_f(__builtin_bit_cast(float, (unsigned)g2 & 0xffff0000u));
              y[2] = o[et][2] * rs * hv[2] * pg8::silu_f(__builtin_bit_cast(float, (unsigned)(g2 >> 32) << 16));
              y[3] = o[et][3] * rs * hv[3] * pg8::silu_f(__builtin_bit_cast(float, (unsigned)(g2 >> 32) & 0xffff0000u));
              pg8::st_bf16x4(ao + orow * 1024 + h * 128 + e, y);
          } }
        __syncthreads();
    }
#undef GLA_LOAD_B
}

__device__ __forceinline__ unsigned f2key(float f) { const unsigned u = __builtin_bit_cast(unsigned, f); return (u & 0x80000000u) ? ~u : (u | 0x80000000u); }

typedef float f32x16 __attribute__((ext_vector_type(16)));
__device__ __forceinline__ int wave_sum_i(int v) {
    v += __builtin_amdgcn_update_dpp(0, v, 0xB1, 0xf, 0xf, true);
    v += __builtin_amdgcn_update_dpp(0, v, 0x4E, 0xf, 0xf, true);
    v += __builtin_amdgcn_update_dpp(0, v, 0x141, 0xf, 0xf, true);
    v += __builtin_amdgcn_update_dpp(0, v, 0x140, 0xf, 0xf, true);
    return (__builtin_amdgcn_readlane(v, 0) + __builtin_amdgcn_readlane(v, 16)) + (__builtin_amdgcn_readlane(v, 32) + __builtin_amdgcn_readlane(v, 48));
}
__device__ __forceinline__ void sel_score(unsigned* sc, const bf16* iq, const bf16* ik, const float* iw, int bb, int t0, int lane_in, int wave) {
    int lane = lane_in; asm volatile("" : "+v"(lane));
    const int r32 = lane & 31, hh = lane >> 5;
    const size_t qrow0 = (size_t)bb * SEQ + t0;
    bf16x8 af[4];
#pragma unroll
    for (int ks = 0; ks < 4; ++ks) af[ks] = *(const bf16x8*)(iq + (qrow0 + (r32 >> 2)) * 256 + (r32 & 3) * 64 + ks * 16 + hh * 8);
    f32x4 w[4];
#pragma unroll
    for (int j = 0; j < 4; ++j) w[j] = *(const f32x4*)(iw + (qrow0 + 2 * j + hh) * 4);
    const int ntile = ((t0 + 7) >> 5) + 1;
    const bf16* ikb = ik + (size_t)bb * SEQ * 64 + lane * 8;
#define SEL_LOAD(dst, tb) do { _Pragma("unroll") for (int k_ = 0; k_ < 2; ++k_) { int tl_ = (tb) + 8 * k_; tl_ = tl_ > 127 ? 127 : tl_; \
        const bf16* kr_ = ikb + (size_t)tl_ * 2048; _Pragma("unroll") for (int ks = 0; ks < 4; ++ks) dst[k_][ks] = *(const bf16x8*)(kr_ + ks * 512); } } while (0)
#define SEL_COMP(src, tb) do { _Pragma("unroll") for (int k_ = 0; k_ < 2; ++k_) { const int tile_ = (tb) + 8 * k_; if (tile_ < ntile) { const int key_ = tile_ * 32 + r32; \
        f32x16 dd; _Pragma("unroll") for (int e = 0; e < 16; ++e) dd[e] = 0.f; \
        _Pragma("unroll") for (int ks = 0; ks < 4; ++ks) dd = __builtin_amdgcn_mfma_f32_32x32x16_bf16(af[ks], src[k_][ks], dd, 0, 0, 0); \
        _Pragma("unroll") for (int j = 0; j < 4; ++j) { \
            const float s_ = (w[j][0] * fmaxf(dd[4 * j], 0.f) + w[j][1] * fmaxf(dd[4 * j + 1], 0.f)) + (w[j][2] * fmaxf(dd[4 * j + 2], 0.f) + w[j][3] * fmaxf(dd[4 * j + 3], 0.f)) + 0.0f; \
            const int q_ = 2 * j + hh; const unsigned kv_ = f2key(s_); sc[q_ * 4096 + key_] = (key_ <= t0 + q_) ? kv_ : 0u; } } } } while (0)
    bf16x8 bufA[2][4], bufB[2][4];
    int tb = wave;
    SEL_LOAD(bufA, tb);
    for (;;) {
        SEL_LOAD(bufB, tb + 16);
        SEL_COMP(bufA, tb);
        tb += 16; if (tb >= ntile) break;
        SEL_LOAD(bufA, tb + 16);
        SEL_COMP(bufB, tb);
        tb += 16; if (tb >= ntile) break;
    }
#undef SEL_LOAD
#undef SEL_COMP
}
__device__ __forceinline__ void sel_pick(const unsigned (&u)[64], int ng, int ls, int wave, unsigned char* lds, unsigned short* out) {
#define CNT_GE4(a0, a1, a2, a3, v0, v1, v2, v3, thr) do { unsigned long long m0_, m1_, m2_, m3_; \
        asm volatile("v_cmp_ge_u32_e64 %4, %8, %12\n\tv_cmp_ge_u32_e64 %5, %9, %12\n\tv_cmp_ge_u32_e64 %6, %10, %12\n\tv_cmp_ge_u32_e64 %7, %11, %12\n\t" \
                     "v_addc_co_u32_e64 %0, %4, 0, %0, %4\n\tv_addc_co_u32_e64 %1, %5, 0, %1, %5\n\tv_addc_co_u32_e64 %2, %6, 0, %2, %6\n\tv_addc_co_u32_e64 %3, %7, 0, %3, %7" \
                     : "+v"(a0), "+v"(a1), "+v"(a2), "+v"(a3), "=&s"(m0_), "=&s"(m1_), "=&s"(m2_), "=&s"(m3_) : "v"(v0), "v"(v1), "v"(v2), "v"(v3), "v"(thr)); } while (0)
    unsigned T = 0u; int cT = 4096;
#define SEL_STEP(NG, bit_) do { unsigned cand = T | (1u << (bit_)); int c0 = 0, c1 = 0, c2 = 0, c3 = 0; \
        _Pragma("unroll") for (int g8 = 0; g8 < NG; ++g8) { const int j = 8 * g8; \
            CNT_GE4(c0, c1, c2, c3, u[j], u[j + 1], u[j + 2], u[j + 3], cand); CNT_GE4(c0, c1, c2, c3, u[j + 4], u[j + 5], u[j + 6], u[j + 7], cand); } \
        int v_ = (c0 + c1) + (c2 + c3); \
        v_ += __builtin_amdgcn_update_dpp(0, v_, 0xB1, 0xf, 0xf, true); v_ += __builtin_amdgcn_update_dpp(0, v_, 0x4E, 0xf, 0xf, true); \
        v_ += __builtin_amdgcn_update_dpp(0, v_, 0x141, 0xf, 0xf, true); v_ += __builtin_amdgcn_update_dpp(0, v_, 0x140, 0xf, 0xf, true); \
        { auto s_ = __builtin_amdgcn_permlane16_swap((unsigned)v_, (unsigned)v_, false, false); v_ = (int)(s_[0] + s_[1]); \
          auto t_ = __builtin_amdgcn_permlane32_swap((unsigned)v_, (unsigned)v_, false, false); v_ = (int)(t_[0] + t_[1]); } \
        const bool ge_ = v_ >= 256; T = ge_ ? cand : T; cT = ge_ ? v_ : cT; } while (0)
#define SEL_LOOP(NG) do { _Pragma("unroll 1") for (int bit = 31; bit >= 1; bit -= 2) { SEL_STEP(NG, bit); SEL_STEP(NG, bit - 1); \
        if (__builtin_amdgcn_readfirstlane(cT) == 256) break; } } while (0)
    switch (ng) { case 1: SEL_LOOP(1); break; case 2: SEL_LOOP(2); break; case 3: SEL_LOOP(3); break; case 4: SEL_LOOP(4); break;
                  case 5: SEL_LOOP(5); break; case 6: SEL_LOOP(6); break; case 7: SEL_LOOP(7); break; default: SEL_LOOP(8); break; }
    cT = __builtin_amdgcn_readfirstlane(cT); T = __builtin_amdgcn_readfirstlane(T);
#undef SEL_LOOP
#undef SEL_STEP
#undef CNT_GE4
    unsigned short* lst = (unsigned short*)(lds + 131072) + wave * 512;
    if (cT == 256) {
        unsigned wlo = 0u, whi = 0u;
#pragma unroll
        for (int j = 0; j < 64; ++j) if ((j >> 3) < ng) { const unsigned long long m_ = __ballot(u[j] >= T);
            wlo = (ls == j) ? (unsigned)m_ : wlo; whi = (ls == j) ? (unsigned)(m_ >> 32) : whi; }
        const int cl = __popc(wlo) + __popc(whi);
        int inc = cl;
        inc += __builtin_amdgcn_update_dpp(0, inc, 0x111, 0xf, 0xf, true); inc += __builtin_amdgcn_update_dpp(0, inc, 0x112, 0xf, 0xf, true);
        inc += __builtin_amdgcn_update_dpp(0, inc, 0x114, 0xf, 0xf, true); inc += __builtin_amdgcn_update_dpp(0, inc, 0x118, 0xf, 0xf, true);
        inc += __builtin_amdgcn_update_dpp(0, inc, 0x142, 0xa, 0xf, false); inc += __builtin_amdgcn_update_dpp(0, inc, 0x143, 0xc, 0xf, false);
        int off = inc - cl;
        while (__any((wlo | whi) != 0u)) {
            const bool has = (wlo | whi) != 0u;
            const int b_ = wlo ? __builtin_ctz(wlo) : 32 + __builtin_ctz(whi | 0x80000000u * (whi == 0u));
            lst[has ? off : 256 + ls] = (unsigned short)(ls * 64 + b_);
            off += has ? 1 : 0;
            if (wlo) wlo &= wlo - 1u; else whi &= whi - 1u;
        }
    } else {
        int ngt = 0;
#pragma unroll
        for (int j = 0; j < 64; ++j) if ((j >> 3) < ng) ngt += __popcll(__ballot(u[j] > T));
        const int need = 256 - ngt;
        const unsigned long long lt = (1ull << ls) - 1ull;
        int base = 0, eqt = 0;
#pragma unroll
        for (int j = 0; j < 64; ++j) if ((j >> 3) < ng) {
            const bool eq = (u[j] == T);
            const unsigned long long me = __ballot(eq);
            const bool take = (u[j] > T) || (eq && (eqt + __popcll(me & lt) < need));
            const unsigned long long mf = __ballot(take);
            lst[take ? base + __popcll(mf & lt) : 256 + ls] = (unsigned short)(j * 64 + ls);
            base += __popcll(mf); eqt += __popcll(me);
        }
    }
    LDS_WAIT(); asm volatile("" ::: "memory");
    *(unsigned long long*)(out + 4 * ls) = *(const unsigned long long*)(lst + 4 * ls);
}
__device__ __forceinline__ void dsa_select(const Args& a, unsigned char* lds, int vcu, int G, int tid) {
    unsigned char* ws = a.ws;
    const int lane0 = tid & 63, wave = __builtin_amdgcn_readfirstlane(tid >> 6);
    unsigned* sc = (unsigned*)lds;
    const bf16* iq = (const bf16*)(ws + R_IQ); const bf16* ik = (const bf16*)(ws + R_IK); const float* iw = (const float*)(ws + R_IW);
    unsigned short* idx = (unsigned short*)(ws + R_IDX);
    const int ngrp = vcu < 1024 ? 2 * ((1024 - vcu + G - 1) / G) : 0;
#define GRP(j, bb_, t0_) const int p_ = vcu + ((j) >> 1) * G; const int bb_ = p_ >> 8, x_ = p_ & 255, t0_ = (((j) & 1) ? (511 - x_) : x_) * 8
    if (ngrp > 0) { GRP(0, bb0, t00); if (t00 >= 256) sel_score(sc, iq, ik, iw, bb0, t00, lane0, wave); }
    __syncthreads();
#pragma unroll 1
    for (int j = 0; j < ngrp; ++j) {
        GRP(j, bb, t0);
        const int t = t0 + wave;
        unsigned short* out = idx + ((size_t)bb * SEQ + t) * 256;
        int ls = lane0; asm volatile("" : "+v"(ls));
        const bool trivial = t0 < 256;
        const int ng = __builtin_amdgcn_readfirstlane(((t >> 6) + 8) >> 3);
        unsigned u[64];
        if (!trivial) {
            const unsigned* scq = sc + wave * 4096;
            const int tl = t - ls;
#pragma unroll
            for (int g8 = 0; g8 < 8; ++g8) {
                if (g8 < ng) {
#pragma unroll
                    for (int jj = 8 * g8; jj < 8 * g8 + 8; ++jj) { const unsigned v_ = scq[jj * 64 + ls]; u[jj] = (jj * 64 <= tl) ? v_ : 0u; }
                } else {
#pragma unroll
                    for (int jj = 8 * g8; jj < 8 * g8 + 8; ++jj) u[jj] = 0u;
                }
            }
        } else {
#pragma unroll
            for (int jj = 0; jj < 64; ++jj) u[jj] = 0u;
        }
        LDS_WAIT();
        __syncthreads();
#pragma unroll 1
        for (int step = 0; step < 2; ++step) {
            if ((step == 0) == (wave < 4)) {
                if (trivial) {
#pragma unroll
                    for (int q4 = 0; q4 < 4; ++q4) { const int kk = q4 * 64 + ls; out[kk] = (unsigned short)(kk <= t ? kk : 0xFFFF); }
                } else sel_pick(u, ng, ls, wave, lds, out);
            } else if (j + 1 < ngrp) {
                GRP(j + 1, bbn, t0n);
                if (t0n >= 256) sel_score(sc, iq, ik, iw, bbn, t0n, lane0, wave);
            }
        }
        __syncthreads();
    }
#undef GRP
}

__device__ __forceinline__ void dsa_attend(const Args& a, unsigned char* lds, int vcu, int G, int tid) {
    unsigned char* ws = a.ws;
    const int lane0 = tid & 63, wave = __builtin_amdgcn_readfirstlane(tid >> 6);
    unsigned char* wl = lds + wave * 12288;
    int* kl = (int*)(wl + 10240);
    const bf16* bq = (const bf16*)(ws + R_BQ); const bf16* bk = (const bf16*)(ws + R_BK); const bf16* bv = (const bf16*)(ws + R_BV);
    const unsigned short* idx = (const unsigned short*)(ws + R_IDX);
    bf16* ao = (bf16*)(ws + R_AO);
    const int gw = vcu * NWAVES + wave, NGW = G * NWAVES;
    for (int p = gw; p < M / 2; p += NGW) {
#pragma unroll 1
        for (int half = 0; half < 2; ++half) {
            int lane = lane0; asm volatile("" : "+v"(lane));
            const int fr = lane & 15, fq = lane >> 4;
            const int bb = p >> 11, x = p & 2047, t = half ? (SEQ - 1 - x) : x;
            const size_t q = (size_t)bb * SEQ + t;
            const int cnt = t < 255 ? t + 1 : 256;
            { const unsigned long long w4 = *(const unsigned long long*)(idx + q * 256 + 4 * lane);
              int k0 = (int)(w4 & 0xffffu), k1 = (int)((w4 >> 16) & 0xffffu), k2 = (int)((w4 >> 32) & 0xffffu), k3 = (int)(w4 >> 48);
              const int p0 = 4 * lane;
              k0 = p0 < cnt ? k0 : 0; k1 = p0 + 1 < cnt ? k1 : 0; k2 = p0 + 2 < cnt ? k2 : 0; k3 = p0 + 3 < cnt ? k3 : 0;
              *(v4u*)(kl + p0) = (v4u){(unsigned)k0, (unsigned)k1, (unsigned)k2, (unsigned)k3}; }
            bf16x8 qf[2];
#pragma unroll
            for (int ks = 0; ks < 2; ++ks) qf[ks] = *(const bf16x8*)(bq + q * 512 + (fr & 7) * 64 + ks * 32 + fq * 8);
            LDS_WAIT(); asm volatile("" ::: "memory");
            const bf16* bkb = bk + (size_t)bb * SEQ * 64 + (lane & 7) * 8;
            const bf16* bvb = bv + (size_t)bb * SEQ * 64 + (lane & 7) * 8;
            v4u vreg[8];
#pragma unroll
            for (int i = 0; i < 8; ++i) vreg[i] = *(const v4u*)(bkb + (size_t)kl[(lane >> 3) + 8 * i] * 64);
            f32x4 s[16];
            const unsigned char* krb = wl + fr * 160 + fq * 16;
#pragma unroll
            for (int c = 0; c < 4; ++c) {
#pragma unroll
                for (int i = 0; i < 8; ++i) *(v4u*)(wl + ((lane >> 3) + 8 * i) * 160 + (lane & 7) * 16) = vreg[i];
                if (c < 3) {
#pragma unroll
                    for (int i = 0; i < 8; ++i) vreg[i] = *(const v4u*)(bkb + (size_t)kl[64 * (c + 1) + (lane >> 3) + 8 * i] * 64);
                } else {
#pragma unroll
                    for (int i = 0; i < 8; ++i) vreg[i] = *(const v4u*)(bvb + (size_t)kl[(lane >> 3) + 8 * i] * 64);
                }
                LDS_WAIT(); asm volatile("" ::: "memory");
#pragma unroll
                for (int T4 = 0; T4 < 4; ++T4) {
                    const bf16x8 k0 = *(const bf16x8*)(krb + T4 * 16 * 160), k1 = *(const bf16x8*)(krb + T4 * 16 * 160 + 64);
                    f32x4 z = {0.f, 0.f, 0.f, 0.f};
                    z = __builtin_amdgcn_mfma_f32_16x16x32_bf16(k0, qf[0], z, 0, 0, 0);
                    s[4 * c + T4] = __builtin_amdgcn_mfma_f32_16x16x32_bf16(k1, qf[1], z, 0, 0, 0);
                }
                LDS_WAIT(); asm volatile("" ::: "memory");
            }
            float mx = -INFINITY;
#pragma unroll
            for (int T = 0; T < 16; ++T)
#pragma unroll
                for (int r = 0; r < 4; ++r) { if (T * 16 + 4 * fq + r >= cnt) s[T][r] = -INFINITY; mx = fmaxf(mx, s[T][r]); }
            mx = fmaxf(mx, __shfl_xor(mx, 16)); mx = fmaxf(mx, __shfl_xor(mx, 32));
            float sum = 0.f;
#pragma unroll
            for (int T = 0; T < 16; ++T)
#pragma unroll
                for (int r = 0; r < 4; ++r) { const float pv = __expf(s[T][r] - mx); s[T][r] = pv; sum += pv; }
            sum += __shfl_xor(sum, 16); sum += __shfl_xor(sum, 32);
            const float inv = __builtin_amdgcn_rcpf(sum);
            bf16x8 pf[8];
#pragma unroll
            for (int kk = 0; kk < 8; ++kk) { v4u w_;
                w_.x = pg8::cvt_pk_bf16(s[2 * kk][0], s[2 * kk][1]); w_.y = pg8::cvt_pk_bf16(s[2 * kk][2], s[2 * kk][3]);
                w_.z = pg8::cvt_pk_bf16(s[2 * kk + 1][0], s[2 * kk + 1][1]); w_.w = pg8::cvt_pk_bf16(s[2 * kk + 1][2], s[2 * kk + 1][3]);
                pf[kk] = __builtin_bit_cast(bf16x8, w_); }
            f32x4 o[4];
#pragma unroll
            for (int dt = 0; dt < 4; ++dt) o[dt] = (f32x4){0.f, 0.f, 0.f, 0.f};
            const unsigned char* trb = wl + (4 * fq + (fr >> 2)) * 160 + (fr & 3) * 8;
#pragma unroll
            for (int c = 0; c < 4; ++c) {
#pragma unroll
                for (int i = 0; i < 8; ++i) *(v4u*)(wl + ((lane >> 3) + 8 * i) * 160 + (lane & 7) * 16) = vreg[i];
                if (c < 3) {
#pragma unroll
                    for (int i = 0; i < 8; ++i) vreg[i] = *(const v4u*)(bvb + (size_t)kl[64 * (c + 1) + (lane >> 3) + 8 * i] * 64);
                }
                LDS_WAIT(); asm volatile("" ::: "memory");
#pragma unroll
                for (int k2 = 0; k2 < 2; ++k2)
#pragma unroll
                    for (int dt = 0; dt < 4; ++dt) {
                        const v4i16_t a0 = tr16(trb + (2 * k2) * 16 * 160 + dt * 32), a1 = tr16(trb + (2 * k2 + 1) * 16 * 160 + dt * 32);
                        const bf16x8 vf = {a0[0], a0[1], a0[2], a0[3], a1[0], a1[1], a1[2], a1[3]};
                        o[dt] = __builtin_amdgcn_mfma_f32_16x16x32_bf16(vf, pf[2 * c + k2], o[dt], 0, 0, 0);
                    }
                LDS_WAIT(); asm volatile("" ::: "memory");
            }
            if (fr < 8) {
#pragma unroll
                for (int dt = 0; dt < 4; ++dt) pg8::st_bf16x4(ao + q * 1024 + 512 + fr * 64 + dt * 16 + 4 * fq, o[dt] * inv);
            }
        }
    }
}

__device__ __forceinline__ void ffn_fixup(const Args& a, int layer, int vcu, int G, int tid) {
    unsigned char* ws = a.ws;
    const float* hl = (const float*)(ws + R_HL); const float* hf = (const float*)(ws + R_HF);
    const float* cw = a.in[16] + (size_t)layer * 3 * DFF2; const float* cb = a.in[17] + (size_t)layer * DFF2;
    bf16* gt = (bf16*)(ws + R_GT);
    for (int it = vcu * NTHR + tid; it < 256 * 2 * (DFF / 4); it += G * NTHR) {
        const int cg = it % (DFF / 4), rr = (it / (DFF / 4)) & 1, blk = it / (2 * (DFF / 4));
        const int g0 = cg * 4; const bool bstart = (blk & 63) == 0;
        const f32x4 z4 = {0.f, 0.f, 0.f, 0.f};
        f32x4 a0g, a0u, a1g, a1u, a2g, a2u;
        { const float* h0 = hf + (size_t)(blk * 2 + rr) * DFF2 + g0; a0g = *(const f32x4*)h0; a0u = *(const f32x4*)(h0 + DFF); }
        if (rr == 1) {
            const float* h1 = hf + (size_t)(blk * 2) * DFF2 + g0; a1g = *(const f32x4*)h1; a1u = *(const f32x4*)(h1 + DFF);
            if (bstart) { a2g = z4; a2u = z4; } else { const float* h2 = hl + (size_t)((blk - 1) * 2 + 1) * DFF2 + g0; a2g = *(const f32x4*)h2; a2u = *(const f32x4*)(h2 + DFF); }
        } else {
            if (bstart) { a1g = z4; a1u = z4; a2g = z4; a2u = z4; }
            else { const float* h1 = hl + (size_t)((blk - 1) * 2 + 1) * DFF2 + g0; a1g = *(const f32x4*)h1; a1u = *(const f32x4*)(h1 + DFF);
                   const float* h2 = hl + (size_t)((blk - 1) * 2) * DFF2 + g0; a2g = *(const f32x4*)h2; a2u = *(const f32x4*)(h2 + DFF); }
        }
        const f32x4 cgv = *(const f32x4*)(cb + g0) + *(const f32x4*)(cw + g0) * a2g + *(const f32x4*)(cw + DFF2 + g0) * a1g + *(const f32x4*)(cw + 2 * DFF2 + g0) * a0g;
        const f32x4 cuv = *(const f32x4*)(cb + DFF + g0) + *(const f32x4*)(cw + DFF + g0) * a2u + *(const f32x4*)(cw + DFF2 + DFF + g0) * a1u + *(const f32x4*)(cw + 2 * DFF2 + DFF + g0) * a0u;
        f32x4 o; o[0] = pg8::silu_f(cgv[0]) * cuv[0]; o[1] = pg8::silu_f(cgv[1]) * cuv[1]; o[2] = pg8::silu_f(cgv[2]) * cuv[2]; o[3] = pg8::silu_f(cgv[3]) * cuv[3];
        pg8::st_bf16x4(gt + (size_t)(blk * 64 + rr) * DFF + g0, o);
    }
}

__device__ __forceinline__ void sgu_mix(const Args& a, unsigned char* lds, int vcu, int G, int tid) {
    unsigned char* ws = a.ws;
    constexpr int RSV = 288, RSW = 272;
    unsigned char* vn = lds;
    unsigned char* wl = lds + 128 * RSV;
    const bf16* z = (const bf16*)(ws + R_Z); bf16* sg = (bf16*)(ws + R_SG);
    const float* lns = (const float*)(ws + WS_SSQ) + 5 * M; const float* lnq = lns + M;
    const float* lg = a.in[9]; const float* lb = a.in[10]; const float* wsp = a.in[11]; const float* bs = a.in[12];
    const int lane = tid & 63, wave = tid >> 6, fr = lane & 15, fq = lane >> 4;
    int gcur = -1;
    for (int unit = vcu; unit < 1024; unit += G) {
        const int g = unit & 7, ci = unit >> 3, row0 = ci * 128;
        if (g != gcur) {
            gcur = g;
            const int t = tid >> 2, s0 = (tid & 3) * 32;
            const f32x4* wr = (const f32x4*)(wsp + ((size_t)g * 128 + t) * 128 + s0);
#pragma unroll
            for (int j = 0; j < 4; ++j) { const f32x4 w0 = wr[2 * j], w1 = wr[2 * j + 1]; const int s = s0 + 8 * j;
                *(v4u*)(wl + t * RSW + s * 2) = (v4u){pk2(s <= t ? w0[0] : 0.f, s + 1 <= t ? w0[1] : 0.f), pk2(s + 2 <= t ? w0[2] : 0.f, s + 3 <= t ? w0[3] : 0.f),
                                                     pk2(s + 4 <= t ? w1[0] : 0.f, s + 5 <= t ? w1[1] : 0.f), pk2(s + 6 <= t ? w1[2] : 0.f, s + 7 <= t ? w1[3] : 0.f)}; }
        }
        { const int s = tid >> 2, c0 = (tid & 3) * 32; const size_t row = (size_t)(row0 + s);
          const float mean = lns[row] * (1.0f / 1024.0f); const float var = lnq[row] * (1.0f / 1024.0f) - mean * mean; const float rstd = __builtin_amdgcn_rsqf(var + 1e-5f);
          const v4u* zr = (const v4u*)(z + row * 2048 + 1024 + g * 128 + c0);
#pragma unroll
          for (int j = 0; j < 4; ++j) { const v4u zw = zr[j]; const int c = g * 128 + c0 + 8 * j;
              const f32x4 g0 = *(const f32x4*)(lg + c), g1 = *(const f32x4*)(lg + c + 4), b0 = *(const f32x4*)(lb + c), b1 = *(const f32x4*)(lb + c + 4);
              const float v0 = (__builtin_bit_cast(float, zw.x << 16) - mean) * rstd * g0[0] + b0[0], v1 = (__builtin_bit_cast(float, zw.x & 0xffff0000u) - mean) * rstd * g0[1] + b0[1];
              const float v2 = (__builtin_bit_cast(float, zw.y << 16) - mean) * rstd * g0[2] + b0[2], v3 = (__builtin_bit_cast(float, zw.y & 0xffff0000u) - mean) * rstd * g0[3] + b0[3];
              const float v4 = (__builtin_bit_cast(float, zw.z << 16) - mean) * rstd * g1[0] + b1[0], v5 = (__builtin_bit_cast(float, zw.z & 0xffff0000u) - mean) * rstd * g1[1] + b1[1];
              const float v6 = (__builtin_bit_cast(float, zw.w << 16) - mean) * rstd * g1[2] + b1[2], v7 = (__builtin_bit_cast(float, zw.w & 0xffff0000u) - mean) * rstd * g1[3] + b1[3];
              *(v4u*)(vn + s * RSV + (c0 + 8 * j) * 2) = (v4u){pk2(v0, v1), pk2(v2, v3), pk2(v4, v5), pk2(v6, v7)}; } }
        __syncthreads();
        bf16x8 af[4];
#pragma unroll
        for (int ks = 0; ks < 4; ++ks) af[ks] = frag_tr(vn, RSV, 32 * ks, 32 * ks + 16, wave * 16, fr, fq);
#pragma unroll
        for (int Tt = 0; Tt < 8; ++Tt) {
            f32x4 acc = {0.f, 0.f, 0.f, 0.f};
#pragma unroll
            for (int ks = 0; ks <= Tt / 2; ++ks) acc = __builtin_amdgcn_mfma_f32_16x16x32_bf16(af[ks], frag_row_perm(wl, RSW, Tt * 16, 32 * ks, 32 * ks + 16, fr, fq), acc, 0, 0, 0);
            const int t = Tt * 16 + fr; const size_t row = (size_t)(row0 + t);
            const float bias = bs[g * 128 + t];
            const int col = g * 128 + wave * 16 + 4 * fq;
            const unsigned long long uw = *(const unsigned long long*)(z + row * 2048 + col);
            f32x4 o;
            o[0] = __builtin_bit_cast(float, (unsigned)(uw << 16)) * (acc[0] + bias); o[1] = __builtin_bit_cast(float, (unsigned)uw & 0xffff0000u) * (acc[1] + bias);
            o[2] = __builtin_bit_cast(float, (unsigned)(uw >> 32) << 16) * (acc[2] + bias); o[3] = __builtin_bit_cast(float, (unsigned)(uw >> 32) & 0xffff0000u) * (acc[3] + bias);
            pg8::st_bf16x4(sg + row * 1024 + col, o);
        }
        __syncthreads();
    }
}

__device__ __forceinline__ void final_norm(const Args& a, int vcu, int G, int tid) {
    const int lane = tid & 63, wave = tid >> 6;
    const float* g = a.in[19];
    const bf16* xb = (const bf16*)(a.ws + WS_XB); const float* ssq4 = (const float*)(a.ws + WS_SSQ) + 4 * M;
    for (int m = vcu * NWAVES + wave; m < M; m += G * NWAVES) {
        const float rs = __builtin_amdgcn_rsqf(ssq4[m] * (1.0f / 1024.0f) + 1e-6f);
        const v4u* xr = (const v4u*)(xb + (size_t)m * DM) + lane;
        f32x4* orow = (f32x4*)(a.out + (size_t)m * DM);
#pragma unroll
        for (int j = 0; j < 2; ++j) { const v4u w = xr[64 * j]; const int c = (lane + 64 * j) * 8;
            const f32x4 g0 = *(const f32x4*)(g + c), g1 = *(const f32x4*)(g + c + 4);
            f32x4 o0, o1;
            o0[0] = __builtin_bit_cast(float, w.x << 16) * rs * g0[0]; o0[1] = __builtin_bit_cast(float, w.x & 0xffff0000u) * rs * g0[1];
            o0[2] = __builtin_bit_cast(float, w.y << 16) * rs * g0[2]; o0[3] = __builtin_bit_cast(float, w.y & 0xffff0000u) * rs * g0[3];
            o1[0] = __builtin_bit_cast(float, w.z << 16) * rs * g1[0]; o1[1] = __builtin_bit_cast(float, w.z & 0xffff0000u) * rs * g1[1];
            o1[2] = __builtin_bit_cast(float, w.w << 16) * rs * g1[2]; o1[3] = __builtin_bit_cast(float, w.w & 0xffff0000u) * rs * g1[3];
            orow[c / 4] = o0; orow[c / 4 + 1] = o1; }
    }
}

__device__ __forceinline__ int opq(int x) { asm volatile("" : "+s"(x)); return x; }
__device__ __forceinline__ int opqv(int x) { asm volatile("" : "+v"(x)); return x; }
constexpr int NPHASE = 16;
__global__ void __launch_bounds__(NTHR, 2) fwd_megakernel(Args args) {
    extern __shared__ __attribute__((aligned(16))) unsigned char lds[];
    const int tid = threadIdx.x;
    const int G = gridDim.x; const int bx = blockIdx.x;
    const int vcu = (G % 8 == 0) ? (bx % 8) * (G / 8) + bx / 8 : bx;
    unsigned char* ws = args.ws;
    for (int u = tid; u < (LDS_BYTES - LDSCTL_OFF) / 4; u += NTHR) ((LAS unsigned*)((LAS unsigned char*)lds + LDSCTL_OFF))[u] = 0u;
    __syncthreads();
    XcdBarrier bar; bar.bar = (unsigned*)(ws + WS_CTL) + CW_BAR; bar.x = 0; bar.st = nullptr;
    const int lo = args.ph_lo, hi = args.ph_hi;
    if (hi - lo > 1) bar = xcd_barrier_post((unsigned*)(ws + WS_CTL) + CW_BAR, (volatile LAS unsigned*)((LAS unsigned char*)lds + MISC_OFF) + 8);
#ifdef PHASE_MASK
#define IN(k) (((PHASE_MASK >> (k)) & 1) && lo <= (k) && (k) < hi)
#else
#define IN(k) (lo <= (k) && (k) < hi)
#endif
#define SEAM(k) do { if (IN(k) && IN((k) + 1)) xcd_barrier(bar); } while (0)
    LAS unsigned char* ring = (LAS unsigned char*)lds;
    float* ssq = (float*)(ws + WS_SSQ);
    bf16* xb = (bf16*)(ws + WS_XB);

    if (IN(0)) { p0_prologue(args, lds, opq(vcu), G, opqv(tid)); __syncthreads(); } SEAM(0);

    if (IN(1)) {
        pg8::Gemm g{xb, (const bf16*)(ws + WS_WIN), M, NIN, DM}; pg8::StaticOrder S; S.init(M, NIN, G, opq(bx));
        pg8::EpiIn E{ssq, (const float*)(ws + WS_ROPE), (bf16*)(ws + R_GQ), (bf16*)(ws + R_GK), (bf16*)(ws + R_GV), (bf16*)(ws + R_GR), (bf16*)(ws + R_BQ), (bf16*)(ws + R_BK), (bf16*)(ws + R_BV),
                      (bf16*)(ws + R_IQ), (bf16*)(ws + R_IK), (float*)(ws + R_ALR), (float*)(ws + R_IW)};
        pg8::gemm_phase<pg8::EpiIn, pg8::StaticOrder, true, true>(ring, g, S, E);
        { const int rem = S.nwg % G;
          if (rem == 0) convert_weights(args, lds, bx, G, opqv(tid), CW_E0, CW_E2); else if (bx >= rem) convert_weights(args, lds, bx - rem, G - rem, opqv(tid), CW_E0, CW_E2); }
    } SEAM(1);

    if (IN(2)) { gla_phase_a(args, lds, opq(vcu), G, opqv(tid)); dsa_select(args, lds, opq(vcu), G, opqv(tid)); __syncthreads(); } SEAM(2);
    if (IN(3)) { gla_scan(args, opq(vcu), G, opqv(tid)); dsa_attend(args, lds, opq(vcu), G, opqv(tid)); __syncthreads(); } SEAM(3);
    if (IN(4)) { gla_phase_b(args, lds, opq(vcu), G, opqv(tid)); } SEAM(4);

    if (IN(5)) {
        pg8::Gemm g{(const bf16*)(ws + R_AO), (const bf16*)(ws + WS_WO), M, DM, DM}; pg8::StaticOrder S; S.init(M, DM, G, opq(bx));
        pg8::EpiRes E{xb, ssq + M};
        pg8::gemm_phase<pg8::EpiRes, pg8::StaticOrder, true, true>(ring, g, S, E);
    } SEAM(5);

#pragma unroll 1
    for (int layer = 0; layer < 2; ++layer) {
        const int pb = layer == 0 ? 6 : 12;
        if (IN(pb)) {
            pg8::Gemm g{xb, (const bf16*)(ws + (layer == 0 ? WS_WUP0 : WS_WUP1)), M, DFF2, DM}; pg8::StaticOrder S; S.init(M, DFF2, G, opq(bx));
            pg8::EpiConv E{ssq + (layer == 0 ? 1 : 3) * M, args.in[16] + (size_t)layer * 3 * DFF2, args.in[17] + (size_t)layer * DFF2, (bf16*)(ws + R_GT), (float*)(ws + R_HL), (float*)(ws + R_HF)};
            pg8::gemm_phase<pg8::EpiConv, pg8::StaticOrder, true, true>(ring, g, S, E);
            if (layer == 0) { const int rem = S.nwg % G;
                if (rem == 0) convert_weights(args, lds, bx, G, opqv(tid), CW_E2, CW_E5); else if (bx >= rem) convert_weights(args, lds, bx - rem, G - rem, opqv(tid), CW_E2, CW_E5); }
        } SEAM(pb);
        if (IN(pb + 1)) { ffn_fixup(args, layer, opq(vcu), G, opqv(tid)); } SEAM(pb + 1);
        if (IN(pb + 2)) {
            pg8::Gemm g{(const bf16*)(ws + R_GT), (const bf16*)(ws + (layer == 0 ? WS_WDN0 : WS_WDN1)), M, DM, DFF}; pg8::StaticOrder S; S.init(M, DM, G, opq(bx));
            pg8::EpiRes E{xb, ssq + (layer == 0 ? 2 : 4) * M};
            pg8::gemm_phase<pg8::EpiRes, pg8::StaticOrder, true, true>(ring, g, S, E);
        } SEAM(pb + 2);
        if (layer == 0) {
            if (IN(9)) {
                pg8::Gemm g{xb, (const bf16*)(ws + WS_WUV), M, 2048, DM}; pg8::StaticOrder S; S.init(M, 2048, G, opq(bx));
                pg8::EpiSgu E{ssq + 2 * M, (bf16*)(ws + R_Z), ssq + 5 * M, ssq + 6 * M};
                pg8::gemm_phase<pg8::EpiSgu, pg8::StaticOrder, true, true>(ring, g, S, E);
            } SEAM(9);
            if (IN(10)) { sgu_mix(args, lds, opq(vcu), G, opqv(tid)); } SEAM(10);
            if (IN(11)) {
                pg8::Gemm g{(const bf16*)(ws + R_SG), (const bf16*)(ws + WS_WOUT), M, DM, DM}; pg8::StaticOrder S; S.init(M, DM, G, opq(bx));
                pg8::EpiRes E{xb, ssq + 3 * M};
                pg8::gemm_phase<pg8::EpiRes, pg8::StaticOrder, true, true>(ring, g, S, E);
            } SEAM(11);
        }
    }
    if (IN(15)) { final_norm(args, opq(vcu), G, opqv(tid)); }
#undef IN
#undef SEAM
}

extern "C" void kernel_launch(void* const* d_in, const int* in_sizes, int n_in, void* d_out, int out_size, void* d_ws, size_t ws_size, hipStream_t stream) {
    static int grid = 0;
    if (grid == 0) {
        if (n_in != 20 || out_size != M * DM || ws_size < WS_END) { fprintf(stderr, "kernel_launch: unexpected problem (n_in %d, out %d, ws %zu)\n", n_in, out_size, ws_size); grid = -1; return; }
        int dev = 0, cus = 0, per_cu = 0;
        if (hipGetDevice(&dev) != hipSuccess || hipDeviceGetAttribute(&cus, hipDeviceAttributeMultiprocessorCount, dev) != hipSuccess) { grid = -1; return; }
        if (hipFuncSetAttribute((const void*)fwd_megakernel, hipFuncAttributeMaxDynamicSharedMemorySize, LDS_BYTES) != hipSuccess) { fprintf(stderr, "kernel_launch: hipFuncSetAttribute failed\n"); grid = -1; return; }
        if (hipOccupancyMaxActiveBlocksPerMultiprocessor(&per_cu, (const void*)fwd_megakernel, NTHR, LDS_BYTES) != hipSuccess || per_cu < 1)
            fprintf(stderr, "kernel_launch: note: occupancy query reports %d workgroups per CU\n", per_cu);
        (void)hipGetLastError();
        grid = cus;
    }
    if (grid < 0) return;
    if (hipMemsetAsync((char*)d_ws + WS_CTL, 0, CTL_ZERO_BYTES, stream) != hipSuccess) { fprintf(stderr, "kernel_launch: hipMemsetAsync failed\n"); return; }
    Args a{};
    for (int i = 0; i < 20; ++i) a.in[i] = (const float*)d_in[i];
    a.out = (float*)d_out; a.ws = (unsigned char*)d_ws;
#if MK_MULTI
    for (int p = 0; p < NPHASE; ++p) { a.ph_lo = p; a.ph_hi = p + 1; hipLaunchKernelGGL(fwd_megakernel, dim3(grid), dim3(NTHR), LDS_BYTES, stream, a); }
#else
    a.ph_lo = 0; a.ph_hi = NPHASE;
    hipLaunchKernelGGL(fwd_megakernel, dim3(grid), dim3(NTHR), LDS_BYTES, stream, a);
#endif
    const hipError_t le = hipPeekAtLastError();
    if (le != hipSuccess) fprintf(stderr, "kernel_launch: launch failed: %s\n", hipGetErrorName(le));
}
```
